# Optimizing an MI355X kernel written in HIP

```python
import math
import jax, jax.numpy as jnp
from jax import lax
import numpy as np

D_MODEL = 1024
BATCH = 4
SEQ = 4096
DEPTH = 2

GRID_W = 64
CTX_LEN = 256
N_MOD = 9
EPS = 1e-6
D_FF = 2816
FFN_RES = 0.5

HEAD_DIM = 64
ROPE_BASE = 10000.0

LRU_WIDTH = 256
LRU_BLOCKS = 4
LRU_BLOCK = LRU_WIDTH // LRU_BLOCKS
CONV_WIDTH = 4
CONV_LEFT = 2
LRU_C = 8.0

SWA_HEADS = 4
SWA_KV_HEADS = 2
SWA_GROUP = SWA_HEADS // SWA_KV_HEADS
WINDOW = 128
QBLK = 128

DIFF_HEADS = 4
DIFF_V_DIM = 2 * HEAD_DIM

IN_SIZES = (LRU_WIDTH, LRU_WIDTH,
            SWA_HEADS * HEAD_DIM, SWA_KV_HEADS * HEAD_DIM, SWA_KV_HEADS * HEAD_DIM,
            DIFF_HEADS * 2 * HEAD_DIM, DIFF_HEADS * 2 * HEAD_DIM, DIFF_HEADS * DIFF_V_DIM)
IN_WIDTH = sum(IN_SIZES)
IN_SPLITS = tuple(int(s) for s in np.cumsum(IN_SIZES)[:-1])
MIX_WIDTH = LRU_WIDTH + SWA_HEADS * HEAD_DIM + DIFF_HEADS * DIFF_V_DIM
NEG_INF = -1e30

kernel_name = 'hybrid_prefix_dit_block'


def rmsnorm(x, g):
    xf = x.astype(jnp.float32)
    y = xf * lax.rsqrt(jnp.mean(xf * xf, axis=-1, keepdims=True) + EPS)
    return (y * g.astype(jnp.float32)).astype(x.dtype)


def modulated_norm(x, g, mod, k):
    shift = mod[:, 3 * k][:, None]
    scale = mod[:, 3 * k + 1][:, None]
    return rmsnorm(x, g) * (1 + scale) + shift


def gate_of(mod, k):
    return mod[:, 3 * k + 2][:, None]


def swiglu(x, w_gu, w_down):
    g, u = jnp.split(x @ w_gu, 2, axis=-1)
    return (jax.nn.silu(g) * u) @ w_down


def ffn_sublayer(h, g, mod, k, w_gu, w_down):
    return h + FFN_RES * gate_of(mod, k) * swiglu(modulated_norm(h, g, mod, k), w_gu, w_down)


def axial_rope_tables(n, dtype):
    rows = n // GRID_W
    row = jnp.repeat(jnp.arange(rows, dtype=jnp.float32), GRID_W)
    col = jnp.tile(jnp.arange(GRID_W, dtype=jnp.float32), rows)
    n_freq = HEAD_DIM // 4
    inv_freq = ROPE_BASE ** (-jnp.arange(n_freq, dtype=jnp.float32) / n_freq)
    ang = jnp.concatenate([row[:, None] * inv_freq, col[:, None] * inv_freq], axis=-1)
    return jnp.cos(ang).astype(dtype), jnp.sin(ang).astype(dtype)


def apply_rope(x, cos, sin):
    x1, x2 = jnp.split(x, 2, axis=-1)
    c = cos[None, :, None]
    s = sin[None, :, None]
    return jnp.concatenate([x1 * c - x2 * s, x1 * s + x2 * c], axis=-1)


def depthwise_conv(x, w, b):
    n = x.shape[1]
    xp = jnp.pad(x, ((0, 0), (CONV_LEFT, CONV_WIDTH - 1 - CONV_LEFT), (0, 0)))
    y = b
    for k in range(CONV_WIDTH):
        y = y + xp[:, k:k + n] * w[k]
    return y


def rglru_coeffs(u, w_r, b_r, w_i, b_i, lam):
    B, n, W = u.shape
    uf = u.astype(jnp.float32)
    ub = uf.reshape(B, n, LRU_BLOCKS, LRU_BLOCK)
    r = jax.nn.sigmoid(jnp.einsum('bnkc,kcd->bnkd', ub, w_r.astype(jnp.float32)).reshape(B, n, W) + b_r.astype(jnp.float32))
    i = jax.nn.sigmoid(jnp.einsum('bnkc,kcd->bnkd', ub, w_i.astype(jnp.float32)).reshape(B, n, W) + b_i.astype(jnp.float32))
    log_a = -LRU_C * r * jax.nn.softplus(-lam.astype(jnp.float32))
    a = jnp.exp(log_a)
    mult = jnp.sqrt(-jnp.expm1(2.0 * log_a))
    return a, mult * i * uf


def linear_scan(a, b, h0, reverse):
    if h0 is not None:
        edge = -1 if reverse else 0
        b = b.at[:, edge].add(a[:, edge] * h0)

    def combine(left, right):
        a_l, b_l = left
        a_r, b_r = right
        return a_l * a_r, a_r * b_l + b_r

    _, h = lax.associative_scan(combine, (a, b), reverse=reverse, axis=1)
    return h


def sink_softmax(logits, sink):
    sink_b = jnp.broadcast_to(sink, logits.shape[:-1] + (1,))
    return jax.nn.softmax(jnp.concatenate([logits, sink_b], axis=-1), axis=-1)


def window_attention_latent(q, k, v, kc, vc, sink):
    B, S, _, d = q.shape
    nb = S // QBLK
    scale = d ** -0.5
    qb = q.reshape(B, nb, QBLK, SWA_KV_HEADS, SWA_GROUP, d)

    def band(t):
        tp = jnp.pad(t, ((0, 0), (QBLK, QBLK), (0, 0), (0, 0))).reshape(B, nb + 2, QBLK, SWA_KV_HEADS, d)
        return jnp.concatenate([tp[:, :-2], tp[:, 1:-1], tp[:, 2:]], axis=2)

    kband, vband = band(k), band(v)
    s_loc = jnp.einsum('bnqhgd,bnkhd->bnhgqk', qb, kband).astype(jnp.float32) * scale
    blk = jnp.arange(nb)[:, None, None]
    q_abs = blk * QBLK + jnp.arange(QBLK)[None, :, None]
    k_abs = (blk - 1) * QBLK + jnp.arange(3 * QBLK)[None, None, :]
    valid = (k_abs >= 0) & (k_abs < S) & (jnp.abs(q_abs - k_abs) <= WINDOW)
    s_loc = jnp.where(valid[None, :, None, None], s_loc, NEG_INF)
    s_ctx = jnp.einsum('bnqhgd,bchd->bnhgqc', qb, kc).astype(jnp.float32) * scale
    sink_r = sink.astype(jnp.float32).reshape(SWA_KV_HEADS, SWA_GROUP)[None, None, :, :, None, None]
    p = sink_softmax(jnp.concatenate([s_loc, s_ctx], axis=-1), sink_r)
    n_loc = 3 * QBLK
    p_loc = p[..., :n_loc].astype(v.dtype)
    p_ctx = p[..., n_loc:n_loc + kc.shape[1]].astype(v.dtype)
    o = jnp.einsum('bnhgqk,bnkhd->bnqhgd', p_loc, vband) + jnp.einsum('bnhgqc,bchd->bnqhgd', p_ctx, vc)
    return o.reshape(B, S, SWA_HEADS * d)


def window_attention_context(qc, kc, vc, sink):
    B, L, _, d = qc.shape
    qg = qc.reshape(B, L, SWA_KV_HEADS, SWA_GROUP, d)
    s = jnp.einsum('bqhgd,bkhd->bhgqk', qg, kc).astype(jnp.float32) * d ** -0.5
    sink_r = sink.astype(jnp.float32).reshape(SWA_KV_HEADS, SWA_GROUP)[None, :, :, None, None]
    p = sink_softmax(s, sink_r)[..., :-1].astype(vc.dtype)
    o = jnp.einsum('bhgqk,bkhd->bqhgd', p, vc)
    return o.reshape(B, L, SWA_HEADS * d)


def diff_attend(q, k, v, lam):
    d = q.shape[-1]
    s = jnp.einsum('bqhmd,bkhmd->bhmqk', q, k).astype(jnp.float32) * d ** -0.5
    p = jax.nn.softmax(s, axis=-1)
    w = (p[:, :, 0] - lam * p[:, :, 1]).astype(v.dtype)
    return jnp.einsum('bhqk,bkhe->bqhe', w, v)


def diff_attention_latent(q, k, v, kc, vc, lam):
    B, S, H, _, d = q.shape
    nb = S // QBLK
    k_all = jnp.concatenate([k, kc], axis=1)
    v_all = jnp.concatenate([v, vc], axis=1)
    qb = jnp.moveaxis(q.reshape(B, nb, QBLK, H, 2, d), 1, 0)
    o = lax.map(lambda qblk: diff_attend(qblk, k_all, v_all, lam), qb)
    return jnp.moveaxis(o, 0, 1).reshape(B, S, H, 2 * d)


def token_mixer(n, nc, w_in, w_out, conv_w, conv_b, lru_w_r, lru_b_r, lru_w_i, lru_b_i, lru_lambda,
                swa_sink, diff_lambda, diff_subln_g, lambda_init, with_ctx_out):
    B, S, _ = n.shape
    Lc = nc.shape[1]
    lx, lg, sq, sk, sv, dq, dk, dv = jnp.split(n @ w_in, IN_SPLITS, axis=-1)
    lxc, lgc, sqc, skc, svc, dqc, dkc, dvc = jnp.split(nc @ w_in, IN_SPLITS, axis=-1)
    cos, sin = axial_rope_tables(S, n.dtype)

    u = depthwise_conv(lx, conv_w, conv_b)
    uc = depthwise_conv(lxc, conv_w, conv_b)
    h_lat = 0.0
    h_ctx = 0.0
    for dirn, reverse in ((0, False), (1, True)):
        prm = (lru_w_r[dirn], lru_b_r[dirn], lru_w_i[dirn], lru_b_i[dirn], lru_lambda[dirn])
        a_c, b_c = rglru_coeffs(uc, *prm)
        hc = linear_scan(a_c, b_c, None, reverse)
        h0 = hc[:, 0] if reverse else hc[:, -1]
        a_l, b_l = rglru_coeffs(u, *prm)
        h_lat = h_lat + linear_scan(a_l, b_l, h0, reverse)
        if with_ctx_out:
            h_ctx = h_ctx + hc
    y_lru = h_lat.astype(n.dtype) * jax.nn.gelu(lg)

    q_s = apply_rope(sq.reshape(B, S, SWA_HEADS, HEAD_DIM), cos, sin)
    k_s = apply_rope(sk.reshape(B, S, SWA_KV_HEADS, HEAD_DIM), cos, sin)
    v_s = sv.reshape(B, S, SWA_KV_HEADS, HEAD_DIM)
    kc_s = skc.reshape(B, Lc, SWA_KV_HEADS, HEAD_DIM)
    vc_s = svc.reshape(B, Lc, SWA_KV_HEADS, HEAD_DIM)
    y_swa = window_attention_latent(q_s, k_s, v_s, kc_s, vc_s, swa_sink)

    lam_f = diff_lambda.astype(jnp.float32)
    lam = jnp.exp(jnp.sum(lam_f[0] * lam_f[1])) - jnp.exp(jnp.sum(lam_f[2] * lam_f[3])) + lambda_init
    q_d = apply_rope(dq.reshape(B, S, DIFF_HEADS * 2, HEAD_DIM), cos, sin).reshape(B, S, DIFF_HEADS, 2, HEAD_DIM)
    k_d = apply_rope(dk.reshape(B, S, DIFF_HEADS * 2, HEAD_DIM), cos, sin).reshape(B, S, DIFF_HEADS, 2, HEAD_DIM)
    v_d = dv.reshape(B, S, DIFF_HEADS, DIFF_V_DIM)
    kc_d = dkc.reshape(B, Lc, DIFF_HEADS, 2, HEAD_DIM)
    vc_d = dvc.reshape(B, Lc, DIFF_HEADS, DIFF_V_DIM)
    o_d = diff_attention_latent(q_d, k_d, v_d, kc_d, vc_d, lam)
    y_diff = (rmsnorm(o_d, diff_subln_g) * (1 - lambda_init)).reshape(B, S, DIFF_HEADS * DIFF_V_DIM)

    y = jnp.concatenate([y_lru, y_swa, y_diff], axis=-1) @ w_out
    if not with_ctx_out:
        return y, None

    yc_lru = h_ctx.astype(nc.dtype) * jax.nn.gelu(lgc)
    yc_swa = window_attention_context(sqc.reshape(B, Lc, SWA_HEADS, HEAD_DIM), kc_s, vc_s, swa_sink)
    oc_d = diff_attend(dqc.reshape(B, Lc, DIFF_HEADS, 2, HEAD_DIM), kc_d, vc_d, lam)
    yc_diff = (rmsnorm(oc_d, diff_subln_g) * (1 - lambda_init)).reshape(B, Lc, DIFF_HEADS * DIFF_V_DIM)
    yc = jnp.concatenate([yc_lru, yc_swa, yc_diff], axis=-1) @ w_out
    return y, yc


def setup_inputs(seed: int = 0) -> dict:
    key = jax.random.key(seed)
    ks = jax.random.split(key, 24)
    f32 = jnp.float32
    D = D_MODEL

    def nrm(k, shape, scale):
        return jax.random.normal(k, shape, f32) * scale

    u = jax.random.uniform(ks[19], (DEPTH, 2, LRU_WIDTH), f32, 0.9, 0.999)
    a0 = u ** (1.0 / LRU_C)
    return {
        'x': nrm(ks[0], (BATCH, SEQ, D), 1.0),
        'c': nrm(ks[1], (BATCH, D), 1.0),
        'ctx': nrm(ks[2], (BATCH, CTX_LEN, D), 1.0),
        'c_ctx': nrm(ks[3], (D,), 1.0),
        'w_ada': nrm(ks[4], (DEPTH, D, N_MOD * D), 0.5 * D ** -0.5),
        'b_ada': nrm(ks[5], (DEPTH, N_MOD * D), 0.02),
        'norm_g': 1.0 + nrm(ks[6], (DEPTH, 3, D), 0.02),
        'ffn1_w_gu': nrm(ks[7], (DEPTH, D, 2 * D_FF), D ** -0.5),
        'ffn1_w_down': nrm(ks[8], (DEPTH, D_FF, D), D_FF ** -0.5),
        'ffn2_w_gu': nrm(ks[9], (DEPTH, D, 2 * D_FF), D ** -0.5),
        'ffn2_w_down': nrm(ks[10], (DEPTH, D_FF, D), D_FF ** -0.5),
        'w_in': nrm(ks[11], (DEPTH, D, IN_WIDTH), D ** -0.5),
        'w_out': nrm(ks[12], (DEPTH, MIX_WIDTH, D), MIX_WIDTH ** -0.5),
        'conv_w': nrm(ks[13], (DEPTH, CONV_WIDTH, LRU_WIDTH), CONV_WIDTH ** -0.5),
        'conv_b': nrm(ks[14], (DEPTH, LRU_WIDTH), 0.02),
        'lru_w_r': nrm(ks[15], (DEPTH, 2, LRU_BLOCKS, LRU_BLOCK, LRU_BLOCK), LRU_BLOCK ** -0.5),
        'lru_b_r': nrm(ks[16], (DEPTH, 2, LRU_WIDTH), 0.02),
        'lru_w_i': nrm(ks[17], (DEPTH, 2, LRU_BLOCKS, LRU_BLOCK, LRU_BLOCK), LRU_BLOCK ** -0.5),
        'lru_b_i': nrm(ks[18], (DEPTH, 2, LRU_WIDTH), 0.02),
        'lru_lambda': jnp.log(a0) - jnp.log1p(-a0),
        'swa_sink': nrm(ks[20], (DEPTH, SWA_HEADS), 0.5),
        'diff_lambda': nrm(ks[21], (DEPTH, 4, HEAD_DIM), 0.1),
        'diff_subln_g': 1.0 + nrm(ks[22], (DEPTH, DIFF_V_DIM), 0.02),
        'final_g': 1.0 + nrm(ks[23], (D,), 0.02),
    }


def reference(x, c, ctx, c_ctx, w_ada, b_ada, norm_g, ffn1_w_gu, ffn1_w_down, ffn2_w_gu, ffn2_w_down,
              w_in, w_out, conv_w, conv_b, lru_w_r, lru_b_r, lru_w_i, lru_b_i, lru_lambda,
              swa_sink, diff_lambda, diff_subln_g, final_g):
    B = x.shape[0]
    h, hc = x, ctx
    s_c = jax.nn.silu(c)
    s_cc = jax.nn.silu(c_ctx)
    for l in range(DEPTH):
        last = l == DEPTH - 1
        mod = (s_c @ w_ada[l] + b_ada[l]).reshape(B, N_MOD, D_MODEL)
        mod_c = (s_cc @ w_ada[l] + b_ada[l]).reshape(1, N_MOD, D_MODEL)
        lambda_init = 0.8 - 0.6 * math.exp(-0.3 * l)
        h = ffn_sublayer(h, norm_g[l, 0], mod, 0, ffn1_w_gu[l], ffn1_w_down[l])
        hc = ffn_sublayer(hc, norm_g[l, 0], mod_c, 0, ffn1_w_gu[l], ffn1_w_down[l])
        y, yc = token_mixer(modulated_norm(h, norm_g[l, 1], mod, 1), modulated_norm(hc, norm_g[l, 1], mod_c, 1),
                            w_in[l], w_out[l], conv_w[l], conv_b[l], lru_w_r[l], lru_b_r[l], lru_w_i[l], lru_b_i[l],
                            lru_lambda[l], swa_sink[l], diff_lambda[l], diff_subln_g[l], lambda_init, not last)
        h = h + gate_of(mod, 1) * y
        h = ffn_sublayer(h, norm_g[l, 2], mod, 2, ffn2_w_gu[l], ffn2_w_down[l])
        if not last:
            hc = hc + gate_of(mod_c, 1) * yc
            hc = ffn_sublayer(hc, norm_g[l, 2], mod_c, 2, ffn2_w_gu[l], ffn2_w_down[l])
    return rmsnorm(h, final_g)
```

```cpp
#include <hip/hip_runtime.h>
#include <cstdio>
#include <cstdint>
#include <cmath>

typedef unsigned short bf16_t;
constexpr int D = 1024, NB = 4, S = 4096, LC = 256, DFF = 2816, NIN = 2560;
constexpr int ML = NB * S, MC = NB * LC, M = ML + MC;
constexpr int NMODW = 9 * D;
constexpr float C2 = 0.125f * 1.4426950408889634f;
constexpr float LOG2E = 1.4426950408889634f;

__device__ __forceinline__ float bf2f(bf16_t v) { return __uint_as_float((unsigned)v << 16); }
__device__ __forceinline__ bf16_t f2bf(float f) { unsigned u = __float_as_uint(f); return (bf16_t)((u + 0x7fffu + ((u >> 16) & 1u)) >> 16); }
__device__ __forceinline__ int bidx(int row) { return row < ML ? (row >> 12) : 4; }
__device__ __forceinline__ float silu_f(float x) { return x / (1.f + __expf(-x)); }
__device__ __forceinline__ float gelu_tanh_f(float x) { const float u = 0.7978845608028654f * (x + 0.044715f * x * x * x); return 0.5f * x * (1.f + tanhf(u)); }
__device__ __forceinline__ float sigmoid_f(float x) { return 1.f / (1.f + __expf(-x)); }

constexpr size_t MiB = 1u << 20;
constexpr size_t WS_CTL = 0;
constexpr size_t WS_MOD = 1 * MiB;
constexpr size_t WS_TAB = WS_MOD + 512 * 1024;
constexpr size_t WS_SUMM = 2 * MiB;
constexpr size_t WS_W = 4 * MiB;
constexpr size_t W_GU = (size_t)2 * DFF * D, W_DN = (size_t)D * DFF, W_IN = (size_t)NIN * D, W_OUT = (size_t)D * D, W_LRU = 2 * 4 * 2 * 64 * 64;
constexpr size_t W_LAYER = 2 * W_GU + 2 * W_DN + W_IN + W_OUT + W_LRU;
constexpr size_t OFF_GU1 = 0, OFF_DN1 = OFF_GU1 + W_GU, OFF_IN = OFF_DN1 + W_DN, OFF_OUT = OFF_IN + W_IN, OFF_GU2 = OFF_OUT + W_OUT, OFF_DN2 = OFF_GU2 + W_GU, OFF_LRU = OFF_DN2 + W_DN;
constexpr size_t WS_H = WS_W + ((2 * W_LAYER * 2 + MiB - 1) / MiB) * MiB;
constexpr size_t WS_R = WS_H + (((size_t)M * D * 4 + MiB - 1) / MiB) * MiB;
constexpr size_t R_PROJ = 0, R_Y = (size_t)M * NIN * 2, R_BYTES = (size_t)M * NIN * 2 + (size_t)M * D * 2;
constexpr size_t WS_NAIVE = WS_R + ((R_BYTES + MiB - 1) / MiB) * MiB;
constexpr size_t WS_END = WS_NAIVE + (size_t)M * 256 * 4;

struct Tab { float cosv[1024]; float sinv[1024]; float lam[2]; float pad[2]; float lruc[2 * 2 * 256]; };

__global__ void k_tables(const float* lru_lambda, const float* diff_lambda, Tab* T) {
    const int i = blockIdx.x * blockDim.x + threadIdx.x;
    if (i < 1024) {
        const int pos = i >> 4, f = i & 15;
        const double q[4] = {1.0, 0.5623413251903491, 0.31622776601683794, 0.1778279410038923};
        double inv = q[f & 3]; for (int j = 0; j < (f >> 2); ++j) inv *= 0.1;
        const float ang = (float)pos * (float)inv;
        double x = (double)ang; const double TWO_PI = 6.283185307179586476925287, PI = 3.141592653589793238462643;
        const double k = rint(x / TWO_PI); double r = x - k * TWO_PI;
        double sgn = 1.0; if (r > PI * 0.5) { r = PI - r; sgn = -1.0; } else if (r < -PI * 0.5) { r = -PI - r; sgn = -1.0; }
        const double r2 = r * r; double ts = r, tc = 1.0, ss = r, cs = 1.0;
        for (int n = 1; n <= 10; ++n) { tc = -tc * r2 / ((2.0 * n - 1.0) * (2.0 * n)); cs += tc; ts = -ts * r2 / ((2.0 * n) * (2.0 * n + 1.0)); ss += ts; }
        T->cosv[i] = (float)(sgn * cs); T->sinv[i] = (float)ss;
        const float lamv = lru_lambda[i]; T->lruc[i] = -8.0f * log1pf(expf(-lamv));
    }
    if (i < 2) {
        const float* dl = diff_lambda + i * 256; float s0 = 0.f, s1 = 0.f;
        for (int j = 0; j < 64; ++j) { s0 += dl[j] * dl[64 + j]; s1 += dl[128 + j] * dl[192 + j]; }
        const float li = 0.8f - 0.6f * expf(-0.3f * (float)i);
        T->lam[i] = expf(s0) - expf(s1) + li;
    }
}

__global__ void __launch_bounds__(256) k_mod(const float* c, const float* c_ctx, const float* w_ada, const float* b_ada, float* MOD) {
    __shared__ float sc[5][1024];
    for (int i = threadIdx.x; i < 5 * 1024; i += 256) { const int b = i >> 10, k = i & 1023; const float v = b < 4 ? c[b * 1024 + k] : c_ctx[k]; sc[b][k] = silu_f(v); }
    __syncthreads();
    const int idx = blockIdx.x * 256 + threadIdx.x;
    const int l = idx / NMODW, n = idx % NMODW;
    const float* w = w_ada + (size_t)l * D * NMODW + n;
    float a0 = 0, a1 = 0, a2 = 0, a3 = 0, a4 = 0;
    for (int k = 0; k < 1024; ++k) { const float wv = w[(size_t)k * NMODW]; a0 += sc[0][k] * wv; a1 += sc[1][k] * wv; a2 += sc[2][k] * wv; a3 += sc[3][k] * wv; a4 += sc[4][k] * wv; }
    const float bb = b_ada[l * NMODW + n]; float* o = MOD + (size_t)l * 5 * NMODW + n;
    o[0] = a0 + bb; o[NMODW] = a1 + bb; o[2 * NMODW] = a2 + bb; o[3 * NMODW] = a3 + bb; o[4 * NMODW] = a4 + bb;
}

__device__ __forceinline__ int dest_row(int kind, int n) {
    if (kind == 1) { const int s = n >= DFF ? 1 : 0, j = n - s * DFF; return 256 * (j >> 7) + 128 * s + (j & 127); }
    if (kind == 2) {
        const int pn = n >> 8, w = n & 255;
        if (pn == 2 || (pn >= 4 && pn <= 7)) { const int hh = w >> 6, x = (w >> 5) & 1, i = w & 31; return 256 * pn + 128 * x + 32 * hh + i; }
        if (pn == 3) { if (w < 128) { const int hh = w >> 6, x = (w >> 5) & 1, i = w & 31; return 768 + 128 * x + 32 * hh + i; } const int v = w - 128; return 768 + 128 * (v >> 6) + 64 + (v & 63); }
        return n;
    }
    return n;
}
__global__ void __launch_bounds__(256) k_wconv(const float* W, int K, int N, bf16_t* WT, int kind) {
    __shared__ float t[64][33];
    const int nblk = N / 32, kb = blockIdx.x / nblk, nb = blockIdx.x % nblk, k0 = 64 * kb, n0 = 32 * nb;
    const int tid = threadIdx.x;
    for (int i = tid; i < 64 * 32; i += 256) { const int kk = i >> 5, nn = i & 31; t[kk][nn] = W[(size_t)(k0 + kk) * N + n0 + nn]; }
    __syncthreads();
    for (int i = tid; i < 32 * 64; i += 256) { const int nn = i >> 6, kk = i & 63; WT[(size_t)dest_row(kind, n0 + nn) * K + k0 + kk] = f2bf(t[kk][nn]); }
}
__global__ void k_wlru(const float* wr, const float* wi, bf16_t* dst) {
    const int i = blockIdx.x * blockDim.x + threadIdx.x;
    const int c = i & 63, d = (i >> 6) & 63, ri = (i >> 12) & 1, blk = (i >> 13) & 3, dir = i >> 15;
    const float* src = ri ? wi : wr;
    dst[i] = f2bf(src[((size_t)(dir * 4 + blk) * 64 + c) * 64 + d]);
}

__global__ void __launch_bounds__(256) k_norm(const float* lat, const float* ctxp, const float* g, const float* MODl, int kk, bf16_t* XN, int nrows) {
    const int row = blockIdx.x * 4 + (threadIdx.x >> 6), lane = threadIdx.x & 63;
    if (row >= nrows) return;
    const float* src = row < ML ? lat + (size_t)row * D : ctxp + (size_t)(row - ML) * D;
    const int b = bidx(row);
    const float* shift = MODl + (size_t)b * NMODW + (3 * kk) * D; const float* scale = shift + D;
    float4 v[4]; float s = 0.f;
    for (int j = 0; j < 4; ++j) { v[j] = ((const float4*)src)[lane + 64 * j]; s += v[j].x * v[j].x + v[j].y * v[j].y + v[j].z * v[j].z + v[j].w * v[j].w; }
    for (int o = 1; o < 64; o <<= 1) s += __shfl_xor(s, o);
    const float rstd = 1.0f / sqrtf(s * (1.0f / D) + 1e-6f);
    for (int j = 0; j < 4; ++j) {
        const int c0 = (lane + 64 * j) * 4; const float4 gg = *(const float4*)(g + c0), sc = *(const float4*)(scale + c0), sh = *(const float4*)(shift + c0);
        bf16_t* o = XN + (size_t)row * D + c0;
        o[0] = f2bf(v[j].x * rstd * gg.x * (1.f + sc.x) + sh.x); o[1] = f2bf(v[j].y * rstd * gg.y * (1.f + sc.y) + sh.y);
        o[2] = f2bf(v[j].z * rstd * gg.z * (1.f + sc.z) + sh.z); o[3] = f2bf(v[j].w * rstd * gg.w * (1.f + sc.w) + sh.w);
    }
}
__global__ void __launch_bounds__(256) k_final(const float* H, const float* g, float* out) {
    const int row = blockIdx.x * 4 + (threadIdx.x >> 6), lane = threadIdx.x & 63;
    const float* src = H + (size_t)row * D; float4 v[4]; float s = 0.f;
    for (int j = 0; j < 4; ++j) { v[j] = ((const float4*)src)[lane + 64 * j]; s += v[j].x * v[j].x + v[j].y * v[j].y + v[j].z * v[j].z + v[j].w * v[j].w; }
    for (int o = 1; o < 64; o <<= 1) s += __shfl_xor(s, o);
    const float rstd = 1.0f / sqrtf(s * (1.0f / D) + 1e-6f);
    for (int j = 0; j < 4; ++j) { const int c0 = (lane + 64 * j) * 4; const float4 gg = *(const float4*)(g + c0);
        float4 o; o.x = v[j].x * rstd * gg.x; o.y = v[j].y * rstd * gg.y; o.z = v[j].z * rstd * gg.z; o.w = v[j].w * rstd * gg.w; *(float4*)(out + (size_t)row * D + c0) = o; }
}

struct OpGU {
    bf16_t* HB;
    static __device__ __forceinline__ void rows(int p, int& r0, int& r1) { r0 = 256 * (p >> 7) + (p & 127); r1 = r0 + 128; }
    __device__ __forceinline__ void epi(int row, int p, float v0, float v1) const { HB[(size_t)row * DFF + p] = f2bf(silu_f(v0) * v1); }
};
struct OpRes {
    const float* in_lat; const float* in_ctx; float* Hout; const float* gate; float coef;
    static __device__ __forceinline__ void rows(int p, int& r0, int& r1) { r0 = 2 * p; r1 = 2 * p + 1; }
    __device__ __forceinline__ void epi(int row, int p, float v0, float v1) const {
        const float* src = row < ML ? in_lat + (size_t)row * D : in_ctx + (size_t)(row - ML) * D; const float* gt = gate + (size_t)bidx(row) * NMODW;
        const int c = 2 * p; Hout[(size_t)row * D + c] = src[c] + coef * gt[c] * v0; Hout[(size_t)row * D + c + 1] = src[c + 1] + coef * gt[c + 1] * v1;
    }
};
struct OpIN {
    bf16_t* PROJ; const float* cosv; const float* sinv;
    static __device__ __forceinline__ void cols(int p, int& c0, int& c1, int& cls) {
        const int pn = p >> 7, w = p & 127;
        if (pn == 2 || (pn >= 4 && pn <= 7)) { c0 = 256 * pn + 64 * (w >> 5) + (w & 31); c1 = c0 + 32; cls = (pn >= 6) ? 3 : 2; }
        else if (pn == 3) { if (w < 64) { c0 = 768 + 64 * (w >> 5) + (w & 31); c1 = c0 + 32; cls = 3; } else { c0 = 896 + 2 * (w - 64); c1 = c0 + 1; cls = 0; } }
        else { c0 = 256 * pn + 2 * w; c1 = c0 + 1; cls = (pn == 1) ? 1 : 0; }
    }
    static __device__ __forceinline__ void rows(int p, int& r0, int& r1) { int c0, c1, cls; cols(p, c0, c1, cls); r0 = dest_row(2, c0); r1 = dest_row(2, c1); }
    __device__ __forceinline__ void epi(int row, int p, float v0, float v1) const {
        int c0, c1, cls; cols(p, c0, c1, cls);
        if (cls == 1) { v0 = gelu_tanh_f(v0); v1 = gelu_tanh_f(v1); }
        else if (cls >= 2) {
            if (row < ML) { const int i = c0 & 31, t = row & 4095, pos = (i < 16) ? (t >> 6) : (t & 63), f = i & 15; const float c = cosv[pos * 16 + f], s = sinv[pos * 16 + f];
                const float o0 = v0 * c - v1 * s, o1 = v0 * s + v1 * c; v0 = o0; v1 = o1; }
            if (cls == 2) { v0 *= C2; v1 *= C2; }
        }
        PROJ[(size_t)row * NIN + c0] = f2bf(v0); PROJ[(size_t)row * NIN + c1] = f2bf(v1);
    }
};
template <class Op> __global__ void __launch_bounds__(256) k_gemm_naive(const bf16_t* A, const bf16_t* Bt, int K, Op op) {
    __shared__ float As[32][68]; __shared__ float Bs[32][68];
    const int tid = threadIdx.x, tx = tid & 15, ty = tid >> 4, row0 = blockIdx.y * 64, p0 = blockIdx.x * 32;
    const int lr = tid >> 2, lk = (tid & 3) * 8;
    int br0, br1; Op::rows(p0 + (lr >> 1), br0, br1); const int brow = (lr & 1) ? br1 : br0;
    const bf16_t* ap = A + (size_t)(row0 + lr) * K + lk; const bf16_t* bp = Bt + (size_t)brow * K + lk;
    float acc[4][4];
    for (int i = 0; i < 4; ++i) for (int j = 0; j < 4; ++j) acc[i][j] = 0.f;
    for (int k0 = 0; k0 < K; k0 += 32) {
        const uint4 av = *(const uint4*)(ap + k0), bv = *(const uint4*)(bp + k0);
        const unsigned aw[4] = {av.x, av.y, av.z, av.w}, bw[4] = {bv.x, bv.y, bv.z, bv.w};
#pragma unroll
        for (int i = 0; i < 4; ++i) { As[lk + 2 * i][lr] = __uint_as_float(aw[i] << 16); As[lk + 2 * i + 1][lr] = __uint_as_float(aw[i] & 0xffff0000u);
                                      Bs[lk + 2 * i][lr] = __uint_as_float(bw[i] << 16); Bs[lk + 2 * i + 1][lr] = __uint_as_float(bw[i] & 0xffff0000u); }
        __syncthreads();
#pragma unroll 8
        for (int kk = 0; kk < 32; ++kk) { const float4 a = *(const float4*)&As[kk][ty * 4], b = *(const float4*)&Bs[kk][tx * 4];
            const float aa[4] = {a.x, a.y, a.z, a.w}, bb[4] = {b.x, b.y, b.z, b.w};
#pragma unroll
            for (int i = 0; i < 4; ++i)
#pragma unroll
                for (int j = 0; j < 4; ++j) acc[i][j] += aa[i] * bb[j]; }
        __syncthreads();
    }
#pragma unroll
    for (int i = 0; i < 4; ++i)
#pragma unroll
        for (int jp = 0; jp < 2; ++jp) op.epi(row0 + ty * 4 + i, p0 + tx * 2 + jp, acc[i][2 * jp], acc[i][2 * jp + 1]);
}

__global__ void __launch_bounds__(256) k_lru_u(const bf16_t* PROJ, const float* cw, const float* cb, float* U) {
    const int row = blockIdx.x, ch = threadIdx.x;
    int base, pos, len; if (row < ML) { base = row & ~4095; pos = row & 4095; len = S; } else { base = ML + ((row - ML) & ~255); pos = (row - ML) & 255; len = LC; }
    float u = cb[ch];
    for (int k = 0; k < 4; ++k) { const int p = pos + k - 2; if (p >= 0 && p < len) u += cw[k * 256 + ch] * bf2f(PROJ[(size_t)(base + p) * NIN + ch]); }
    U[(size_t)row * 256 + ch] = bf2f(f2bf(u));
}
__global__ void __launch_bounds__(256) k_lru_gates(const float* U, const bf16_t* WL  , const float* br, const float* bi, const float* lruc, int dir, float* A, float* Bv) {
    __shared__ float us[256];
    const int row = blockIdx.x, ch = threadIdx.x, blk = ch >> 6, d = ch & 63;
    us[ch] = U[(size_t)row * 256 + ch]; __syncthreads();
    const bf16_t* wr = WL + ((size_t)((dir * 4 + blk) * 2 + 0) * 64 + d) * 64; const bf16_t* wi = wr + 64 * 64;
    float r = 0.f, ii = 0.f;
    for (int c = 0; c < 64; ++c) { const float uv = us[blk * 64 + c]; r += uv * bf2f(wr[c]); ii += uv * bf2f(wi[c]); }
    r = sigmoid_f(r + br[dir * 256 + ch]); ii = sigmoid_f(ii + bi[dir * 256 + ch]);
    const float la = r * lruc[dir * 256 + ch]; const float a = expf(la); const float mult = sqrtf(-expm1f(2.f * la));
    A[(size_t)row * 256 + ch] = a; Bv[(size_t)row * 256 + ch] = mult * ii * us[ch];
}
__global__ void __launch_bounds__(256) k_lru_scan(const float* A, const float* Bv, int dir, float* HSUM) {
    const int b = blockIdx.x, ch = threadIdx.x; float h = 0.f;
    if (dir == 0) {
        for (int j = 0; j < LC; ++j) { const size_t o = (size_t)(ML + b * LC + j) * 256 + ch; h = A[o] * h + Bv[o]; HSUM[o] = h; }
        for (int t = 0; t < S; ++t) { const size_t o = (size_t)(b * S + t) * 256 + ch; h = A[o] * h + Bv[o]; HSUM[o] = h; }
    } else {
        for (int j = LC - 1; j >= 0; --j) { const size_t o = (size_t)(ML + b * LC + j) * 256 + ch; h = A[o] * h + Bv[o]; HSUM[o] += h; }
        for (int t = S - 1; t >= 0; --t) { const size_t o = (size_t)(b * S + t) * 256 + ch; h = A[o] * h + Bv[o]; HSUM[o] += h; }
    }
}
__global__ void __launch_bounds__(256) k_lru_y(const float* HSUM, const bf16_t* PROJ, bf16_t* Y) {
    const int row = blockIdx.x, ch = threadIdx.x;
    Y[(size_t)row * D + ch] = f2bf(HSUM[(size_t)row * 256 + ch] * bf2f(PROJ[(size_t)row * NIN + 256 + ch]));
}
__global__ void __launch_bounds__(64) k_swa_naive(const bf16_t* PROJ, const float* sink, bf16_t* Y, int nrows) {
    const int idx = blockIdx.x * 64 + threadIdx.x; const int row = idx >> 2, h = idx & 3; if (row >= nrows) return;
    const int kvh = h >> 1; float q[64], o[64];
    const bf16_t* qp = PROJ + (size_t)row * NIN + 512 + 64 * h;
#pragma unroll
    for (int d = 0; d < 64; ++d) { q[d] = bf2f(qp[d]); o[d] = 0.f; }
    float m = sink[h] * LOG2E, l = 1.0f;
    int b, t, lo, hi; if (row < ML) { b = row >> 12; t = row & 4095; lo = t - 128 < 0 ? 0 : t - 128; hi = t + 128 > S - 1 ? S - 1 : t + 128; } else { b = (row - ML) >> 8; t = 0; lo = 0; hi = -1; }
    const int nk = LC + (hi - lo + 1);
    for (int kidx = 0; kidx < nk; ++kidx) {
        const int krow = kidx < LC ? ML + b * LC + kidx : b * S + lo + (kidx - LC);
        const bf16_t* kp = PROJ + (size_t)krow * NIN + 768 + 64 * kvh; const bf16_t* vp = PROJ + (size_t)krow * NIN + 896 + 64 * kvh;
        float s = 0.f;
#pragma unroll
        for (int d = 0; d < 64; ++d) s += q[d] * bf2f(kp[d]);
        const float mn = fmaxf(m, s), f = exp2f(m - mn), p = exp2f(s - mn); l = l * f + p; m = mn;
        const float pb = bf2f(f2bf(p));
#pragma unroll
        for (int d = 0; d < 64; ++d) o[d] = o[d] * f + pb * bf2f(vp[d]);
    }
    const float il = 1.f / l; bf16_t* yp = Y + (size_t)row * D + 256 + 64 * h;
#pragma unroll
    for (int d = 0; d < 64; ++d) yp[d] = f2bf(o[d] * il);
}
__global__ void __launch_bounds__(64) k_diff_naive(const bf16_t* PROJ, const float* lamp, const float* subg, float one_minus_li, bf16_t* Y) {
    __shared__ float s1[S + LC], s2[S + LC];
    const int row = blockIdx.x >> 2, h = blockIdx.x & 3, lane = threadIdx.x;
    int b, nk; if (row < ML) { b = row >> 12; nk = S + LC; } else { b = (row - ML) >> 8; nk = LC; }
    const bf16_t* qp = PROJ + (size_t)row * NIN + 1024 + 128 * h;
    float q1[64], q2[64];
#pragma unroll
    for (int d = 0; d < 64; ++d) { q1[d] = bf2f(qp[d]); q2[d] = bf2f(qp[64 + d]); }
    float m1 = -1e30f, m2 = -1e30f;
    for (int kidx = lane; kidx < nk; kidx += 64) {
        const int krow = kidx < LC ? ML + b * LC + kidx : b * S + (kidx - LC);
        const bf16_t* kp = PROJ + (size_t)krow * NIN + 1536 + 128 * h; float a = 0.f, c = 0.f;
#pragma unroll
        for (int d = 0; d < 64; ++d) { a += q1[d] * bf2f(kp[d]); c += q2[d] * bf2f(kp[64 + d]); }
        s1[kidx] = a; s2[kidx] = c; m1 = fmaxf(m1, a); m2 = fmaxf(m2, c);
    }
    for (int o = 1; o < 64; o <<= 1) { m1 = fmaxf(m1, __shfl_xor(m1, o)); m2 = fmaxf(m2, __shfl_xor(m2, o)); }
    float l1 = 0.f, l2 = 0.f;
    for (int kidx = lane; kidx < nk; kidx += 64) { const float e1 = exp2f(s1[kidx] - m1), e2 = exp2f(s2[kidx] - m2); s1[kidx] = e1; s2[kidx] = e2; l1 += e1; l2 += e2; }
    for (int o = 1; o < 64; o <<= 1) { l1 += __shfl_xor(l1, o); l2 += __shfl_xor(l2, o); }
    __syncthreads();
    const float lam = lamp[0]; float o1a = 0.f, o1b = 0.f, o2a = 0.f, o2b = 0.f;
    for (int kidx = 0; kidx < nk; ++kidx) {
        const int krow = kidx < LC ? ML + b * LC + kidx : b * S + (kidx - LC);
        const bf16_t* vp = PROJ + (size_t)krow * NIN + 2048 + 128 * h; const float va = bf2f(vp[lane]), vb = bf2f(vp[64 + lane]);
        const float p1 = bf2f(f2bf(s1[kidx])), p2 = bf2f(f2bf(s2[kidx]));
        o1a += p1 * va; o1b += p1 * vb; o2a += p2 * va; o2b += p2 * vb;
    }
    const float oa = o1a / l1 - lam * o2a / l2, ob = o1b / l1 - lam * o2b / l2;
    float ss = oa * oa + ob * ob; for (int o = 1; o < 64; o <<= 1) ss += __shfl_xor(ss, o);
    const float rstd = 1.0f / sqrtf(ss * (1.0f / 128.f) + 1e-6f);
    bf16_t* yp = Y + (size_t)row * D + 512 + 128 * h;
    yp[lane] = f2bf(oa * rstd * subg[lane] * one_minus_li); yp[64 + lane] = f2bf(ob * rstd * subg[64 + lane] * one_minus_li);
}

extern "C" void kernel_launch(void* const* d_in, const int* in_sizes, int n_in, void* d_out, int out_size, void* d_ws, size_t ws_size, hipStream_t stream) {
    if (n_in != 24 || ws_size < WS_END || out_size != ML * D) { fprintf(stderr, "kernel_launch: unexpected shapes (n_in %d, ws %zu need %zu, out %d)\n", n_in, ws_size, (size_t)WS_END, out_size); return; }
    const float* x = (const float*)d_in[0]; const float* c = (const float*)d_in[1]; const float* ctx = (const float*)d_in[2]; const float* c_ctx = (const float*)d_in[3];
    const float* w_ada = (const float*)d_in[4]; const float* b_ada = (const float*)d_in[5]; const float* norm_g = (const float*)d_in[6];
    const float* ffn1_w_gu = (const float*)d_in[7]; const float* ffn1_w_down = (const float*)d_in[8]; const float* ffn2_w_gu = (const float*)d_in[9]; const float* ffn2_w_down = (const float*)d_in[10];
    const float* w_in = (const float*)d_in[11]; const float* w_out = (const float*)d_in[12]; const float* conv_w = (const float*)d_in[13]; const float* conv_b = (const float*)d_in[14];
    const float* lru_w_r = (const float*)d_in[15]; const float* lru_b_r = (const float*)d_in[16]; const float* lru_w_i = (const float*)d_in[17]; const float* lru_b_i = (const float*)d_in[18];
    const float* lru_lambda = (const float*)d_in[19]; const float* swa_sink = (const float*)d_in[20]; const float* diff_lambda = (const float*)d_in[21]; const float* diff_subln_g = (const float*)d_in[22]; const float* final_g = (const float*)d_in[23];
    unsigned char* ws = (unsigned char*)d_ws;
    float* MOD = (float*)(ws + WS_MOD); Tab* T = (Tab*)(ws + WS_TAB); bf16_t* W = (bf16_t*)(ws + WS_W); float* H = (float*)(ws + WS_H);
    bf16_t* HB = (bf16_t*)(ws + WS_R); bf16_t* PROJ = (bf16_t*)(ws + WS_R + R_PROJ); bf16_t* Y = (bf16_t*)(ws + WS_R + R_Y);
    float* HSUM = (float*)(ws + WS_NAIVE);
    bf16_t* XN = (bf16_t*)d_out;
    float* U = (float*)d_out; float* Ab = U + (size_t)M * 256; float* Bb = Ab + (size_t)M * 256;

    k_tables<<<4, 256, 0, stream>>>(lru_lambda, diff_lambda, T);
    k_mod<<<2 * NMODW / 256, 256, 0, stream>>>(c, c_ctx, w_ada, b_ada, MOD);
    for (int l = 0; l < 2; ++l) {
        bf16_t* Wl = W + (size_t)l * W_LAYER;
        k_wconv<<<(D / 64) * (2 * DFF / 32), 256, 0, stream>>>(ffn1_w_gu + (size_t)l * D * 2 * DFF, D, 2 * DFF, Wl + OFF_GU1, 1);
        k_wconv<<<(DFF / 64) * (D / 32), 256, 0, stream>>>(ffn1_w_down + (size_t)l * DFF * D, DFF, D, Wl + OFF_DN1, 0);
        k_wconv<<<(D / 64) * (NIN / 32), 256, 0, stream>>>(w_in + (size_t)l * D * NIN, D, NIN, Wl + OFF_IN, 2);
        k_wconv<<<(D / 64) * (D / 32), 256, 0, stream>>>(w_out + (size_t)l * D * D, D, D, Wl + OFF_OUT, 0);
        k_wconv<<<(D / 64) * (2 * DFF / 32), 256, 0, stream>>>(ffn2_w_gu + (size_t)l * D * 2 * DFF, D, 2 * DFF, Wl + OFF_GU2, 1);
        k_wconv<<<(DFF / 64) * (D / 32), 256, 0, stream>>>(ffn2_w_down + (size_t)l * DFF * D, DFF, D, Wl + OFF_DN2, 0);
        k_wlru<<<65536 / 256, 256, 0, stream>>>(lru_w_r + (size_t)l * 32768, lru_w_i + (size_t)l * 32768, Wl + OFF_LRU);
    }
    for (int l = 0; l < 2; ++l) {
        const bool last = (l == 1); bf16_t* Wl = W + (size_t)l * W_LAYER; const float* MODl = MOD + (size_t)l * 5 * NMODW; const float* ng = norm_g + (size_t)l * 3 * D;
        const float* in_lat = (l == 0) ? x : H; const float* in_ctx = (l == 0) ? ctx : H + (size_t)ML * D;
        k_norm<<<M / 4, 256, 0, stream>>>(in_lat, in_ctx, ng, MODl, 0, XN, M);
        k_gemm_naive<OpGU><<<dim3(DFF / 32, M / 64), 256, 0, stream>>>(XN, Wl + OFF_GU1, D, OpGU{HB});
        k_gemm_naive<OpRes><<<dim3(D / 64, M / 64), 256, 0, stream>>>(HB, Wl + OFF_DN1, DFF, OpRes{in_lat, in_ctx, H, MODl + 2 * D, 0.5f});
        k_norm<<<M / 4, 256, 0, stream>>>(H, H + (size_t)ML * D, ng + D, MODl, 1, XN, M);
        k_gemm_naive<OpIN><<<dim3(NIN / 64, M / 64), 256, 0, stream>>>(XN, Wl + OFF_IN, D, OpIN{PROJ, T->cosv, T->sinv});
        k_lru_u<<<M, 256, 0, stream>>>(PROJ, conv_w + (size_t)l * 1024, conv_b + (size_t)l * 256, U);
        for (int dir = 0; dir < 2; ++dir) {
            k_lru_gates<<<M, 256, 0, stream>>>(U, Wl + OFF_LRU, lru_b_r + (size_t)l * 512, lru_b_i + (size_t)l * 512, T->lruc + l * 512, dir, Ab, Bb);
            k_lru_scan<<<NB, 256, 0, stream>>>(Ab, Bb, dir, HSUM);
        }
        k_lru_y<<<M, 256, 0, stream>>>(HSUM, PROJ, Y);
        const int mrows = last ? ML : M;
        k_swa_naive<<<mrows * 4 / 64, 64, 0, stream>>>(PROJ, swa_sink + l * 4, Y, mrows);
        k_diff_naive<<<mrows * 4, 64, 0, stream>>>(PROJ, T->lam + l, diff_subln_g + (size_t)l * 128, 1.0f - (0.8f - 0.6f * expf(-0.3f * (float)l)), Y);
        k_gemm_naive<OpRes><<<dim3(D / 64, mrows / 64), 256, 0, stream>>>(Y, Wl + OFF_OUT, D, OpRes{H, H + (size_t)ML * D, H, MODl + 5 * D, 1.0f});
        k_norm<<<mrows / 4, 256, 0, stream>>>(H, H + (size_t)ML * D, ng + 2 * D, MODl, 2, XN, mrows);
        k_gemm_naive<OpGU><<<dim3(DFF / 32, mrows / 64), 256, 0, stream>>>(XN, Wl + OFF_GU2, D, OpGU{HB});
        k_gemm_naive<OpRes><<<dim3(D / 64, mrows / 64), 256, 0, stream>>>(HB, Wl + OFF_DN2, DFF, OpRes{H, H + (size_t)ML * D, H, MODl + 8 * D, 0.5f});
    }
    k_final<<<ML / 4, 256, 0, stream>>>(H, final_g, (float*)d_out);
}
```

```cpp
#include <hip/hip_runtime.h>
#include <cstdio>
#include <cstdint>
#include <cmath>

typedef unsigned short bf16_t;
constexpr int D = 1024, NB = 4, S = 4096, LC = 256, DFF = 2816, NIN = 2560;
constexpr int ML = NB * S, MC = NB * LC, M = ML + MC;
constexpr int NMODW = 9 * D;
constexpr float C2 = 0.125f * 1.4426950408889634f;
constexpr float LOG2E = 1.4426950408889634f;

__device__ __forceinline__ float bf2f(bf16_t v) { return __uint_as_float((unsigned)v << 16); }
__device__ __forceinline__ bf16_t f2bf(float f) { unsigned u = __float_as_uint(f); return (bf16_t)((u + 0x7fffu + ((u >> 16) & 1u)) >> 16); }
__device__ __forceinline__ unsigned cvtpk2(float lo, float hi) { typedef float f2_t __attribute__((ext_vector_type(2))); typedef __bf16 b2_t __attribute__((ext_vector_type(2))); f2_t v = {lo, hi}; b2_t b = __builtin_convertvector(v, b2_t); return __builtin_bit_cast(unsigned, b); }
__device__ __forceinline__ int bidx(int row) { return row < ML ? (row >> 12) : 4; }
__device__ __forceinline__ float silu_f(float x) { return x / (1.f + __expf(-x)); }
__device__ __forceinline__ float gelu_tanh_f(float x) { const float u = 0.7978845608028654f * (x + 0.044715f * x * x * x); return 0.5f * x * (1.f + tanhf(u)); }
__device__ __forceinline__ float sigmoid_f(float x) { return 1.f / (1.f + __expf(-x)); }

constexpr size_t MiB = 1u << 20;
constexpr size_t WS_CTL = 0;
constexpr size_t WS_MOD = 1 * MiB;
constexpr size_t WS_TAB = WS_MOD + 512 * 1024;
constexpr size_t WS_SUMM = 2 * MiB;
constexpr size_t WS_SSQ = 3 * MiB + 256 * 1024;
constexpr size_t WS_GS = 3 * MiB + 512 * 1024;
constexpr size_t WS_SW = 3 * MiB + 768 * 1024;
constexpr size_t WS_W = 5 * MiB;
constexpr size_t W_GU = (size_t)2 * DFF * D, W_DN = (size_t)D * DFF, W_IN = (size_t)NIN * D, W_OUT = (size_t)D * D, W_LRU = 2 * 4 * 2 * 64 * 64;
constexpr size_t W_LAYER = 2 * W_GU + 2 * W_DN + W_IN + W_OUT + W_LRU;
constexpr size_t OFF_GU1 = 0, OFF_DN1 = OFF_GU1 + W_GU, OFF_IN = OFF_DN1 + W_DN, OFF_OUT = OFF_IN + W_IN, OFF_GU2 = OFF_OUT + W_OUT, OFF_DN2 = OFF_GU2 + W_GU, OFF_LRU = OFF_DN2 + W_DN;
constexpr size_t WS_H = WS_W + ((2 * W_LAYER * 2 + MiB - 1) / MiB) * MiB;
constexpr size_t WS_R = WS_H + (((size_t)M * D * 4 + MiB - 1) / MiB) * MiB;
constexpr size_t R_PROJ = 0, R_Y = (size_t)M * NIN * 2, R_BYTES = (size_t)M * NIN * 2 + (size_t)M * D * 2;
constexpr size_t WS_NAIVE = WS_R + ((R_BYTES + MiB - 1) / MiB) * MiB;
constexpr size_t WS_END = WS_NAIVE + (size_t)M * 256 * 4;

enum { T_GU1 = 0, T_DN1, T_NC1, T_IN, T_M1, T_M2, T_OUT, T_NC2, T_GU2, T_DN2, T_NC3 };
struct Tab { float cosv[1024]; float sinv[1024]; float lam[2]; float pad[2]; float lruc[2 * 2 * 256]; };

__device__ __forceinline__ int dest_row(int kind, int n) {
    if (kind == 1) { const int s = n >= DFF ? 1 : 0, j = n - s * DFF; return 256 * (j >> 7) + 128 * s + (j & 127); }
    if (kind == 2) {
        const int pn = n >> 8, w = n & 255;
        if (pn == 2 || (pn >= 4 && pn <= 7)) { const int hh = w >> 6, x = (w >> 5) & 1, i = w & 31; return 256 * pn + 128 * x + 32 * hh + i; }
        if (pn == 3) { if (w < 128) { const int hh = w >> 6, x = (w >> 5) & 1, i = w & 31; return 768 + 128 * x + 32 * hh + i; } const int v = w - 128; return 768 + 128 * (v >> 6) + 64 + (v & 63); }
        return n;
    }
    return n;
}
namespace pg8 {
#define PG8_LAS __attribute__((address_space(3)))
typedef unsigned short bf16_t;
typedef short bf16x8 __attribute__((ext_vector_type(8)));
typedef float f32x4 __attribute__((ext_vector_type(4)));
typedef unsigned u32x4 __attribute__((ext_vector_type(4)));
constexpr int BM = 256, BK = 64, HALF = 128, HTB = HALF * BK * 2  , STAGE_BYTES = 8 * HTB, NXCD = 8, WGM = 4;

__host__ __device__ __forceinline__ int lds_byte(int r, int c) { const int st = (r >> 4) * 2 + (c >> 5), rr = r & 15, cc = c & 31, ob = rr * 64 + cc * 2; return st * 1024 + (ob ^ (((ob >> 9) & 1) << 5)); }
__host__ __device__ __forceinline__ void stage_rc(int b, int& R, int& C) { const int st = b / 1024, sb = b % 1024, swz = sb ^ (((sb >> 9) & 1) << 5); R = (st >> 1) * 16 + swz / 64; C = (st & 1) * 32 + (swz % 64) / 2; }
__host__ __device__ __forceinline__ int perm32(int rho) { const int n = rho >> 4, i = rho & 15; return 8 * (i >> 2) + 4 * n + (i & 3); }

struct Unit { int pm, pn, ko, nt; };
struct Gemm { const bf16_t* A; const bf16_t* Bt; int M, N, K, ld; };

struct StaticOrder {
    static constexpr bool VAR_NT = false;
    int nM, nN, nwg, G, c;
    __host__ __device__ void init(int M, int N, int G_, int c_) { nM = M / BM; nN = N / BM; nwg = nM * nN; G = G_; c = c_; }
    __host__ __device__ bool next(int i, Unit& u) const {
        const long L = (long)i * G + c; if (L >= nwg) return false;
        int wgid = (int)L; { const int q = nwg / NXCD, r = nwg % NXCD, xcd = wgid % NXCD, off = wgid / NXCD; wgid = (xcd < r ? xcd * (q + 1) : r * (q + 1) + (xcd - r) * q) + off; }
        const int nig = WGM * nN, gid = wgid / nig, fm = gid * WGM, gsz = (nM - fm) < WGM ? (nM - fm) : WGM;
        u.pm = fm + ((wgid % nig) % gsz); u.pn = (wgid % nig) / gsz; u.ko = 0; return true;
    }
    __device__ __forceinline__ void a_ready(const Unit&) const {}
    __device__ __forceinline__ void done(const Unit&) const {}
};
struct SliceOrder {
    static constexpr bool VAR_NT = false;
    int ns, KS, G, c;
    __host__ __device__ bool next(int i, Unit& u) const { const int L = i * G + (G - 1 - c); if (L >= 16 * ns) return false; const int tile = L / ns, sl = L % ns; u.pm = 64 + (tile >> 2); u.pn = tile & 3; u.ko = sl * KS; return true; }
    __device__ __forceinline__ void a_ready(const Unit&) const {}
    __device__ __forceinline__ void done(const Unit&) const {}
};

struct DnOrder {
    static constexpr bool VAR_NT = true;
    StaticOrder so; int ns, KS, ntl;
    __host__ __device__ bool next(int i, Unit& u) const {
        const int Ls = so.G - 1 - so.c; const bool hs = Ls < 16 * ns;
        if (hs && i == 0) { const int tile = Ls / ns, sl = Ls % ns; u.pm = 64 + (tile >> 2); u.pn = tile & 3; u.ko = sl * KS; u.nt = KS / BK; return true; }
        if (!so.next(hs ? i - 1 : i, u)) return false;
        u.nt = ntl; return true;
    }
    __device__ __forceinline__ void a_ready(const Unit&) const {}
    __device__ __forceinline__ void done(const Unit&) const {}
};

__device__ __forceinline__ unsigned cvt_pk_bf16(float lo, float hi) { unsigned r; asm volatile("v_cvt_pk_bf16_f32 %0, %1, %2" : "=v"(r) : "v"(lo), "v"(hi)); return r; }
__device__ __forceinline__ float fast_silu(float x) { return x * __builtin_amdgcn_rcpf(1.0f + __builtin_amdgcn_exp2f(-1.4426950408889634f * x)); }
__device__ __forceinline__ float fast_gelu_tanh(float x) {
    const float u = 0.7978845608028654f * (x + 0.044715f * x * x * x);
    return x * __builtin_amdgcn_rcpf(1.0f + __builtin_amdgcn_exp2f(-2.0f * 1.4426950408889634f * u));
}
struct EpiCtx { unsigned long long wsi, outi; const __attribute__((address_space(4))) unsigned long long* kin; int l, ty; };
#define PG8_GAS __attribute__((address_space(1)))
__device__ __forceinline__ unsigned char* ectx_ws(const EpiCtx& c) { return (unsigned char*)(PG8_GAS unsigned char*)c.wsi; }
__device__ __forceinline__ const float* ectx_in(const EpiCtx& c, int i) { return (const float*)(const PG8_GAS float*)(c.kin[i]); }
__device__ __forceinline__ int hw_lane() { unsigned z = 0u; asm volatile("" : "+v"(z)); return (int)__builtin_amdgcn_mbcnt_hi(~0u, __builtin_amdgcn_mbcnt_lo(~0u, z)); }
__device__ __forceinline__ void epi_stage_params(PG8_LAS unsigned char* par, const float* ssq_tile, const float* sw_tile, int wid, int) {
    const int lane = hw_lane();
    if (wid < 4) __builtin_amdgcn_global_load_lds((const unsigned*)(ssq_tile + (size_t)(wid * 64 + lane) * 4), (PG8_LAS unsigned*)(par + wid * 1024), 16, 0, 0);
    else if (wid == 4) __builtin_amdgcn_global_load_lds((const unsigned*)(sw_tile + lane * 4), (PG8_LAS unsigned*)(par + 4096), 16, 0, 0);
}
struct EpiGU {
    static constexpr bool PERM = true, AFTER_DRAIN = false, PARAMS = true, LOOSE = true; static constexpr int NST = 8;
    EpiCtx cx;
    __device__ __forceinline__ void stage(PG8_LAS unsigned char* par, const Unit& u, int wid, int lane) const {
        if (u.pm >= 64) return;
        unsigned char* wsb = ectx_ws(cx);
        epi_stage_params(par, (const float*)(wsb + WS_SSQ) + (size_t)u.pm * BM * 4, (const float*)(wsb + WS_SW) + (size_t)(cx.l * 3 + (cx.ty == T_GU1 ? 0 : 2)) * 4 * 5632 + (size_t)(u.pm >> 4) * 5632 + u.pn * 256, wid, lane);
    }
    __device__ __forceinline__ void operator()(const f32x4 (&acc)[2][2][4][2], const Unit& u, int wr, int wc, int fr_in, int fq_in, const PG8_LAS unsigned char* par) const {
        const int ln_ = hw_lane(); const int fr = ln_ & 15, fq = ln_ >> 4;
        unsigned char* wsb = ectx_ws(cx); bf16_t* HB = (bf16_t*)(wsb + WS_R);
        const int row0 = u.pm * BM + wr * 64 + fr, col0 = u.pn * 128 + wc * 32 + 8 * fq; const bool lat = u.pm < 64;
        float rs[2][4];
        { f32x4 sq[2][4];
#pragma unroll
          for (int ai = 0; ai < 2; ++ai)
#pragma unroll
            for (int m = 0; m < 4; ++m) sq[ai][m] = *(const PG8_LAS f32x4*)(par + (wr * 64 + fr + ai * HALF + m * 16) * 16);
#pragma unroll
          for (int ai = 0; ai < 2; ++ai)
#pragma unroll
            for (int m = 0; m < 4; ++m) rs[ai][m] = lat ? __builtin_amdgcn_rsqf(((sq[ai][m][0] + sq[ai][m][1]) + (sq[ai][m][2] + sq[ai][m][3])) * (1.0f / 1024.0f) + 1e-6f) : 1.0f; }
        f32x4 sv[2][2];
#pragma unroll
        for (int bj = 0; bj < 2; ++bj)
#pragma unroll
            for (int n = 0; n < 2; ++n) { const f32x4 t = *(const PG8_LAS f32x4*)(par + 4096 + (bj * 128 + wc * 32 + 8 * fq + 4 * n) * 4); sv[bj][n] = lat ? t : (f32x4){0.f, 0.f, 0.f, 0.f}; }
        f32x4 svg[2], svu[2];
#pragma unroll
        for (int n = 0; n < 2; ++n) { svg[n] = sv[0][n] * -1.4426950408889634f; svu[n] = sv[1][n] * -0.6931471805599453f; }
#pragma unroll
        for (int ai = 0; ai < 2; ++ai)
#pragma unroll
            for (int m = 0; m < 4; ++m) {
                const int row = row0 + ai * HALF + m * 16; bf16_t* rowp = HB + (size_t)row * 2816 + col0; const float rstd = rs[ai][m];
                const float rg = rstd * -1.4426950408889634f, ru = rstd * -0.6931471805599453f;
                const f32x4 g0 = acc[ai][0][m][0] * rg + svg[0], g1 = acc[ai][0][m][1] * rg + svg[1], u0 = acc[ai][1][m][0] * ru + svu[0], u1 = acc[ai][1][m][1] * ru + svu[1];
#define GU_F(g_, u_) (((g_) * (u_)) * __builtin_amdgcn_rcpf(1.0f + __builtin_amdgcn_exp2f(g_)))
                u32x4 w;
                w.x = cvt_pk_bf16(GU_F(g0[0], u0[0]), GU_F(g0[1], u0[1])); w.y = cvt_pk_bf16(GU_F(g0[2], u0[2]), GU_F(g0[3], u0[3]));
                w.z = cvt_pk_bf16(GU_F(g1[0], u1[0]), GU_F(g1[1], u1[1])); w.w = cvt_pk_bf16(GU_F(g1[2], u1[2]), GU_F(g1[3], u1[3]));
#undef GU_F
                *(u32x4*)rowp = w;
            }
    }
};
struct EpiRes {
    static constexpr bool PERM = false, AFTER_DRAIN = false, PARAMS = false, LOOSE = false;
    EpiCtx cx; PG8_LAS float* part;
    __device__ __forceinline__ void operator()(const f32x4 (&acc)[2][2][4][2], const Unit& u, int wr, int wc, int fr_in, int fq_in, const PG8_LAS unsigned char* par) const {
        const int ln_ = hw_lane(); const int fr = ln_ & 15, fq = ln_ >> 4;
        unsigned char* wsb = ectx_ws(cx); const int l = cx.l, ty = cx.ty;
        const bool hasAN = !(l == 1 && ty == T_DN2);
        const float coef = (ty == T_OUT) ? 1.0f : 0.5f;
        float* ssq = (float*)(wsb + WS_SSQ);
        const int pc0 = wc * 32 + 4 * fq;
        const size_t tb = ((size_t)u.pm * BM) * 1024 + (size_t)u.pn * BM;
        char* hbt = (char*)((bf16_t*)(wsb + WS_H) + tb); char* ant = (char*)((bf16_t*)(PG8_GAS bf16_t*)cx.outi + tb);
        const int r0 = wr * 64 + fr;
        unsigned ro[2][4];
#pragma unroll
        for (int ai = 0; ai < 2; ++ai)
#pragma unroll
            for (int m = 0; m < 4; ++m) ro[ai][m] = (unsigned)((r0 + ai * HALF + m * 16) * 1024 + pc0) * 2u;
        typedef unsigned u32x2w __attribute__((ext_vector_type(2)));
        u32x2w hq[2][4][2][2];
#pragma unroll
        for (int ai = 0; ai < 2; ++ai)
#pragma unroll
            for (int m = 0; m < 4; ++m)
#pragma unroll
                for (int bj = 0; bj < 2; ++bj)
#pragma unroll
                    for (int n = 0; n < 2; ++n) hq[ai][m][bj][n] = *(const u32x2w*)(hbt + (size_t)ro[ai][m] + (bj * HALF + n * 16) * 2);
#pragma unroll
        for (int ai = 0; ai < 2; ++ai)
#pragma unroll
            for (int m = 0; m < 4; ++m) { float sqr = 0.f;
#pragma unroll
                for (int bj = 0; bj < 2; ++bj)
#pragma unroll
                    for (int n = 0; n < 2; ++n) { const int co = bj * HALF + n * 16;
                        const f32x4 gv = *(const PG8_LAS f32x4*)(par + (pc0 + co) * 4) * coef;
                        const u32x2w hw0 = hq[ai][m][bj][n]; const f32x4 hin = (f32x4){__uint_as_float(hw0.x << 16), __uint_as_float(hw0.x & 0xffff0000u), __uint_as_float(hw0.y << 16), __uint_as_float(hw0.y & 0xffff0000u)};
                        const f32x4 v = hin + gv * acc[ai][bj][m][n];
                        { u32x2w hw; hw.x = cvt_pk_bf16(v[0], v[1]); hw.y = cvt_pk_bf16(v[2], v[3]); *(u32x2w*)(hbt + (size_t)ro[ai][m] + co * 2) = hw; }
                        if (hasAN) { const f32x4 gs = *(const PG8_LAS f32x4*)(par + 1024 + (pc0 + co) * 4);
                            sqr += (v[0] * v[0] + v[1] * v[1]) + (v[2] * v[2] + v[3] * v[3]); const f32x4 a = v * gs;
                            u32x2w w; w.x = cvt_pk_bf16(a[0], a[1]); w.y = cvt_pk_bf16(a[2], a[3]);
                            *(u32x2w*)(ant + (size_t)ro[ai][m] + co * 2) = w; } }
                if (hasAN) { float s = sqr;
                    s += __int_as_float(__builtin_amdgcn_ds_bpermute((ln_ ^ 16) << 2, __float_as_int(s))); s += __int_as_float(__builtin_amdgcn_ds_bpermute((ln_ ^ 32) << 2, __float_as_int(s)));
                    if (fq == 0) part[(ai * HALF + wr * 64 + m * 16 + fr) * 4 + wc] = s; }
            }
        if (hasAN) { const int lane = ln_;
            asm volatile("s_waitcnt lgkmcnt(0)" ::: "memory"); __builtin_amdgcn_s_barrier(); asm volatile("" ::: "memory");
            const int tid = (wr * 4 + wc) * 64 + lane;
            if (tid < 256) { const f32x4 p = *(const PG8_LAS f32x4*)(part + tid * 4); ssq[(size_t)(u.pm * BM + tid) * 4 + u.pn] = (p[0] + p[1]) + (p[2] + p[3]); }
        }
    }
};
__device__ __forceinline__ float* slab_ptr(unsigned long long wsi, unsigned long long outi, int s) {
    return s < 7 ? (float*)(PG8_GAS float*)(outi + ((size_t)34 << 20) + ((size_t)s << 22)) : (float*)(PG8_GAS float*)(wsi + WS_R + ((size_t)94 << 20) + ((size_t)(s - 7) << 22)); }
struct EpiResAt {
    static constexpr bool PERM = false, AFTER_DRAIN = false, PARAMS = false, LOOSE = false;
    EpiCtx cx;
    __device__ __forceinline__ void operator()(const f32x4 (&acc)[2][2][4][2], const Unit& u, int wr, int wc, int fr_in, int fq_in, const PG8_LAS unsigned char* par) const {
        const int ln_ = hw_lane(); const int fr = ln_ & 15, fq = ln_ >> 4;
        const int ty = cx.ty;
        const float coef = (ty == T_OUT) ? 1.0f : 0.5f;
        float* dst = (float*)((bf16_t*)slab_ptr(cx.wsi, cx.outi, u.ko >> 8) + (size_t)(u.pm - 64) * BM * 1024); const int col0 = u.pn * BM + wc * 32 + 4 * fq, r0 = wr * 64 + fr;
        f32x4 gv[2][2];
#pragma unroll
        for (int bj = 0; bj < 2; ++bj)
#pragma unroll
            for (int n = 0; n < 2; ++n) gv[bj][n] = *(const PG8_LAS f32x4*)(par + (wc * 32 + 4 * fq + bj * HALF + n * 16) * 4) * coef;
#pragma unroll
        for (int ai = 0; ai < 2; ++ai)
#pragma unroll
            for (int m = 0; m < 4; ++m) { bf16_t* rp = (bf16_t*)dst + (size_t)(r0 + ai * HALF + m * 16) * 1024 + col0;
#pragma unroll
                for (int bj = 0; bj < 2; ++bj)
#pragma unroll
                    for (int n = 0; n < 2; ++n) { const f32x4 t = gv[bj][n] * acc[ai][bj][m][n]; typedef unsigned u32x2s __attribute__((ext_vector_type(2)));
                        u32x2s w; w.x = cvt_pk_bf16(t[0], t[1]); w.y = cvt_pk_bf16(t[2], t[3]); *(u32x2s*)(rp + bj * HALF + n * 16) = w; } }
    }
};
struct EpiDn {
    static constexpr bool PERM = false, AFTER_DRAIN = false, PARAMS = true, LOOSE = true; static constexpr int NST = 32;
    EpiRes r; EpiResAt a;
    __device__ __forceinline__ void stage(PG8_LAS unsigned char* par, const Unit& u, int wid, int) const {
        if (wid >= 2) return;
        const int l = r.cx.l, ty = r.cx.ty; unsigned char* wsb = ectx_ws(r.cx); const int lane = hw_lane(); const bool ctxu = u.pm >= 64; const int b = ctxu ? 4 : (u.pm >> 4);
        if (wid == 0) { const int gk = (ty == T_DN1) ? 2 : (ty == T_OUT) ? 5 : 8;
            __builtin_amdgcn_global_load_lds((const unsigned*)((const float*)(wsb + WS_MOD) + (size_t)l * 5 * 9216 + (size_t)b * 9216 + gk * 1024 + u.pn * BM + lane * 4), (PG8_LAS unsigned*)par, 16, 0, 0); }
        else if (!ctxu && !(l == 1 && ty == T_DN2)) {
            const float* gsn = (const float*)(wsb + WS_GS) + (size_t)((ty == T_DN2 ? l + 1 : l) * 3 + (ty == T_DN1 ? 1 : ty == T_OUT ? 2 : 0)) * 5 * 1024;
            __builtin_amdgcn_global_load_lds((const unsigned*)(gsn + (size_t)b * 1024 + u.pn * BM + lane * 4), (PG8_LAS unsigned*)(par + 1024), 16, 0, 0); }
    }
    __device__ __forceinline__ void operator()(const f32x4 (&acc)[2][2][4][2], const Unit& u, int wr, int wc, int fr_in, int fq_in, const PG8_LAS unsigned char* par) const { if (u.pm >= 64) a(acc, u, wr, wc, fr_in, fq_in, par); else r(acc, u, wr, wc, fr_in, fq_in, par); }
};
struct EpiIN {
    static constexpr bool PERM = true, AFTER_DRAIN = false, PARAMS = true, LOOSE = true; static constexpr int NST = 16;
    EpiCtx cx; const PG8_LAS float* ropet;
    __device__ __forceinline__ void stage(PG8_LAS unsigned char* par, const Unit& u, int wid, int lane) const {
        if (u.pm >= 64) return;
        unsigned char* wsb = ectx_ws(cx);
        epi_stage_params(par, (const float*)(wsb + WS_SSQ) + (size_t)u.pm * BM * 4, (const float*)(wsb + WS_SW) + (size_t)(cx.l * 3 + 1) * 4 * 5632 + (size_t)(u.pm >> 4) * 5632 + u.pn * 256, wid, lane);
    }
    __device__ __forceinline__ void operator()(const f32x4 (&acc)[2][2][4][2], const Unit& u, int wr, int wc, int fr_in, int fq_in, const PG8_LAS unsigned char* par) const {
        const int ln_ = hw_lane(); const int fr = ln_ & 15, fq = ln_ >> 4;
        unsigned char* wsb = ectx_ws(cx); bf16_t* PROJ = (bf16_t*)(wsb + WS_R + R_PROJ); const PG8_LAS float* cosv = ropet; const PG8_LAS float* sinv = ropet + 1024;
        const int pn = u.pn; const int row0 = u.pm * BM + wr * 64 + fr; const int j0 = wc * 32 + 8 * fq;
        const bool rope_tile = (pn == 2) || (pn >= 4 && pn <= 7) || (pn == 3 && wc < 2);
        const float C2q = 0.125f * 1.4426950408889634f;
        const bool lat = u.pm < 64;
        f32x4 sv[2][2];
#pragma unroll
        for (int bj = 0; bj < 2; ++bj)
#pragma unroll
            for (int n = 0; n < 2; ++n) { const f32x4 t = *(const PG8_LAS f32x4*)(par + 4096 + (bj * 128 + j0 + 4 * n) * 4); sv[bj][n] = lat ? t : (f32x4){0.f, 0.f, 0.f, 0.f}; }
        float rs[2][4];
        { f32x4 sq[2][4];
#pragma unroll
          for (int ai = 0; ai < 2; ++ai)
#pragma unroll
            for (int m = 0; m < 4; ++m) sq[ai][m] = *(const PG8_LAS f32x4*)(par + (wr * 64 + fr + ai * HALF + m * 16) * 16);
#pragma unroll
          for (int ai = 0; ai < 2; ++ai)
#pragma unroll
            for (int m = 0; m < 4; ++m) rs[ai][m] = lat ? __builtin_amdgcn_rsqf(((sq[ai][m][0] + sq[ai][m][1]) + (sq[ai][m][2] + sq[ai][m][3])) * (1.0f / 1024.0f) + 1e-6f) : 1.0f; }
#define EPIIN_SV
#define EPIIN_RSTD(row_) const float rstd = rs[ai][m];
        if (!rope_tile) {
            int cbase[2];
            if (pn == 3) { cbase[0] = 896 + (j0 - 64); cbase[1] = 896 + 64 + (j0 - 64); } else { cbase[0] = 256 * pn + j0; cbase[1] = 256 * pn + 128 + j0; }
#pragma unroll
            for (int ai = 0; ai < 2; ++ai)
#pragma unroll
                for (int m = 0; m < 4; ++m) { bf16_t* rowp = PROJ + (size_t)(row0 + ai * HALF + m * 16) * 2560; EPIIN_RSTD(row0 + ai * HALF + m * 16) EPIIN_SV
#pragma unroll
                    for (int bj = 0; bj < 2; ++bj) { f32x4 v0 = acc[ai][bj][m][0] * rstd + sv[bj][0], v1 = acc[ai][bj][m][1] * rstd + sv[bj][1];
                        if (pn == 1) {
#pragma unroll
                            for (int e = 0; e < 4; ++e) { v0[e] = fast_gelu_tanh(v0[e]); v1[e] = fast_gelu_tanh(v1[e]); } }
                        u32x4 w; w.x = cvt_pk_bf16(v0[0], v0[1]); w.y = cvt_pk_bf16(v0[2], v0[3]); w.z = cvt_pk_bf16(v1[0], v1[1]); w.w = cvt_pk_bf16(v1[2], v1[3]);
                        *(u32x4*)(rowp + cbase[bj]) = w; } }
        } else {
            const bool latent = lat; const float qs = (pn == 2 || pn == 4 || pn == 5) ? C2q : 1.0f;
            const int c1 = (pn == 3 ? 768 : 256 * pn) + 64 * wc + 8 * fq;
            const int fo = 8 * (fq & 1);
#pragma unroll
            for (int ai = 0; ai < 2; ++ai) {
                const int posr = (4 * u.pm + 2 * ai + wr) & 63;
#pragma unroll
                for (int m = 0; m < 4; ++m) { bf16_t* rowp = PROJ + (size_t)(row0 + ai * HALF + m * 16) * 2560 + c1;
                    const int pos = (fq < 2) ? posr : (16 * m + fr); EPIIN_RSTD(row0 + ai * HALF + m * 16) EPIIN_SV
                    f32x4 x1a = acc[ai][0][m][0] * rstd + sv[0][0], x1b = acc[ai][0][m][1] * rstd + sv[0][1], x2a = acc[ai][1][m][0] * rstd + sv[1][0], x2b = acc[ai][1][m][1] * rstd + sv[1][1];
                    if (latent) {
                        const f32x4 ca = *(const PG8_LAS f32x4*)(cosv + pos * 16 + fo), cb = *(const PG8_LAS f32x4*)(cosv + pos * 16 + fo + 4), sa = *(const PG8_LAS f32x4*)(sinv + pos * 16 + fo), sb = *(const PG8_LAS f32x4*)(sinv + pos * 16 + fo + 4);
                        const f32x4 o1a = x1a * ca - x2a * sa, o1b = x1b * cb - x2b * sb, o2a = x1a * sa + x2a * ca, o2b = x1b * sb + x2b * cb;
                        x1a = o1a; x1b = o1b; x2a = o2a; x2b = o2b;
                    }
                    x1a = x1a * qs; x1b = x1b * qs; x2a = x2a * qs; x2b = x2b * qs;
                    u32x4 w1, w2; w1.x = cvt_pk_bf16(x1a[0], x1a[1]); w1.y = cvt_pk_bf16(x1a[2], x1a[3]); w1.z = cvt_pk_bf16(x1b[0], x1b[1]); w1.w = cvt_pk_bf16(x1b[2], x1b[3]);
                    w2.x = cvt_pk_bf16(x2a[0], x2a[1]); w2.y = cvt_pk_bf16(x2a[2], x2a[3]); w2.z = cvt_pk_bf16(x2b[0], x2b[1]); w2.w = cvt_pk_bf16(x2b[2], x2b[3]);
                    *(u32x4*)rowp = w1; *(u32x4*)(rowp + 32) = w2; }
            }
        }
    }
};
#undef EPIIN_RSTD
#undef EPIIN_SV

template <class Epi, class Sched, bool ALIGN_EPI = false, bool SP2 = false>
__device__ __forceinline__ void gemm_phase(PG8_LAS unsigned char* lds, const Gemm g, const Sched& S, const Epi& E, const int tid_in) {
    const int tid = tid_in, wid = __builtin_amdgcn_readfirstlane(tid >> 6), lane = tid & 63, wr = wid >> 2, wc = wid & 3, fr = lane & 15, fq = lane >> 4;
    const int K = g.K, LD = g.ld; int nt = K / BK;
    unsigned voffA[2], voffB[2];
#pragma unroll
    for (int i = 0; i < 2; ++i) { int R, C; stage_rc(tid * 16 + i * 8192, R, C); const int Rb = Epi::PERM ? ((R & ~31) + perm32(R & 31)) : R;
        voffA[i] = (unsigned)(R * LD + C) * 2u; voffB[i] = (unsigned)(Rb * LD + C) * 2u; }
    const size_t kstep = (size_t)(BK * 2);
    const size_t hstep = (size_t)HALF * LD * 2;
    const size_t tstep = 2 * hstep;
    const unsigned ldsw = (unsigned)wid * 1024u;
    const int aoff = lds_byte(wr * 64 + fr, fq * 8), boff = lds_byte(wc * 32 + fr, fq * 8);
#define PG8_SA(b, h) (((b) * 2 + (h)) * HTB)
#define PG8_SB(b, h) ((4 + (b) * 2 + (h)) * HTB)
#define PG8_STAGE(bufoff, gbase, voff) do { _Pragma("unroll") for (int _i = 0; _i < 2; ++_i) { unsigned vo_ = (voff)[_i]; asm volatile("" : "+v"(vo_));   \
        __builtin_amdgcn_global_load_lds((const unsigned*)((const char*)(gbase) + vo_), (PG8_LAS unsigned*)(lds + (bufoff) + ldsw + _i * 8192), 16, 0, 0); } } while (0)
#define PG8_LDA(dst, b, h) do { _Pragma("unroll") for (int m = 0; m < 4; ++m) _Pragma("unroll") for (int k = 0; k < 2; ++k) dst[m][k] = *(const PG8_LAS bf16x8*)(lds + PG8_SA(b, h) + aoff + m * 2048 + k * 1024); } while (0)
#define PG8_LDB(dst, b, h) do { _Pragma("unroll") for (int n = 0; n < 2; ++n) _Pragma("unroll") for (int k = 0; k < 2; ++k) dst[n][k] = *(const PG8_LAS bf16x8*)(lds + PG8_SB(b, h) + boff + n * 2048 + k * 1024); } while (0)
#define PG8_MMA(ai, bj, At, Bt) do { __builtin_amdgcn_s_setprio(1); _Pragma("unroll") for (int m = 0; m < 4; ++m) _Pragma("unroll") for (int n = 0; n < 2; ++n) _Pragma("unroll") for (int k = 0; k < 2; ++k) \
        acc[ai][bj][m][n] = __builtin_amdgcn_mfma_f32_16x16x32_bf16(Bt[n][k], At[m][k], acc[ai][bj][m][n], 0, 0, 0); __builtin_amdgcn_s_setprio(0); } while (0)
#define PG8_WAIT_V(n) asm volatile("s_waitcnt vmcnt(" #n ")" ::: "memory")
#define PG8_WAIT_L(n) asm volatile("s_waitcnt lgkmcnt(" #n ")" ::: "memory")
#define PG8_WAIT_VN(n) asm volatile("s_waitcnt vmcnt(%0)" :: "n"(n) : "memory")
#define PG8_BAR __builtin_amdgcn_s_barrier()
#define PG8_SCHED __builtin_amdgcn_sched_barrier(0)
    Unit cur, nxt; int ui = 0;
    if (!S.next(0, cur)) return;
    f32x4 acc[2][2][4][2];
#pragma unroll
    for (int a = 0; a < 2; ++a)
#pragma unroll
        for (int b = 0; b < 2; ++b)
#pragma unroll
            for (int m = 0; m < 4; ++m)
#pragma unroll
                for (int n = 0; n < 2; ++n) acc[a][b][m][n] = (f32x4){0.f, 0.f, 0.f, 0.f};
    bf16x8 At[4][2], B0[2][2], B1[2][2];
    const char* cA = (const char*)g.A + (size_t)cur.pm * tstep + (size_t)cur.ko * 2; const char* cB = (const char*)g.Bt + (size_t)cur.pn * tstep + (size_t)cur.ko * 2;
    if constexpr (Sched::VAR_NT) nt = cur.nt;
    S.a_ready(cur);
    if constexpr (SP2) {
        PG8_STAGE(PG8_SB(0, 0), cB, voffB); PG8_STAGE(PG8_SB(0, 1), cB + hstep, voffB); PG8_STAGE(PG8_SA(0, 0), cA, voffA); PG8_STAGE(PG8_SA(0, 1), cA + hstep, voffA);
        if (wr == 1) PG8_BAR;
        PG8_WAIT_V(2); PG8_BAR;
        PG8_STAGE(PG8_SB(1, 0), cB + kstep, voffB); PG8_STAGE(PG8_SA(1, 0), cA + kstep, voffA); PG8_STAGE(PG8_SB(1, 1), cB + hstep + kstep, voffB);
        PG8_WAIT_V(6); PG8_BAR;
    } else {
        PG8_STAGE(PG8_SB(0, 0), cB, voffB); PG8_STAGE(PG8_SA(0, 0), cA, voffA); PG8_STAGE(PG8_SB(0, 1), cB + hstep, voffB); PG8_STAGE(PG8_SA(0, 1), cA + hstep, voffA);
        if (wr == 1) PG8_BAR;
        PG8_WAIT_V(4); PG8_BAR;
        PG8_STAGE(PG8_SB(1, 0), cB + kstep, voffB); PG8_STAGE(PG8_SA(1, 0), cA + kstep, voffA); PG8_STAGE(PG8_SB(1, 1), cB + hstep + kstep, voffB);
        PG8_WAIT_V(6); PG8_BAR;
    }
    if constexpr (Epi::PARAMS) E.stage(lds + STAGE_BYTES, cur, wid, lane);
    for (;;) {
        const bool has_next = S.next(ui + 1, nxt);
        const char* nA = has_next ? (const char*)g.A + (size_t)nxt.pm * tstep + (size_t)nxt.ko * 2 : cA; const char* nB = has_next ? (const char*)g.Bt + (size_t)nxt.pn * tstep + (size_t)nxt.ko * 2 : cB;
        int t0 = 0;
        if constexpr (Epi::LOOSE) { if (ui > 0) {
            const char* a2 = cA + 2 * kstep; const char* b2 = cB + 2 * kstep; asm volatile("" : "+s"(a2), "+s"(b2));
            const char* a3 = a2 + kstep; const char* b3 = b2 + kstep; asm volatile("" : "+s"(a3), "+s"(b3));
            PG8_LDB(B0, 0, 0); PG8_LDB(B1, 0, 1); PG8_SCHED; PG8_LDA(At, 0, 0);
            PG8_WAIT_VN(8 + Epi::NST); PG8_WAIT_L(0); PG8_BAR; PG8_MMA(0, 0, At, B0); PG8_MMA(0, 1, At, B1); PG8_BAR; PG8_SCHED;
            PG8_LDA(At, 0, 1); PG8_STAGE(PG8_SB(0, 0), b2, voffB); PG8_STAGE(PG8_SB(0, 1), b2 + hstep, voffB); PG8_STAGE(PG8_SA(0, 0), a2, voffA);
            PG8_WAIT_VN(8 + Epi::NST); PG8_WAIT_L(0); PG8_BAR; PG8_MMA(1, 0, At, B0); PG8_MMA(1, 1, At, B1); PG8_BAR; PG8_SCHED;
            PG8_LDB(B0, 1, 0); PG8_LDB(B1, 1, 1); PG8_SCHED; PG8_LDA(At, 1, 0); PG8_STAGE(PG8_SA(0, 1), a2 + hstep, voffA);
            PG8_WAIT_VN(8 + Epi::NST); PG8_WAIT_L(0); PG8_BAR; PG8_MMA(0, 0, At, B0); PG8_MMA(0, 1, At, B1); PG8_BAR; PG8_SCHED;
            PG8_LDA(At, 1, 1); PG8_STAGE(PG8_SB(1, 0), b3, voffB); PG8_STAGE(PG8_SB(1, 1), b3 + hstep, voffB); PG8_STAGE(PG8_SA(1, 0), a3, voffA);
            PG8_WAIT_V(8); PG8_WAIT_L(0); PG8_BAR; PG8_MMA(1, 0, At, B0); PG8_MMA(1, 1, At, B1); PG8_BAR; PG8_SCHED;
            t0 = 2; } }
        for (int t = t0; t < nt; t += 2) {
            const bool last = (t == nt - 2);
            const char* a1 = cA + (size_t)(t + 1) * kstep;
            const char* a2 = last ? nA : cA + (size_t)(t + 2) * kstep; const char* b2 = last ? nB : cB + (size_t)(t + 2) * kstep;
            const char* a3 = a2 + kstep; const char* b3 = b2 + kstep;
            if (last && has_next) S.a_ready(nxt);
            if constexpr (SP2) {
            PG8_LDB(B0, 0, 0); PG8_LDB(B1, 0, 1); PG8_SCHED; PG8_LDA(At, 0, 0); PG8_STAGE(PG8_SA(1, 1), a1 + hstep, voffA);
            PG8_WAIT_V(8); PG8_WAIT_L(0); PG8_BAR; PG8_MMA(0, 0, At, B0); PG8_MMA(0, 1, At, B1); PG8_BAR; PG8_SCHED;
            PG8_LDA(At, 0, 1); PG8_STAGE(PG8_SB(0, 0), b2, voffB); PG8_STAGE(PG8_SB(0, 1), b2 + hstep, voffB); PG8_STAGE(PG8_SA(0, 0), a2, voffA);
            PG8_WAIT_V(8); PG8_WAIT_L(0); PG8_BAR; PG8_MMA(1, 0, At, B0); PG8_MMA(1, 1, At, B1); PG8_BAR; PG8_SCHED;
            PG8_LDB(B0, 1, 0); PG8_LDB(B1, 1, 1); PG8_SCHED; PG8_LDA(At, 1, 0); PG8_STAGE(PG8_SA(0, 1), a2 + hstep, voffA);
            PG8_WAIT_V(8); PG8_WAIT_L(0); PG8_BAR; PG8_MMA(0, 0, At, B0); PG8_MMA(0, 1, At, B1); PG8_BAR; PG8_SCHED;
            PG8_LDA(At, 1, 1); PG8_STAGE(PG8_SB(1, 0), b3, voffB); PG8_STAGE(PG8_SB(1, 1), b3 + hstep, voffB); PG8_STAGE(PG8_SA(1, 0), a3, voffA);
            PG8_WAIT_V(8); PG8_WAIT_L(0); PG8_BAR; PG8_MMA(1, 0, At, B0); PG8_MMA(1, 1, At, B1); PG8_BAR; PG8_SCHED;
            } else {
            PG8_LDB(B0, 0, 0); PG8_SCHED; PG8_LDA(At, 0, 0); PG8_STAGE(PG8_SA(1, 1), a1 + hstep, voffA);
            PG8_WAIT_L(8); PG8_BAR; PG8_WAIT_L(0); PG8_MMA(0, 0, At, B0); PG8_BAR; PG8_SCHED;
            PG8_LDB(B1, 0, 1); PG8_STAGE(PG8_SB(0, 0), b2, voffB);
            PG8_BAR; PG8_WAIT_L(0); PG8_MMA(0, 1, At, B1); PG8_BAR;
            PG8_LDA(At, 0, 1); PG8_STAGE(PG8_SA(0, 0), a2, voffA);
            PG8_BAR; PG8_WAIT_L(0); PG8_MMA(1, 0, At, B0); PG8_BAR; PG8_SCHED;
            PG8_STAGE(PG8_SB(0, 1), b2 + hstep, voffB);
            PG8_WAIT_V(6); PG8_BAR; PG8_MMA(1, 1, At, B1); PG8_BAR;
            PG8_LDB(B0, 1, 0); PG8_SCHED; PG8_LDA(At, 1, 0); PG8_STAGE(PG8_SA(0, 1), a2 + hstep, voffA);
            PG8_WAIT_L(8); PG8_BAR; PG8_WAIT_L(0); PG8_MMA(0, 0, At, B0); PG8_BAR; PG8_SCHED;
            PG8_LDB(B1, 1, 1); PG8_STAGE(PG8_SB(1, 0), b3, voffB);
            PG8_BAR; PG8_WAIT_L(0); PG8_MMA(0, 1, At, B1); PG8_BAR;
            PG8_LDA(At, 1, 1); PG8_STAGE(PG8_SA(1, 0), a3, voffA);
            PG8_BAR; PG8_WAIT_L(0); PG8_MMA(1, 0, At, B0); PG8_BAR; PG8_SCHED;
            PG8_STAGE(PG8_SB(1, 1), b3 + hstep, voffB);
            PG8_WAIT_V(6); PG8_BAR; PG8_MMA(1, 1, At, B1); PG8_BAR;
            }
        }
        if constexpr (Epi::PARAMS || Epi::LOOSE) { if (has_next) { if constexpr (Epi::LOOSE) { const char* xa = nA + kstep + hstep; asm volatile("" : "+s"(xa)); PG8_STAGE(PG8_SA(1, 1), xa, voffA); } if constexpr (Epi::PARAMS) E.stage(lds + STAGE_BYTES + ((ui + 1) & 1) * 5120, nxt, wid, lane); } }
        if constexpr (ALIGN_EPI) { if (wr == 0) PG8_BAR; }
        if constexpr (!Epi::AFTER_DRAIN) { if constexpr (Epi::PARAMS) E(acc, cur, wr, wc, fr, fq, lds + STAGE_BYTES + (ui & 1) * 5120); else E(acc, cur, wr, wc, fr, fq); S.done(cur); }
        if (!has_next) break;
#pragma unroll
        for (int a = 0; a < 2; ++a)
#pragma unroll
            for (int b = 0; b < 2; ++b)
#pragma unroll
                for (int m = 0; m < 4; ++m)
#pragma unroll
                    for (int n = 0; n < 2; ++n) acc[a][b][m][n] = (f32x4){0.f, 0.f, 0.f, 0.f};
        cur = nxt; cA = nA; cB = nB; ++ui; if constexpr (Sched::VAR_NT) nt = cur.nt;
        if constexpr (ALIGN_EPI) { if (wr == 1) PG8_BAR; }
    }
    PG8_WAIT_V(0);
    if constexpr (!ALIGN_EPI) { if (wr == 0) PG8_BAR; }
    PG8_BAR;
    if constexpr (Epi::AFTER_DRAIN) { E.fused(acc, cur, wr, wc, fr, fq, lds, wid, lane); S.done(cur); }
#undef PG8_SA
#undef PG8_SB
#undef PG8_STAGE
#undef PG8_LDA
#undef PG8_LDB
#undef PG8_MMA
#undef PG8_WAIT_V
#undef PG8_WAIT_L
#undef PG8_WAIT_VN
#undef PG8_BAR
#undef PG8_SCHED
}
}

#define GAS __attribute__((address_space(1)))
#define LAS __attribute__((address_space(3)))
typedef unsigned short bf16;
typedef unsigned v4u __attribute__((ext_vector_type(4)));
typedef float f32x4 __attribute__((ext_vector_type(4)));
typedef short bf16x8 __attribute__((ext_vector_type(8)));
typedef GAS unsigned gu32;
typedef GAS unsigned long long gu64;
#define RLX_AGENT __ATOMIC_RELAXED, __HIP_MEMORY_SCOPE_AGENT
#define LDS_WAIT() asm volatile("s_waitcnt lgkmcnt(0)" ::: "memory")
#define VM_WAIT() asm volatile("s_waitcnt vmcnt(0)" ::: "memory")
__device__ __forceinline__ unsigned long long rt() { return __builtin_amdgcn_s_memrealtime(); }
#define XB_TMO      128
#define XB_XCNT(j)  (256  + 64 * (j))
#define XB_XSUB(j)  (1280 + 64 * (j))
#define XB_XGEN(j)  (2304 + 64 * (j))
#define XB_TOP      3328
#define XB_TOPGEN   3392
#define XCD_BAR_WORDS 3456
#define XB_SPIN_CAP (1u << 18)

__device__ __forceinline__ unsigned xb_ld(unsigned* p)              { return __hip_atomic_load(p, __ATOMIC_RELAXED, __HIP_MEMORY_SCOPE_AGENT); }
__device__ __forceinline__ unsigned xb_add(unsigned* p, unsigned v) { return __hip_atomic_fetch_add(p, v, __ATOMIC_RELAXED, __HIP_MEMORY_SCOPE_AGENT); }
__device__ __forceinline__ unsigned xb_xcc_id() { return (unsigned)__builtin_amdgcn_s_getreg((3 << 11) | 20) & 0xFu; }
#define XB_SPIN(cond, bar) do { unsigned _sp = 0; while (cond) { __builtin_amdgcn_s_sleep(1); \
    if ((++_sp & 255u) == 0u) { if (xb_ld(&(bar)[XB_TMO])) break; if (_sp > XB_SPIN_CAP) { atomicAdd(&(bar)[XB_TMO], 1u); break; } } } } while (0)

struct XcdBarrier {
    unsigned* bar; unsigned x; int w0;
    volatile LAS unsigned* st;
};

__device__ __forceinline__ XcdBarrier xcd_barrier_post(unsigned* bar, volatile LAS unsigned* st) {
    XcdBarrier b; b.bar = bar; b.x = xb_xcc_id(); b.st = st; b.w0 = __builtin_amdgcn_readfirstlane(threadIdx.x >> 6);
    if (threadIdx.x == 0) (void)xb_add(&bar[XB_XCNT(b.x)], 1u);
    return b;
}
__device__ __forceinline__ void xcd_barrier_complete(unsigned* bar, unsigned x, unsigned& nloc, unsigned& nx) {
    const unsigned G = gridDim.x * gridDim.y * gridDim.z;
    unsigned sum, cnt, mine, sp = 0u;
    for (;;) {
        sum = 0u; cnt = 0u; mine = 0u;
#pragma unroll
        for (unsigned j = 0; j < 16; ++j) { const unsigned c = xb_ld(&bar[XB_XCNT(j)]); sum += c; cnt += (c > 0u) ? 1u : 0u; mine = (j == x) ? c : mine; }
        if (sum == G) break;
        __builtin_amdgcn_s_sleep(1);
        if ((++sp & 255u) == 0u) { if (xb_ld(&bar[XB_TMO])) break; if (sp > XB_SPIN_CAP) { atomicAdd(&bar[XB_TMO], 1u); break; } }
    }
    nloc = mine > 0u ? mine : 1u; nx = cnt > 0u ? cnt : 1u;
}

__device__ __forceinline__ void xcd_barrier(const XcdBarrier& b) {
    asm volatile("s_waitcnt vmcnt(0)" ::: "memory");
    __syncthreads();
    if (b.w0 == 0 && __builtin_amdgcn_mbcnt_hi(~0u, __builtin_amdgcn_mbcnt_lo(~0u, 0u)) == 0u) {
        unsigned* bar = b.bar;
        __builtin_amdgcn_s_waitcnt(0);
        unsigned nloc = b.st[0], nx = b.st[1];
        if (nloc == 0u) { xcd_barrier_complete(bar, b.x, nloc, nx); b.st[0] = nloc; b.st[1] = nx; }
        const unsigned old = xb_add(&bar[XB_XSUB(b.x)], 1u);
        const unsigned gen = old / nloc;
        if (old + 1u == (gen + 1u) * nloc) {
            __builtin_amdgcn_fence(__ATOMIC_RELEASE, "agent");
            asm volatile("s_waitcnt vmcnt(0)" ::: "memory");
            const unsigned og = xb_add(&bar[XB_TOP], 1u);
            const unsigned tg = og / nx;
            if (og + 1u == (tg + 1u) * nx) xb_add(&bar[XB_TOPGEN], 1u);
            else XB_SPIN(xb_ld(&bar[XB_TOPGEN]) == tg, bar);
            __builtin_amdgcn_fence(__ATOMIC_ACQUIRE, "agent");
            xb_add(&bar[XB_XGEN(b.x)], 1u);
            asm volatile("s_waitcnt vmcnt(0)" ::: "memory");
        } else {
            XB_SPIN(xb_ld(&bar[XB_XGEN(b.x)]) == gen, bar);
            __builtin_amdgcn_fence(__ATOMIC_ACQUIRE, "agent");
            asm volatile("s_waitcnt vmcnt(0)" ::: "memory");
        }
    }
    __syncthreads();
}


namespace att {
typedef float f32x16 __attribute__((ext_vector_type(16)));
typedef short s16x4 __attribute__((ext_vector_type(4)));
typedef short v4i16_t __attribute__((ext_vector_type(4)));
typedef short bf16x8 __attribute__((ext_vector_type(8)));
typedef unsigned u32x4 __attribute__((ext_vector_type(4)));
#define ATT_LAS __attribute__((address_space(3)))
__device__ __forceinline__ int crow(int r, int hi) { return (r & 3) + 8 * (r >> 2) + 4 * hi; }
__device__ __forceinline__ unsigned cvtpk(float lo, float hi) { typedef float f2 __attribute__((ext_vector_type(2))); typedef __bf16 b2 __attribute__((ext_vector_type(2))); f2 v = {lo, hi}; b2 b = __builtin_convertvector(v, b2); return __builtin_bit_cast(unsigned, b); }
__device__ __forceinline__ float swapmax(float m) { auto rr = __builtin_amdgcn_permlane32_swap(__float_as_uint(m), __float_as_uint(m), false, false); return fmaxf(__uint_as_float(rr[0]), __uint_as_float(rr[1])); }
__device__ __forceinline__ float swapsum(float m) { auto rr = __builtin_amdgcn_permlane32_swap(__float_as_uint(m), __float_as_uint(m), false, false); return __uint_as_float(rr[0]) + __uint_as_float(rr[1]); }
__device__ __forceinline__ float sx(float v, int mask, int lane) { return __int_as_float(__builtin_amdgcn_ds_bpermute((lane ^ mask) << 2, __float_as_int(v))); }
constexpr float THR = 8.0f;
constexpr int NOMASK = -1000000;

struct TileSeq {
    int b, nt, mode  , q0, jlo;
    __device__ __forceinline__ int row(int t, int& kabs0) const {
        if (t < 4) { kabs0 = NOMASK; return 16384 + b * 256 + 64 * t; }
        if (mode == 0) { kabs0 = NOMASK; return b * 4096 + 64 * (t - 4); }
        const int j = jlo + t - 4; kabs0 = q0 - 128 + 64 * j; return b * 4096 + kabs0;
    }
};

__device__ __forceinline__ void dma16(const void* g, ATT_LAS unsigned char* l) {
    asm volatile("s_mov_b32 m0, %1\n\ts_nop 0\n\tglobal_load_lds_dwordx4 %0, off" :: "v"(g), "s"((unsigned)(unsigned long)l) : "memory", "m0");
}
template <int NS, int ND> __device__ __forceinline__ void issue_tile(ATT_LAS unsigned char* stage, const unsigned short* PROJ, int krow0, int kcol, int vcol, int wave, int lane) {
#pragma unroll
    for (int i = 0; i < NS; ++i) { const int p = wave + 8 * i, s = p >> 3, c = p & 7;
        const unsigned short* src = PROJ + (size_t)(krow0 + lane) * 2560 + kcol + 64 * s + 8 * c;
        dma16(src, stage + s * 8192 + c * 1024); }
#pragma unroll
    for (int i = 0; i < ND / 2; ++i) { const int p = wave + 8 * i, dblk = p >> 2, rg = p & 3;
        const unsigned short* src = PROJ + (size_t)(krow0 + 16 * rg + (lane >> 2)) * 2560 + vcol + 32 * dblk + 8 * (lane & 3);
        dma16(src, stage + NS * 8192 + (dblk * 4 + rg) * 1024); }
}
__device__ __forceinline__ s16x4 vtr(const ATT_LAS unsigned char* p) { return __builtin_bit_cast(s16x4, __builtin_amdgcn_ds_read_tr16_b64_v4i16((ATT_LAS v4i16_t*)p)); }

#define AT_ROWS_OUT(Ts_, ND_, Y_, qrow_, ycol_, lane_) do { asm volatile("s_waitcnt lgkmcnt(0)" ::: "memory"); \
        _Pragma("unroll") for (int j_ = 0; j_ < 2 * (ND_); ++j_) { const int idx_ = (lane_) + 64 * j_, row_ = idx_ / (4 * (ND_)), ch_ = idx_ % (4 * (ND_)); \
            const u32x4 v_ = *(const ATT_LAS u32x4*)((Ts_) + row_ * (64 * (ND_)) + ch_ * 16); \
            *(u32x4*)((Y_) + (size_t)((qrow_) + row_) * 1024 + (ycol_) + 8 * ch_) = v_; } } while (0)
#define AT_MX3(a, b, c) __builtin_fmaxf(__builtin_fmaxf((a), (b)), (c))
template <int NS, int ND> __device__ __forceinline__ void pv_step(f32x16 (&o)[NS][ND], const u32x4 (&pf)[NS][4], const ATT_LAS unsigned char* Vs);
template <int NS, int ND, int NSTG, bool QLDS>
__device__ __forceinline__ void attn_unit(ATT_LAS unsigned char* lds, const unsigned short* PROJ, unsigned short* Y, const TileSeq ts, int qrow, int qcol, int kcol, int vcol, int ycol,
                                          int qabs, float sinkl2, float lam, const float* subg, float oml, int tid) {
    constexpr int STAGE = NS * 8192 + ND * 4096, NDMA = NS + ND / 2;
    const int lane = tid & 63, r32 = lane & 31, hi = lane >> 5; const int wave = __builtin_amdgcn_readfirstlane(tid >> 6);
    constexpr int QBYTES = QLDS ? 8 * NS * 4096 : 0;
    ATT_LAS unsigned char* Qs = lds + NSTG * STAGE + wave * (NS * 4096);
    ATT_LAS float* wsf = (ATT_LAS float*)(lds + NSTG * STAGE + QBYTES) + wave * 64;
    int ka;
    { const int kr = ts.row(0, ka); issue_tile<NS, ND>(lds, PROJ, kr, kcol, vcol, wave, lane); }
    if (NSTG == 3 && ts.nt > 1) { const int kr = ts.row(1, ka); issue_tile<NS, ND>(lds + STAGE, PROJ, kr, kcol, vcol, wave, lane); }
    bf16x8 qf[NS][4];
#pragma unroll
    for (int s = 0; s < NS; ++s)
#pragma unroll
        for (int d0 = 0; d0 < 4; ++d0) { qf[s][d0] = *(const bf16x8*)(PROJ + (size_t)(qrow + r32) * 2560 + qcol + 64 * s + 16 * d0 + 8 * hi);
            if (QLDS) *(ATT_LAS bf16x8*)(Qs + (s * 8 + 2 * d0 + hi) * 512 + r32 * 16) = qf[s][d0]; }
    f32x16 o[NS][ND];
#pragma unroll
    for (int s = 0; s < NS; ++s)
#pragma unroll
        for (int d = 0; d < ND; ++d)
#pragma unroll
            for (int r = 0; r < 16; ++r) o[s][d][r] = 0.f;
    float mref[NS], lsum[NS];
#pragma unroll
    for (int s = 0; s < NS; ++s) { mref[s] = (NS == 1) ? sinkl2 : -1e30f; lsum[s] = (NS == 1 && hi == 0) ? 1.0f : 0.f; }
    const int koff = hi * 1024 + r32 * 16;
    const int voff = ((lane >> 4) & 1) * 32 + (lane & 3) * 8 + (4 * hi + ((lane & 15) >> 2)) * 64;
    __builtin_amdgcn_s_waitcnt(0x0F70);
    int st = 0;
    for (int t = 0; t < ts.nt; ++t) {
        if (NSTG == 3 && t + 1 < ts.nt) asm volatile("s_waitcnt vmcnt(%0)" ::"n"(NDMA) : "memory"); else asm volatile("s_waitcnt vmcnt(0)" ::: "memory");
        asm volatile("s_waitcnt lgkmcnt(0)" ::: "memory");
        __builtin_amdgcn_s_barrier();
        asm volatile("" ::: "memory");
        if (NSTG == 3) { if (t + 2 < ts.nt) { int k2; const int kr = ts.row(t + 2, k2); const int s2 = (st >= 1) ? st - 1 : 2; issue_tile<NS, ND>(lds + s2 * STAGE, PROJ, kr, kcol, vcol, wave, lane); } }
        else { if (t + 1 < ts.nt) { int k2; const int kr = ts.row(t + 1, k2); issue_tile<NS, ND>(lds + (st ^ 1) * STAGE, PROJ, kr, kcol, vcol, wave, lane); } }
        int kabs0; (void)ts.row(t, kabs0);
        const ATT_LAS unsigned char* Ks = lds + st * STAGE; const ATT_LAS unsigned char* Vs = Ks + NS * 8192;
        u32x4 pf[NS][4];
#pragma unroll
        for (int s = 0; s < NS; ++s) {
            f32x16 p0, p1;
#pragma unroll
            for (int r = 0; r < 16; ++r) { p0[r] = 0.f; p1[r] = 0.f; }
            bf16x8 kA[4], kB[4];
#pragma unroll
            for (int d0 = 0; d0 < 4; ++d0) { kA[d0] = *(const ATT_LAS bf16x8*)(Ks + s * 8192 + koff + d0 * 2048); kB[d0] = *(const ATT_LAS bf16x8*)(Ks + s * 8192 + koff + d0 * 2048 + 512); }
            __builtin_amdgcn_sched_group_barrier(0x100, 8, 0);
#pragma unroll
            for (int d0 = 0; d0 < 4; ++d0) {
                const bf16x8 qv = QLDS ? *(const ATT_LAS bf16x8*)(Qs + (s * 8 + 2 * d0 + hi) * 512 + r32 * 16) : qf[s][d0];
                p0 = __builtin_amdgcn_mfma_f32_32x32x16_bf16(kA[d0], qv, p0, 0, 0, 0);
                p1 = __builtin_amdgcn_mfma_f32_32x32x16_bf16(kB[d0], qv, p1, 0, 0, 0);
            }
            __builtin_amdgcn_sched_group_barrier(0x008, 8, 0);
            if (NS == 1 && kabs0 != NOMASK) {
                const int dq = qabs + r32 - kabs0 - 4 * hi;
#pragma unroll
                for (int r = 0; r < 16; ++r) { const int dk = dq - ((r & 3) + 8 * (r >> 2)); if (dk > 128 || dk < -128) p0[r] = -1e30f; if (dk - 32 > 128 || dk - 32 < -128) p1[r] = -1e30f; }
            }
            float rm; { float a_ = AT_MX3(p0[0], p0[1], p1[0]), b_ = AT_MX3(p0[2], p0[3], p1[1]); a_ = AT_MX3(a_, p1[2], p1[3]);
#pragma unroll
                for (int r = 4; r < 16; r += 4) { a_ = AT_MX3(a_, p0[r], p0[r + 1]); b_ = AT_MX3(b_, p0[r + 2], p0[r + 3]); a_ = AT_MX3(a_, p1[r], p1[r + 1]); b_ = AT_MX3(b_, p1[r + 2], p1[r + 3]); }
                rm = __builtin_fmaxf(a_, b_); }
            rm = swapmax(rm);
            if (__any(rm > mref[s] + THR)) {
                const float mn = fmaxf(mref[s], rm), f = __builtin_amdgcn_exp2f(mref[s] - mn);
                lsum[s] *= f; mref[s] = mn;
                if (hi == 0) wsf[r32] = f;
                float fr[16];
#pragma unroll
                for (int r = 0; r < 16; ++r) fr[r] = wsf[crow(r, hi)];
#pragma unroll
                for (int d = 0; d < ND; ++d)
#pragma unroll
                    for (int r = 0; r < 16; ++r) o[s][d][r] *= fr[r];
            }
            float sacc = lsum[s];
#pragma unroll
            for (int r = 0; r < 16; ++r) { p0[r] = __builtin_amdgcn_exp2f(p0[r] - mref[s]); p1[r] = __builtin_amdgcn_exp2f(p1[r] - mref[s]); sacc = sacc + p0[r]; sacc = sacc + p1[r]; }
            lsum[s] = sacc;
            pf[s][0] = (u32x4){cvtpk(p0[0], p0[1]), cvtpk(p0[2], p0[3]), cvtpk(p0[4], p0[5]), cvtpk(p0[6], p0[7])};
            pf[s][1] = (u32x4){cvtpk(p0[8], p0[9]), cvtpk(p0[10], p0[11]), cvtpk(p0[12], p0[13]), cvtpk(p0[14], p0[15])};
            pf[s][2] = (u32x4){cvtpk(p1[0], p1[1]), cvtpk(p1[2], p1[3]), cvtpk(p1[4], p1[5]), cvtpk(p1[6], p1[7])};
            pf[s][3] = (u32x4){cvtpk(p1[8], p1[9]), cvtpk(p1[10], p1[11]), cvtpk(p1[12], p1[13]), cvtpk(p1[14], p1[15])};
        }
        __builtin_amdgcn_sched_barrier(0);
        pv_step<NS, ND>(o, pf, Vs + voff);
        __builtin_amdgcn_sched_barrier(0);
        st = (NSTG == 3) ? ((st == 2) ? 0 : st + 1) : (st ^ 1);
    }
    unsigned lz_ = 0u; asm volatile("" : "+v"(lz_)); const int lane_e = (int)__builtin_amdgcn_mbcnt_hi(~0u, __builtin_amdgcn_mbcnt_lo(~0u, lz_));
    const int r32e = lane_e & 31, hie = lane_e >> 5;
    float inv[NS][16];
#pragma unroll
    for (int s = 0; s < NS; ++s) {
        const float lt = swapsum(lsum[s]);
        if (hie == 0) wsf[s * 32 + r32e] = 1.0f / lt;
    }
#pragma unroll
    for (int s = 0; s < NS; ++s)
#pragma unroll
        for (int r = 0; r < 16; ++r) inv[s][r] = wsf[s * 32 + crow(r, hie)];
    if (NS == 1) {
        ATT_LAS unsigned char* Ts = lds + NSTG * STAGE + QBYTES + 2048 + wave * (32 * 64 * ND);
#pragma unroll
        for (int r = 0; r < 16; ++r)
#pragma unroll
            for (int d = 0; d < ND; ++d) *(ATT_LAS unsigned short*)(Ts + crow(r, hie) * (64 * ND) + (32 * d + r32e) * 2) = f2bf(o[0][d][r] * inv[0][r]);
        AT_ROWS_OUT(Ts, ND, Y, qrow, ycol, lane_e);
    } else {
        float gsub[ND];
#pragma unroll
        for (int d = 0; d < ND; ++d) gsub[d] = subg[32 * d + r32e] * oml;
#pragma unroll
        for (int r = 0; r < 16; ++r) {
            float ss = 0.f; float ov[ND];
#pragma unroll
            for (int d = 0; d < ND; ++d) { ov[d] = o[0][d][r] * inv[0][r] - lam * (o[NS - 1][d][r] * inv[NS - 1][r]); ss += ov[d] * ov[d]; }
            ss += sx(ss, 1, lane_e); ss += sx(ss, 2, lane_e); ss += sx(ss, 4, lane_e); ss += sx(ss, 8, lane_e); ss += sx(ss, 16, lane_e);
            const float rstd = 1.0f / sqrtf(ss * (1.0f / (32 * ND)) + 1e-6f);
            unsigned short* yp = Y + (size_t)(qrow + crow(r, hie)) * 1024 + ycol + r32e;
#pragma unroll
            for (int d = 0; d < ND; ++d) yp[32 * d] = f2bf(ov[d] * rstd * gsub[d]);
        }
    }
    asm volatile("s_waitcnt lgkmcnt(0)" ::: "memory");
    __builtin_amdgcn_s_barrier();
    asm volatile("" ::: "memory");
}

#define ATT_MX3(a, b, c) __builtin_fmaxf(__builtin_fmaxf((a), (b)), (c))
constexpr int PVDEP = 3;
#define PV_LD1(vf_, Vs_, ND_, i_) do { const int ks_ = (i_) / (ND_), d_ = (i_) % (ND_); const s16x4 lo_ = vtr((Vs_) + d_ * 4096 + ks_ * 1024), hh_ = vtr((Vs_) + d_ * 4096 + ks_ * 1024 + 512); \
        (vf_)[i_] = (bf16x8){lo_[0], lo_[1], lo_[2], lo_[3], hh_[0], hh_[1], hh_[2], hh_[3]}; } while (0)
template <int ND> __device__ __forceinline__ void pv_prefetch(bf16x8 (&vf)[4 * ND], const ATT_LAS unsigned char* Vs) {
#pragma unroll
    for (int i = 0; i < PVDEP; ++i) PV_LD1(vf, Vs, ND, i);
}
template <int NS, int ND> __device__ __forceinline__ void pv_run(f32x16 (&o)[NS][ND], const u32x4 (&pf)[NS][4], bf16x8 (&vf)[4 * ND], const ATT_LAS unsigned char* Vs) {
    constexpr int NF = 4 * ND;
    __builtin_amdgcn_s_setprio(1);
#pragma unroll
    for (int i = 0; i < NF; ++i) {
        if (i + PVDEP < NF) PV_LD1(vf, Vs, ND, i + PVDEP);
#pragma unroll
        for (int s = 0; s < NS; ++s) o[s][i % ND] = __builtin_amdgcn_mfma_f32_32x32x16_bf16(__builtin_bit_cast(bf16x8, pf[s][i / ND]), vf[i], o[s][i % ND], 0, 0, 0);
        if (i + PVDEP < NF) __builtin_amdgcn_sched_group_barrier(0x100, 2, 0);
        __builtin_amdgcn_sched_group_barrier(0x008, NS, 0);
    }
    __builtin_amdgcn_s_setprio(0);
}
template <int NS, int ND> __device__ __forceinline__ void pv_step(f32x16 (&o)[NS][ND], const u32x4 (&pf)[NS][4], const ATT_LAS unsigned char* Vs) {
    bf16x8 vf[4 * ND]; pv_prefetch<ND>(vf, Vs); __builtin_amdgcn_sched_group_barrier(0x100, 2 * PVDEP, 0); pv_run<NS, ND>(o, pf, vf, Vs);
}
template <int NS, int ND>
__device__ __forceinline__ void attn_unit_pp(ATT_LAS unsigned char* lds, const unsigned short* PROJ, unsigned short* Y, const TileSeq ts, int qrow, int qcol, int kcol, int vcol, int ycol,
                                             float lam, const float* subg, float oml, int tid) {
    constexpr int KB = NS * 8192, VB = ND * 4096, OFF_V = 2 * KB, OFF_Q = 2 * KB + 3 * VB, OFF_W = OFF_Q + 8 * NS * 4096;
    const int lane = tid & 63, r32 = lane & 31, hi = lane >> 5; const int wave = __builtin_amdgcn_readfirstlane(tid >> 6); const bool grpB = wave >= 4;
    ATT_LAS unsigned char* Qs = lds + OFF_Q + wave * (NS * 4096);
    ATT_LAS float* wsf = (ATT_LAS float*)(lds + OFF_W) + wave * 64;
#define PP_ISSUE(t_, kslot_, vslot_) do { int ka_; const int kr_ = ts.row((t_), ka_); \
        _Pragma("unroll") for (int i_ = 0; i_ < NS; ++i_) { const int p_ = wave + 8 * i_, s_ = p_ >> 3, c_ = p_ & 7; \
            dma16(PROJ + (size_t)(kr_ + lane) * 2560 + kcol + 64 * s_ + 8 * c_, lds + (kslot_) * KB + s_ * 8192 + c_ * 1024); } \
        _Pragma("unroll") for (int i_ = 0; i_ < ND / 2; ++i_) { const int p_ = wave + 8 * i_, db_ = p_ >> 2, rg_ = p_ & 3; \
            dma16(PROJ + (size_t)(kr_ + 16 * rg_ + (lane >> 2)) * 2560 + vcol + 32 * db_ + 8 * (lane & 3), lds + OFF_V + (vslot_) * VB + (db_ * 4 + rg_) * 1024); } } while (0)
    PP_ISSUE(0, 0, 0);
#pragma unroll
    for (int s = 0; s < NS; ++s)
#pragma unroll
        for (int d0 = 0; d0 < 4; ++d0) *(ATT_LAS bf16x8*)(Qs + (s * 8 + 2 * d0 + hi) * 512 + r32 * 16) = *(const bf16x8*)(PROJ + (size_t)(qrow + r32) * 2560 + qcol + 64 * s + 16 * d0 + 8 * hi);
    f32x16 o[NS][ND];
#pragma unroll
    for (int s = 0; s < NS; ++s)
#pragma unroll
        for (int d = 0; d < ND; ++d)
#pragma unroll
            for (int r = 0; r < 16; ++r) o[s][d][r] = 0.f;
    float mref[NS], lsum[NS];
#pragma unroll
    for (int s = 0; s < NS; ++s) { mref[s] = 0.f; lsum[s] = 0.f; }
    u32x4 pf[NS][4];
#pragma unroll
    for (int s = 0; s < NS; ++s)
#pragma unroll
        for (int k = 0; k < 4; ++k) pf[s][k] = (u32x4){0u, 0u, 0u, 0u};
    const int koff = hi * 1024 + r32 * 16;
    const int voff = ((lane >> 4) & 1) * 32 + (lane & 3) * 8 + (4 * hi + ((lane & 15) >> 2)) * 64;
#define PP_QKSM(Ks_, MID_, PRE_) do { \
        _Pragma("unroll") for (int s = 0; s < NS; ++s) { \
            f32x16 p0, p1; \
            _Pragma("unroll") for (int r = 0; r < 16; ++r) { p0[r] = -mref[s]; p1[r] = -mref[s]; } \
            bf16x8 kA_[4], kB_[4], qq_[4];        \
            _Pragma("unroll") for (int d0 = 0; d0 < 2; ++d0) { \
                kA_[d0] = *(const ATT_LAS bf16x8*)((Ks_) + s * 8192 + koff + d0 * 2048); kB_[d0] = *(const ATT_LAS bf16x8*)((Ks_) + s * 8192 + koff + d0 * 2048 + 512); \
                qq_[d0] = *(const ATT_LAS bf16x8*)(Qs + (s * 8 + 2 * d0 + hi) * 512 + r32 * 16); } \
            __builtin_amdgcn_sched_group_barrier(0x100, 6, 0); \
            _Pragma("unroll") for (int d0 = 0; d0 < 4; ++d0) { \
                if (d0 + 2 < 4) { kA_[d0 + 2] = *(const ATT_LAS bf16x8*)((Ks_) + s * 8192 + koff + (d0 + 2) * 2048); kB_[d0 + 2] = *(const ATT_LAS bf16x8*)((Ks_) + s * 8192 + koff + (d0 + 2) * 2048 + 512); \
                    qq_[d0 + 2] = *(const ATT_LAS bf16x8*)(Qs + (s * 8 + 2 * (d0 + 2) + hi) * 512 + r32 * 16); } \
                p0 = __builtin_amdgcn_mfma_f32_32x32x16_bf16(kA_[d0], qq_[d0], p0, 0, 0, 0); \
                p1 = __builtin_amdgcn_mfma_f32_32x32x16_bf16(kB_[d0], qq_[d0], p1, 0, 0, 0); \
                __builtin_amdgcn_sched_group_barrier(0x008, 2, 0); \
                if (d0 + 2 < 4) __builtin_amdgcn_sched_group_barrier(0x100, 3, 0); } \
            if (s == NS - 1) { PRE_; } \
            float rm; { float a_ = ATT_MX3(p0[0], p0[1], p1[0]), b_ = ATT_MX3(p0[2], p0[3], p1[1]); a_ = ATT_MX3(a_, p1[2], p1[3]); \
                _Pragma("unroll") for (int r = 4; r < 16; r += 4) { a_ = ATT_MX3(a_, p0[r], p0[r + 1]); b_ = ATT_MX3(b_, p0[r + 2], p0[r + 3]); a_ = ATT_MX3(a_, p1[r], p1[r + 1]); b_ = ATT_MX3(b_, p1[r + 2], p1[r + 3]); } \
                rm = __builtin_fmaxf(a_, b_); } \
            rm = swapmax(rm); \
            if (__any(rm > THR || firstf != 0.f)) { const float dl = fmaxf(rm, (firstf != 0.f) ? -100.f : 0.f), f = __builtin_amdgcn_exp2f(-dl); mref[s] += dl; lsum[s] *= f; \
                _Pragma("unroll") for (int r = 0; r < 16; ++r) { p0[r] -= dl; p1[r] -= dl; } \
                if (hi == 0) wsf[r32] = f; \
                _Pragma("unroll") for (int r = 0; r < 16; ++r) { const float fr = wsf[crow(r, hi)]; _Pragma("unroll") for (int d = 0; d < ND; ++d) o[s][d][r] *= fr; } } \
            float sacc = lsum[s];        \
            _Pragma("unroll") for (int r = 0; r < 16; ++r) { p0[r] = __builtin_amdgcn_exp2f(p0[r]); p1[r] = __builtin_amdgcn_exp2f(p1[r]); sacc = sacc + p0[r]; sacc = sacc + p1[r]; } \
            lsum[s] = sacc; \
            pf[s][0] = (u32x4){cvtpk(p0[0], p0[1]), cvtpk(p0[2], p0[3]), cvtpk(p0[4], p0[5]), cvtpk(p0[6], p0[7])}; \
            pf[s][1] = (u32x4){cvtpk(p0[8], p0[9]), cvtpk(p0[10], p0[11]), cvtpk(p0[12], p0[13]), cvtpk(p0[14], p0[15])}; \
            pf[s][2] = (u32x4){cvtpk(p1[0], p1[1]), cvtpk(p1[2], p1[3]), cvtpk(p1[4], p1[5]), cvtpk(p1[6], p1[7])}; \
            pf[s][3] = (u32x4){cvtpk(p1[8], p1[9]), cvtpk(p1[10], p1[11]), cvtpk(p1[12], p1[13]), cvtpk(p1[14], p1[15])}; \
            if (s == 0) { MID_; }        \
        } \
        firstf = 0.f; asm volatile("" : "+v"(firstf)); } while (0)
#define PP_TOP() do { asm volatile("s_waitcnt vmcnt(0)" ::: "memory"); asm volatile("s_waitcnt lgkmcnt(0)" ::: "memory"); __builtin_amdgcn_s_barrier(); asm volatile("" ::: "memory"); } while (0)
    int kst = 0, vst = 0, vprev = 2;
    float firstf = 1.f; asm volatile("" : "+v"(firstf));
    if (!grpB) {
        for (int t = 0; t < ts.nt; ++t) {
            PP_TOP();
            const int vnext = (vst == 2) ? 0 : vst + 1;
            bf16x8 vfa[4 * ND];
            PP_QKSM(lds + kst * KB, if (t + 1 < ts.nt) PP_ISSUE(t + 1, kst ^ 1, vnext), pv_prefetch<ND>(vfa, lds + OFF_V + vst * VB + voff));
            __builtin_amdgcn_sched_barrier(0);
            pv_run<NS, ND>(o, pf, vfa, lds + OFF_V + vst * VB + voff);
            vst = vnext; kst ^= 1;
        }
    } else {
        for (int t = 0; t < ts.nt; ++t) {
            PP_TOP();
            const int vnext = (vst == 2) ? 0 : vst + 1;
            if (t > 0) pv_step<NS, ND>(o, pf, lds + OFF_V + vprev * VB + voff);
            __builtin_amdgcn_sched_barrier(0);
            PP_QKSM(lds + kst * KB, if (t + 1 < ts.nt) PP_ISSUE(t + 1, kst ^ 1, vnext), (void)0);
            vprev = vst; vst = vnext; kst ^= 1;
        }
        pv_step<NS, ND>(o, pf, lds + OFF_V + vprev * VB + voff);
    }
#undef PP_QKSM
#undef PP_TOP
#undef PP_ISSUE
    unsigned lz_ = 0u; asm volatile("" : "+v"(lz_)); const int lane_e = (int)__builtin_amdgcn_mbcnt_hi(~0u, __builtin_amdgcn_mbcnt_lo(~0u, lz_));
    const int r32e = lane_e & 31, hie = lane_e >> 5;
    float inv[NS][16];
#pragma unroll
    for (int s = 0; s < NS; ++s) {
        const float lt = swapsum(lsum[s]);
        if (hie == 0) wsf[s * 32 + r32e] = 1.0f / lt;
    }
#pragma unroll
    for (int s = 0; s < NS; ++s)
#pragma unroll
        for (int r = 0; r < 16; ++r) inv[s][r] = wsf[s * 32 + crow(r, hie)];
    if (NS == 1) {
#pragma unroll
        for (int r = 0; r < 16; ++r) { unsigned short* yp = Y + (size_t)(qrow + crow(r, hie)) * 1024 + ycol + r32e;
#pragma unroll
            for (int d = 0; d < ND; ++d) yp[32 * d] = f2bf(o[0][d][r] * inv[0][r]); }
    } else {
        float gsub[ND];
#pragma unroll
        for (int d = 0; d < ND; ++d) gsub[d] = subg[32 * d + r32e] * oml;
#pragma unroll
        for (int r = 0; r < 16; ++r) {
            float ss = 0.f; float ov[ND];
#pragma unroll
            for (int d = 0; d < ND; ++d) { ov[d] = o[0][d][r] * inv[0][r] - lam * (o[NS - 1][d][r] * inv[NS - 1][r]); ss += ov[d] * ov[d]; }
            ss += sx(ss, 1, lane_e); ss += sx(ss, 2, lane_e); ss += sx(ss, 4, lane_e); ss += sx(ss, 8, lane_e); ss += sx(ss, 16, lane_e);
            const float rstd = 1.0f / sqrtf(ss * (1.0f / (32 * ND)) + 1e-6f);
#pragma unroll
            for (int d = 0; d < ND; ++d) *(ATT_LAS unsigned short*)(Qs + crow(r, hie) * (64 * ND) + (32 * d + r32e) * 2) = f2bf(ov[d] * rstd * gsub[d]);
        }
        AT_ROWS_OUT(Qs, ND, Y, qrow, ycol, lane_e);
    }
    asm volatile("s_waitcnt lgkmcnt(0)" ::: "memory");
    __builtin_amdgcn_s_barrier();
    asm volatile("" ::: "memory");
}
}

namespace lru {
typedef short bf16x8 __attribute__((ext_vector_type(8)));
typedef float f32x4 __attribute__((ext_vector_type(4)));
typedef unsigned u32x4 __attribute__((ext_vector_type(4)));
#define LRU_LAS __attribute__((address_space(3)))
constexpr int LXS = 528, UBS = 528, HSS = 1040;
constexpr int OFF_HS = 0, OFF_LX = 0, OFF_UB = 66560, OFF_HIN = 66560 + 33792;
__device__ __forceinline__ float sxl(float v, int srclane) { return __int_as_float(__builtin_amdgcn_ds_bpermute(srclane << 2, __float_as_int(v))); }
__device__ __forceinline__ float fsig(float x) { return __builtin_amdgcn_rcpf(1.0f + __builtin_amdgcn_exp2f(-1.4426950408889634f * x)); }


template <bool FINAL, int DIR>
__device__ __forceinline__ void lru_scan_part(LRU_LAS unsigned char* lds, const unsigned short* WL, const float* br, const float* bi, const float* lruc, float* SUMM, unsigned* PH, int rowbase, int b, int ck, int blk, int lane, int nt0, int nt1) {
    constexpr int dir = DIR;
    const int c16 = lane & 15, g = lane >> 4;
    const unsigned short* wbase = WL + (size_t)((dir * 4 + blk) * 2) * 4096;
#pragma unroll 2
    for (int nt = nt0; nt < nt1; ++nt) {
        const int ch = blk * 64 + 16 * nt + c16;
        bf16x8 bw[2][2];
#pragma unroll
        for (int gt = 0; gt < 2; ++gt)
#pragma unroll
            for (int ks = 0; ks < 2; ++ks) bw[gt][ks] = *(const bf16x8*)(wbase + (size_t)gt * 4096 + (16 * nt + c16) * 64 + 32 * ks + 8 * g);
        f32x4 ar[4], ai[4];
#pragma unroll
        for (int m = 0; m < 4; ++m) {
            ar[m] = (f32x4){0.f, 0.f, 0.f, 0.f}; ai[m] = ar[m];
#pragma unroll
            for (int ks = 0; ks < 2; ++ks) { const bf16x8 af = *(const LRU_LAS bf16x8*)(lds + OFF_UB + (16 * m + c16) * UBS + (blk * 64 + 32 * ks + 8 * g) * 2);
                ar[m] = __builtin_amdgcn_mfma_f32_16x16x32_bf16(af, bw[0][ks], ar[m], 0, 0, 0); ai[m] = __builtin_amdgcn_mfma_f32_16x16x32_bf16(af, bw[1][ks], ai[m], 0, 0, 0); }
        }
        const float brv = br[dir * 256 + ch], biv = bi[dir * 256 + ch], cdec = lruc[dir * 256 + ch];
        float Pi[4][4], Hi[4][4], Ps[4], Hs[4];
#pragma unroll
        for (int m = 0; m < 4; ++m) {
            float P = 1.f, Hh = 0.f;
#pragma unroll
            for (int ee = 0; ee < 4; ++ee) { constexpr int dummy = 0; const int e = dir ? 3 - ee : ee;
                const int tok = 16 * m + 4 * g + e;
                const float r = fsig(ar[m][e] + brv), iv = fsig(ai[m][e] + biv), la = r * cdec, a = __builtin_amdgcn_exp2f(1.4426950408889634f * la);
                const float uval = __uint_as_float((unsigned)(*(const LRU_LAS unsigned short*)(lds + OFF_UB + tok * UBS + ch * 2)) << 16);
                const float bb = __builtin_amdgcn_sqrtf((1.f - a) * (1.f + a)) * iv * uval;
                Hh = a * Hh + bb; P = P * a; Pi[m][e] = P; Hi[m][e] = Hh; }
            Ps[m] = P; Hs[m] = Hh;
        }
        float Pc = 1.f, Hc = 0.f;
#pragma unroll
        for (int mm = 0; mm < 4; ++mm) { const int m = dir ? 3 - mm : mm;
            float P = Ps[m], Hh = Hs[m];
            {
                const int src = dir ? lane + 16 : lane - 16; const bool ok = dir ? (g <= 2) : (g >= 1);
                const float Pp = sxl(P, src & 63), Hp = sxl(Hh, src & 63); if (ok) { Hh = P * Hp + Hh; P = P * Pp; } }
            {
                const int src = dir ? lane + 32 : lane - 32; const bool ok = dir ? (g <= 1) : (g >= 2);
                const float Pp = sxl(P, src & 63), Hp = sxl(Hh, src & 63); if (ok) { Hh = P * Hp + Hh; P = P * Pp; } }
            float Pe, He;
            { const int src = dir ? lane + 16 : lane - 16; const bool ok = dir ? (g <= 2) : (g >= 1); const float Pp = sxl(P, src & 63), Hp = sxl(Hh, src & 63); Pe = ok ? Pp : 1.f; He = ok ? Hp : 0.f; }
            const int lastl = (dir ? 0 : 48) + c16; const float Pt = sxl(P, lastl), Ht = sxl(Hh, lastl);
            { const float Pb = Pe * Pc, Hb = Pe * Hc + He;
#pragma unroll
              for (int e = 0; e < 4; ++e) { const int tok = 16 * m + 4 * g + e; const float pt = Pi[m][e] * Pb, ht = Pi[m][e] * Hb + Hi[m][e];
                  PH[((size_t)dir * 17408 + rowbase + tok) * 256 + ch] = cvtpk2(pt, ht); } }
            Hc = Pt * Hc + Ht; Pc = Pt * Pc;
        }
        if (!FINAL) { if (g == 0) { float2 o; o.x = Pc; o.y = Hc; *(float2*)(SUMM + ((size_t)(b * 2 + dir) * 68 + ck) * 512 + 2 * ch) = o; } }
    }
}
template <bool FINAL>
__device__ __forceinline__ void lru_unit(LRU_LAS unsigned char* lds, const unsigned short* PROJ, unsigned short* Y, const unsigned short* WL, const float* cw, const float* cb,
                                         const float* br, const float* bi, const float* lruc, float* SUMM, unsigned* PH, int b, int ck, int mode, int tid) {
    const int lane = tid & 63; const int wave = __builtin_amdgcn_readfirstlane(tid >> 6);
    const int seqbase = (ck < 4) ? 16384 + b * 256 : b * 4096, pos0 = (ck < 4) ? 64 * ck : 64 * (ck - 4), len = (ck < 4) ? 256 : 4096;
    {
        u32x4 v[5];
#pragma unroll
        for (int k = 0; k < 5; ++k) { int it = tid + 512 * k; it = (it < 67 * 32) ? it : 67 * 32 - 1; const int i = it >> 5, c = it & 31, p = pos0 - 2 + i; const int pc = p < 0 ? 0 : (p >= len ? len - 1 : p);
            v[k] = *(const u32x4*)(PROJ + (size_t)(seqbase + pc) * 2560 + 8 * c); }
#pragma unroll
        for (int k = 0; k < 5; ++k) { const int it = tid + 512 * k; const int i = it >> 5, c = it & 31, p = pos0 - 2 + i; const bool ok = (p >= 0 && p < len);
            const u32x4 z = {0u, 0u, 0u, 0u}; if (it < 67 * 32) *(LRU_LAS u32x4*)(lds + OFF_LX + i * LXS + c * 16) = ok ? v[k] : z; }
    }
    __syncthreads();
    {
        const int ch2 = tid & 127, tg = tid >> 7; float w0[4], w1[4];
#pragma unroll
        for (int k = 0; k < 4; ++k) { w0[k] = cw[k * 256 + 2 * ch2]; w1[k] = cw[k * 256 + 2 * ch2 + 1]; }
        const float b0 = cb[2 * ch2], b1 = cb[2 * ch2 + 1];
        float x0[4], x1[4];
#pragma unroll
        for (int k = 0; k < 3; ++k) { const unsigned v = *(const LRU_LAS unsigned*)(lds + OFF_LX + (tg * 16 + k) * LXS + ch2 * 4); x0[k + 1] = __uint_as_float(v << 16); x1[k + 1] = __uint_as_float(v & 0xffff0000u); }
#pragma unroll
        for (int t = 0; t < 16; ++t) {
            x0[0] = x0[1]; x0[1] = x0[2]; x0[2] = x0[3]; x1[0] = x1[1]; x1[1] = x1[2]; x1[2] = x1[3];
            const unsigned v = *(const LRU_LAS unsigned*)(lds + OFF_LX + (tg * 16 + t + 3) * LXS + ch2 * 4); x0[3] = __uint_as_float(v << 16); x1[3] = __uint_as_float(v & 0xffff0000u);
            const float u0 = b0 + w0[0] * x0[0] + w0[1] * x0[1] + w0[2] * x0[2] + w0[3] * x0[3], u1 = b1 + w1[0] * x1[0] + w1[1] * x1[1] + w1[2] * x1[2] + w1[3] * x1[3];
            *(LRU_LAS unsigned*)(lds + OFF_UB + (tg * 16 + t) * UBS + ch2 * 4) = cvtpk2(u0, u1);
        }
    }
    __syncthreads();
    { const int dsel = (mode == 0) ? (wave & 1) : (mode - 1), nt0 = (mode == 0) ? 0 : 2 * (wave & 1), nt1 = (mode == 0) ? 4 : nt0 + 2;
      if (dsel) lru_scan_part<FINAL, 1>(lds, WL, br, bi, lruc, SUMM, PH, seqbase + pos0, b, ck, wave >> 1, lane, nt0, nt1);
      else      lru_scan_part<FINAL, 0>(lds, WL, br, bi, lruc, SUMM, PH, seqbase + pos0, b, ck, wave >> 1, lane, nt0, nt1); }
    __syncthreads();
}

__device__ __forceinline__ void lru_final_unit(LRU_LAS unsigned char* lds, const unsigned short* PROJ, unsigned short* Y, const float* SUMM, const unsigned* PH, int b, int ck, int tid) {
    const int seqbase = (ck < 4) ? 16384 + b * 256 : b * 4096, pos0 = (ck < 4) ? 64 * ck : 64 * (ck - 4);
    { const int ch = tid & 255, dir = tid >> 8; const float* sp = SUMM + ((size_t)(b * 2 + dir) * 68) * 512 + 2 * ch;
      const int np = dir ? ((ck < 4) ? 3 - ck : 4 + (67 - ck)) : ck; float hin = 0.f;
      for (int p0 = 0; p0 < np; p0 += 16) { float2 v[16];
#pragma unroll
          for (int j = 0; j < 16; ++j) { int p = p0 + j; p = (p < np) ? p : np - 1; const int c = dir ? ((p < 4) ? 3 - p : 67 - (p - 4)) : p; v[j] = *(const float2*)(sp + (size_t)c * 512); }
#pragma unroll
          for (int j = 0; j < 16; ++j) { const bool ok = (p0 + j) < np; const float px = ok ? v[j].x : 1.f, hy = ok ? v[j].y : 0.f; hin = px * hin + hy; } }
      *(LRU_LAS float*)(lds + tid * 4) = hin; }
    __syncthreads();
    const int tok = tid >> 3, cg = tid & 7; const size_t row = (size_t)seqbase + pos0 + tok;
#pragma unroll
    for (int j = 0; j < 4; ++j) { const int c0 = 32 * cg + 8 * j;
        const u32x4 f0 = *(const u32x4*)(PH + row * 256 + c0), f1 = *(const u32x4*)(PH + row * 256 + c0 + 4), r0 = *(const u32x4*)(PH + ((size_t)17408 + row) * 256 + c0), r1 = *(const u32x4*)(PH + ((size_t)17408 + row) * 256 + c0 + 4);
        const u32x4 lg = *(const u32x4*)(PROJ + row * 2560 + 256 + c0);
        const unsigned ff[8] = {f0.x, f0.y, f0.z, f0.w, f1.x, f1.y, f1.z, f1.w}, rr[8] = {r0.x, r0.y, r0.z, r0.w, r1.x, r1.y, r1.z, r1.w}; const unsigned lgw[4] = {lg.x, lg.y, lg.z, lg.w};
        float y[8];
#pragma unroll
        for (int k = 0; k < 8; ++k) { const float hf = *(const LRU_LAS float*)(lds + (c0 + k) * 4), hr = *(const LRU_LAS float*)(lds + (256 + c0 + k) * 4);
            const float h = (__uint_as_float(ff[k] & 0xffff0000u) + __uint_as_float(ff[k] << 16) * hf) + (__uint_as_float(rr[k] & 0xffff0000u) + __uint_as_float(rr[k] << 16) * hr);
            const float g = (k & 1) ? __uint_as_float(lgw[k >> 1] & 0xffff0000u) : __uint_as_float(lgw[k >> 1] << 16); y[k] = h * g; }
        u32x4 o; o.x = cvtpk2(y[0], y[1]); o.y = cvtpk2(y[2], y[3]); o.z = cvtpk2(y[4], y[5]); o.w = cvtpk2(y[6], y[7]);
        *(u32x4*)(Y + row * 1024 + c0) = o; }
    __syncthreads();
}
}

#include <utility>
constexpr int NWAVES = 8;
constexpr int RING_OFF = 0, RING_BYTES = 150528;
constexpr int LDSCTL_OFF = RING_BYTES, MISC_OFF = LDSCTL_OFF + 320;
constexpr int LDS_BYTES = 155648;
constexpr int CW_BAR = 4096;
constexpr int MAX_LAUNCHES = 16;
static_assert((CW_BAR + MAX_LAUNCHES * XCD_BAR_WORDS) * 4 <= (int)(1u << 20), "CTL words inside the memset region");

constexpr int PH_PRO = 0, PH_PRO2 = 1, PH_L0 = 2, PH_PER_LAYER = 11, PH_FINAL = PH_L0 + 2 * PH_PER_LAYER, NPH = PH_FINAL + 1;
constexpr int EPI_OFF = LDSCTL_OFF + 1024;

#ifndef MK_REPEAT_PH
#define MK_REPEAT_PH (-1)
#endif
struct Args { const float* in[24]; float* out; unsigned char* ws; int ph_lo, ph_hi, li, rep; };

__device__ __forceinline__ float shfl_xor_l(float v, int mask, int lane) { return __int_as_float(__builtin_amdgcn_ds_bpermute((lane ^ mask) << 2, __float_as_int(v))); }
__device__ __forceinline__ float wave_sum(float v, int lane) {
#pragma unroll
    for (int o = 1; o < 64; o <<= 1) v += shfl_xor_l(v, o, lane);
    return v;
}
__device__ __forceinline__ unsigned pk2(float lo, float hi) { return cvtpk2(lo, hi); }

__device__ __forceinline__ void p0_transpose_item(const float* W, int K, int N, bf16_t* WT, int kind, LAS float* scr, int item, int lane) {
    const int nblk = N / 64, kb = item / nblk, nb = item % nblk, k0 = 64 * kb, n0 = 64 * nb;
    const int rr = lane >> 4, cq = lane & 15;
    f32x4 v[16];
#pragma unroll
    for (int i = 0; i < 16; ++i) v[i] = *(const f32x4*)(W + (size_t)(k0 + 4 * i + rr) * N + n0 + 4 * cq);
#pragma unroll
    for (int i = 0; i < 16; ++i) { LAS float* p = scr + (4 * i + rr) * 65 + 4 * cq; p[0] = v[i].x; p[1] = v[i].y; p[2] = v[i].z; p[3] = v[i].w; }
    LDS_WAIT(); asm volatile("" ::: "memory");
    const int c = lane & 7;
#pragma unroll
    for (int j = 0; j < 8; ++j) { const int n = (lane >> 3) + 8 * j; const LAS float* s = scr + (8 * c) * 65 + n;
        v4u o; o.x = pk2(s[0 * 65], s[1 * 65]); o.y = pk2(s[2 * 65], s[3 * 65]); o.z = pk2(s[4 * 65], s[5 * 65]); o.w = pk2(s[6 * 65], s[7 * 65]);
        *(GAS v4u*)(WT + (size_t)dest_row(kind, n0 + n) * K + k0 + 8 * c) = o; }
    LDS_WAIT(); asm volatile("" ::: "memory");
}

struct ConvDesc { const float* W; bf16_t* WT; int K, N, kind, item; };
__device__ __forceinline__ void p0_load(const ConvDesc& d, f32x4 (&v)[16], int lane) {
    const int nblk = d.N / 64, kb = d.item / nblk, nb = d.item % nblk, k0 = 64 * kb, n0 = 64 * nb; const int rr = lane >> 4, cq = lane & 15;
#pragma unroll
    for (int i = 0; i < 16; ++i) v[i] = *(const f32x4*)(d.W + (size_t)(k0 + 4 * i + rr) * d.N + n0 + 4 * cq);
}
__device__ __forceinline__ void p0_finish(const ConvDesc& d, const f32x4 (&v)[16], LAS float* scr, int lane) {
    const int nblk = d.N / 64, kb = d.item / nblk, nb = d.item % nblk, k0 = 64 * kb, n0 = 64 * nb; const int rr = lane >> 4, cq = lane & 15;
#pragma unroll
    for (int i = 0; i < 16; ++i) { LAS float* p = scr + (4 * i + rr) * 65 + 4 * cq; p[0] = v[i].x; p[1] = v[i].y; p[2] = v[i].z; p[3] = v[i].w; }
    LDS_WAIT(); asm volatile("" ::: "memory");
    const int c = lane & 7;
#pragma unroll
    for (int j = 0; j < 8; ++j) { const int n = (lane >> 3) + 8 * j; const LAS float* s = scr + (8 * c) * 65 + n;
        v4u o; o.x = pk2(s[0 * 65], s[1 * 65]); o.y = pk2(s[2 * 65], s[3 * 65]); o.z = pk2(s[4 * 65], s[5 * 65]); o.w = pk2(s[6 * 65], s[7 * 65]);
        *(GAS v4u*)(d.WT + (size_t)dest_row(d.kind, n0 + n) * d.K + k0 + 8 * c) = o; }
    LDS_WAIT(); asm volatile("" ::: "memory");
}

__device__ __forceinline__ void norm_row(const float* src, const float* g, const float* shift, const float* scale, bf16_t* orow, int lane) {
    const f32x4* xr = (const f32x4*)src + lane; f32x4 v[4]; float s = 0.f;
#pragma unroll
    for (int j = 0; j < 4; ++j) { v[j] = xr[64 * j]; s += (v[j].x * v[j].x + v[j].y * v[j].y) + (v[j].z * v[j].z + v[j].w * v[j].w); }
    const float rstd = 1.0f / sqrtf(wave_sum(s, lane) * (1.0f / D) + 1e-6f);
    unsigned long long* o8 = (unsigned long long*)orow + lane;
#pragma unroll
    for (int j = 0; j < 4; ++j) { const int c0 = (lane + 64 * j) * 4; const f32x4 gg = *(const f32x4*)(g + c0), sc = *(const f32x4*)(scale + c0), sh = *(const f32x4*)(shift + c0);
        const f32x4 y = v[j] * rstd * gg * (sc + 1.0f) + sh;
        o8[64 * j] = (unsigned long long)pk2(y.x, y.y) | ((unsigned long long)pk2(y.z, y.w) << 32); }
}

__device__ __forceinline__ void norm_regs(const f32x4 (&v)[4], const float* g, const float* shift, const float* scale, bf16_t* orow, int lane) {
    float s = 0.f;
#pragma unroll
    for (int j = 0; j < 4; ++j) s += (v[j].x * v[j].x + v[j].y * v[j].y) + (v[j].z * v[j].z + v[j].w * v[j].w);
    const float rstd = 1.0f / sqrtf(wave_sum(s, lane) * (1.0f / D) + 1e-6f);
    unsigned long long* o8 = (unsigned long long*)orow + lane;
#pragma unroll
    for (int j = 0; j < 4; ++j) { const int c0 = (lane + 64 * j) * 4; const f32x4 gg = *(const f32x4*)(g + c0), sc = *(const f32x4*)(scale + c0), sh = *(const f32x4*)(shift + c0);
        const f32x4 y = v[j] * rstd * gg * (sc + 1.0f) + sh;
        o8[64 * j] = (unsigned long long)pk2(y.x, y.y) | ((unsigned long long)pk2(y.z, y.w) << 32); }
}

constexpr int I_GU = (D / 64) * (2 * DFF / 64), I_DN = (DFF / 64) * (D / 64), I_IN = (D / 64) * (NIN / 64), I_OUT = (D / 64) * (D / 64);
constexpr int R_GU1 = 0, R_GU2 = I_GU, R_DN1 = 2 * I_GU, R_DN2 = R_DN1 + I_DN, R_IN = R_DN2 + I_DN, R_OUT = R_IN + I_IN, I_LAYER = R_OUT + I_OUT;

struct KCtx { LAS unsigned char* lds; unsigned char* ws; float* out; const __attribute__((address_space(4))) unsigned long long* kin; int wave0, vcu, G, bx, ph_lo, ph_end; XcdBarrier bar; };
#define tidq() ({ int tq_ = tid; asm volatile("" : "+v"(tq_)); tq_; })
#define KIN(i) ((const float*)(const GAS float*)(kin[(i) + kz]))
template <int PHI> __device__ __forceinline__ void run_phase(const KCtx& kc) {
    if (PHI < kc.ph_lo || PHI >= kc.ph_end) return;
    constexpr int ph = (MK_REPEAT_PH >= 0 && PHI > MK_REPEAT_PH) ? PHI - 1 : PHI;
    LAS unsigned char* lds = kc.lds; unsigned char* ws = kc.ws; const __attribute__((address_space(4))) unsigned long long* kin = kc.kin;
    const int wave0 = kc.wave0, vcu = kc.vcu, G = kc.G, bx = kc.bx, NGW = kc.G * NWAVES;
    struct { float* out; } args; args.out = kc.out;
        unsigned lz = 0u; asm volatile("" : "+v"(lz)); const int lane_o = (int)__builtin_amdgcn_mbcnt_hi(~0u, __builtin_amdgcn_mbcnt_lo(~0u, lz));
        const int lane = lane_o, wave = wave0, tid = wave0 * 64 + lane_o, gw = vcu * NWAVES + wave;
        int kz = 0; asm volatile("" : "+s"(kz));
        unsigned long long wsi = (unsigned long long)ws; asm volatile("" : "+s"(wsi)); unsigned char* wsp = (unsigned char*)(GAS unsigned char*)wsi;
        float* MOD = (float*)(wsp + WS_MOD); Tab* T = (Tab*)(wsp + WS_TAB); bf16_t* W = (bf16_t*)(wsp + WS_W); float* H = (float*)(wsp + WS_H);
        bf16_t* HB = (bf16_t*)(wsp + WS_R); bf16_t* PROJ = (bf16_t*)(wsp + WS_R + R_PROJ); bf16_t* Y = (bf16_t*)(wsp + WS_R + R_Y);
        unsigned long long outi = (unsigned long long)args.out; asm volatile("" : "+s"(outi)); float* outp = (float*)(GAS float*)outi; bf16_t* XN = (bf16_t*)outp;
        auto conv_desc = [&](int l, int r) -> ConvDesc {
            const float* src; int K_, N_, kind; size_t off;
            if (r < R_GU2)      {             src = KIN(7)  + (size_t)l * D * 2 * DFF; K_ = D;   N_ = 2 * DFF; kind = 1; off = OFF_GU1; }
            else if (r < R_DN1) { r -= R_GU2; src = KIN(9)  + (size_t)l * D * 2 * DFF; K_ = D;   N_ = 2 * DFF; kind = 1; off = OFF_GU2; }
            else if (r < R_DN2) { r -= R_DN1; src = KIN(8)  + (size_t)l * DFF * D;     K_ = DFF; N_ = D;       kind = 0; off = OFF_DN1; }
            else if (r < R_IN)  { r -= R_DN2; src = KIN(10) + (size_t)l * DFF * D;     K_ = DFF; N_ = D;       kind = 0; off = OFF_DN2; }
            else if (r < R_OUT) { r -= R_IN;  src = KIN(11) + (size_t)l * D * NIN;     K_ = D;   N_ = NIN;     kind = 2; off = OFF_IN; }
            else                { r -= R_OUT; src = KIN(12) + (size_t)l * D * D;       K_ = D;   N_ = D;       kind = 0; off = OFF_OUT; }
            return ConvDesc{src, W + (size_t)l * W_LAYER + off, K_, N_, kind, r};
        };
        auto conv_range = [&](int l, int r0, int r1, int nb, int bi) {
            const int step = nb * NWAVES; int r = r0 + bi * NWAVES + wave; if (r >= r1) return;
            LAS float* scr = (LAS float*)(lds + wave * 16896);
            ConvDesc dc = conv_desc(l, r); f32x4 vc[16]; p0_load(dc, vc, lane);
            for (;;) {
                const int rn = r + step; const bool hn = rn < r1; ConvDesc dn = conv_desc(l, hn ? rn : r); f32x4 vn[16];
                if (hn) p0_load(dn, vn, lane);
                p0_finish(dc, vc, scr, lane);
                if (!hn) break;
#pragma unroll
                for (int i = 0; i < 16; ++i) vc[i] = vn[i];
                dc = dn; r = rn;
            }
        };
        auto sw_rows = [&](int l, int k, int nb, int bi) {
            const int N = (k == 1) ? NIN : 2 * DFF; const bf16_t* Wt = W + (size_t)l * W_LAYER + (k == 0 ? OFF_GU1 : k == 1 ? OFF_IN : OFF_GU2); float* SWp = (float*)(wsp + WS_SW) + (size_t)(l * 3 + k) * 4 * 5632;
            f32x4 sh[4][4];
#pragma unroll
            for (int b = 0; b < 4; ++b)
#pragma unroll
                for (int j = 0; j < 4; ++j) sh[b][j] = *(const f32x4*)(MOD + (size_t)l * 5 * NMODW + (size_t)b * NMODW + (3 * k) * D + lane * 16 + 4 * j);
            const int stride = nb * NWAVES;
            for (int p0 = bi * NWAVES + wave; p0 < N; p0 += 4 * stride) {
                int pr[4]; bool hv[4]; v4u w0[4], w1[4];
#pragma unroll
                for (int q = 0; q < 4; ++q) { pr[q] = p0 + q * stride; hv[q] = pr[q] < N; const int pc = hv[q] ? pr[q] : p0; w0[q] = *(const v4u*)(Wt + (size_t)pc * D + lane * 16); w1[q] = *(const v4u*)(Wt + (size_t)pc * D + lane * 16 + 8); }
                float a[4][4];
#pragma unroll
                for (int q = 0; q < 4; ++q) { const unsigned ww[8] = {w0[q].x, w0[q].y, w0[q].z, w0[q].w, w1[q].x, w1[q].y, w1[q].z, w1[q].w};
#pragma unroll
                    for (int b = 0; b < 4; ++b) a[q][b] = 0.f;
#pragma unroll
                    for (int j = 0; j < 8; ++j) { const float lo = __uint_as_float(ww[j] << 16), hi = __uint_as_float(ww[j] & 0xffff0000u);
#pragma unroll
                        for (int b = 0; b < 4; ++b) a[q][b] += lo * sh[b][j >> 1][(2 * j) & 3] + hi * sh[b][j >> 1][(2 * j + 1) & 3]; } }
#pragma unroll
                for (int q = 0; q < 4; ++q)
#pragma unroll
                    for (int b = 0; b < 4; ++b) { const float sa = wave_sum(a[q][b], lane); if (lane == 0 && hv[q]) SWp[(size_t)b * 5632 + pr[q]] = sa; }
            }
        };
        if (ph == PH_PRO) {
            const float* cc = KIN(1); const float* c_ctx = KIN(3); const float* w_ada = KIN(4); const float* b_ada = KIN(5);
            LAS float* sc = (LAS float*)lds; LAS float* red = (LAS float*)(lds + 20480);
            for (int i = tid; i < 5 * 1024; i += NWAVES * 64) { const int b = i >> 10, k = i & 1023; const float v = b < 4 ? cc[b * 1024 + k] : c_ctx[k]; sc[i] = v / (1.f + __expf(-v)); }
            __syncthreads();
            for (int item = bx; item < 288; item += G) {
                const int l = item / 144, col0 = (item % 144) * 64, cq = tid & 15, kg = tid >> 4;
                const float* wp = w_ada + (size_t)l * D * NMODW + (size_t)(kg * 32) * NMODW + col0 + 4 * cq;
                f32x4 a0 = {0, 0, 0, 0}, a1 = a0, a2 = a0, a3 = a0, a4 = a0;
#pragma unroll 8
                for (int k = 0; k < 32; ++k) { const f32x4 wv = *(const f32x4*)(wp + (size_t)k * NMODW); const int kk = kg * 32 + k;
                    a0 += wv * sc[kk]; a1 += wv * sc[1024 + kk]; a2 += wv * sc[2048 + kk]; a3 += wv * sc[3072 + kk]; a4 += wv * sc[4096 + kk]; }
                LAS f32x4* rp = (LAS f32x4*)(red + (size_t)kg * 320 + 4 * cq);
                rp[0] = a0; rp[16] = a1; rp[32] = a2; rp[48] = a3; rp[64] = a4;
                __syncthreads();
                if (tid < 320) { float s = 0.f;
#pragma unroll 8
                    for (int k = 0; k < 32; ++k) s += red[k * 320 + tid];
                    const int b = tid >> 6, cidx = tid & 63; MOD[(size_t)l * 5 * NMODW + (size_t)b * NMODW + col0 + cidx] = s + b_ada[l * NMODW + col0 + cidx]; }
                __syncthreads();
            }
            for (int i = (bx * NWAVES * 64 + tid); i < 2 * 65536; i += G * NWAVES * 64) {
                const int l = i >> 16, r = i & 65535; const int c = r & 63, d = (r >> 6) & 63, ri = (r >> 12) & 1, blk = (r >> 13) & 3, dir = r >> 15;
                const float* src = (ri ? KIN(17) : KIN(15)) + (size_t)l * 32768;
                W[(size_t)l * W_LAYER + OFF_LRU + r] = f2bf(src[((size_t)(dir * 4 + blk) * 64 + c) * 64 + d]);
            }
            conv_range(0, R_GU1, R_GU2, G, bx);
        } else if (ph == PH_FINAL) {
            const float* fg = KIN(23); const bf16_t* Hb = (const bf16_t*)(wsp + WS_H);
            for (int row = gw; row < ML; row += NGW) {
                const v4u w0 = *(const v4u*)(Hb + (size_t)row * D + lane * 16), w1 = *(const v4u*)(Hb + (size_t)row * D + lane * 16 + 8);
                const unsigned ww[8] = {w0.x, w0.y, w0.z, w0.w, w1.x, w1.y, w1.z, w1.w}; float v[16]; float sq = 0.f;
#pragma unroll
                for (int j = 0; j < 8; ++j) { v[2 * j] = __uint_as_float(ww[j] << 16); v[2 * j + 1] = __uint_as_float(ww[j] & 0xffff0000u); sq += v[2 * j] * v[2 * j] + v[2 * j + 1] * v[2 * j + 1]; }
                const float rstd = 1.0f / sqrtf(wave_sum(sq, lane) * (1.0f / D) + 1e-6f);
#pragma unroll
                for (int j = 0; j < 4; ++j) { const f32x4 g4 = *(const f32x4*)(fg + lane * 16 + 4 * j); f32x4 o; o.x = v[4 * j] * rstd * g4.x; o.y = v[4 * j + 1] * rstd * g4.y; o.z = v[4 * j + 2] * rstd * g4.z; o.w = v[4 * j + 3] * rstd * g4.w;
                    *(f32x4*)(outp + (size_t)row * D + lane * 16 + 4 * j) = o; }
            }
        } else if (ph == PH_PRO2) {
            float* GS = (float*)(wsp + WS_GS); float* SW = (float*)(wsp + WS_SW); float* SSQ = (float*)(wsp + WS_SSQ);
            for (int i = bx * NWAVES * 64 + tid; i < 2 * 3 * 5 * D; i += G * NWAVES * 64) { const int c = i & 1023, b = (i >> 10) % 5, k = ((i >> 10) / 5) % 3, l = (i >> 10) / 15;
                GS[i] = KIN(6)[(size_t)(l * 3 + k) * D + c] * (1.0f + MOD[(size_t)l * 5 * NMODW + (size_t)b * NMODW + (3 * k + 1) * D + c]); }
            sw_rows(0, 0, G, bx);
            { const float* x = KIN(0); const float* ctxp = KIN(2); const float* g0 = KIN(6);
              for (int row = gw; row < M; row += NGW) {
                if (row < ML) { const int b = row >> 12; const float* sc = MOD + (size_t)b * NMODW + D; const f32x4* xr = (const f32x4*)(x + (size_t)row * D) + lane; float s = 0.f;
                    unsigned long long* o8 = (unsigned long long*)(XN + (size_t)row * D) + lane; unsigned long long* h8 = (unsigned long long*)((bf16_t*)H + (size_t)row * D) + lane;
#pragma unroll
                    for (int j = 0; j < 4; ++j) { const f32x4 v = xr[64 * j]; const int c0 = (lane + 64 * j) * 4; s += (v.x * v.x + v.y * v.y) + (v.z * v.z + v.w * v.w);
                        h8[64 * j] = (unsigned long long)pk2(v.x, v.y) | ((unsigned long long)pk2(v.z, v.w) << 32);
                        const f32x4 y = v * *(const f32x4*)(g0 + c0) * (*(const f32x4*)(sc + c0) + 1.0f); o8[64 * j] = (unsigned long long)pk2(y.x, y.y) | ((unsigned long long)pk2(y.z, y.w) << 32); }
                    s = wave_sum(s, lane); if (lane == 0) *(f32x4*)(SSQ + (size_t)row * 4) = (f32x4){s, 0.f, 0.f, 0.f};
                } else { const float* src = ctxp + (size_t)(row - ML) * D; const float* shift = MOD + (size_t)4 * NMODW;
                    norm_row(src, g0, shift, shift + D, XN + (size_t)row * D, lane);
#pragma unroll
                    for (int j = 0; j < 4; ++j) ((f32x4*)(H + (size_t)row * D))[lane + 64 * j] = ((const f32x4*)src)[lane + 64 * j]; }
              } }
        } else {
            const int l = (ph - PH_L0) / PH_PER_LAYER, ty = (ph - PH_L0) % PH_PER_LAYER; const bool last = (l == 1);
            if (last && (ty == T_NC2 || ty == T_NC3)) return;
            bf16_t* Wl = W + (size_t)l * W_LAYER; const float* MODl = MOD + (size_t)l * 5 * NMODW;
            float* SSQ = (float*)(wsp + WS_SSQ); const float* GS = (const float*)(wsp + WS_GS); const float* SW = (const float*)(wsp + WS_SW);
            const int mrows = (last && ty >= T_OUT) ? ML : M;
            if (ty == T_NC1 || ty == T_NC2 || ty == T_NC3) {
                const int kk = (ty == T_NC1) ? 1 : (ty == T_NC2) ? 2 : 0, ln = (ty == T_NC3) ? l + 1 : l;
                const float* shift = MOD + (size_t)ln * 5 * NMODW + (size_t)4 * NMODW + (3 * kk) * D; const float* ngn = KIN(6) + (size_t)(ln * 3 + kk) * D;
                const int ns = (ty == T_NC2) ? 4 : 11;
                for (int row = ML + gw; row < M; row += NGW) {
                    f32x4* hr = (f32x4*)(H + (size_t)row * D) + lane; f32x4 v[4];
#pragma unroll
                    for (int j = 0; j < 4; ++j) v[j] = hr[64 * j];
#define NC_ALL(cnt_) do { typedef unsigned u32x2n __attribute__((ext_vector_type(2))); u32x2n w_[cnt_][4]; \
                        _Pragma("unroll") for (int q_ = 0; q_ < (cnt_); ++q_) { const u32x2n* sp = (const u32x2n*)((const bf16_t*)pg8::slab_ptr(wsi, outi, q_) + (size_t)(row - ML) * D) + lane; \
                            _Pragma("unroll") for (int j = 0; j < 4; ++j) w_[q_][j] = sp[64 * j]; } \
                        _Pragma("unroll") for (int q_ = 0; q_ < (cnt_); ++q_) _Pragma("unroll") for (int j = 0; j < 4; ++j) { const u32x2n t_ = w_[q_][j]; \
                            v[j] += (f32x4){__uint_as_float(t_.x << 16), __uint_as_float(t_.x & 0xffff0000u), __uint_as_float(t_.y << 16), __uint_as_float(t_.y & 0xffff0000u)}; } } while (0)
                    if (ns == 11) { NC_ALL(11); } else { NC_ALL(4); }
#undef NC_ALL
                    norm_regs(v, ngn, shift, shift + D, XN + (size_t)row * D, lane);
#pragma unroll
                    for (int j = 0; j < 4; ++j) hr[64 * j] = v[j];
                }
            } else if (ty == T_GU1 || ty == T_GU2) {
                pg8::Gemm g{XN, Wl + (ty == T_GU1 ? OFF_GU1 : OFF_GU2), mrows, 2 * DFF, D, D}; pg8::StaticOrder So; So.init(mrows, 2 * DFF, G, bx);
                pg8::EpiGU E{pg8::EpiCtx{wsi, outi, kin, l, ty}};
                pg8::gemm_phase<pg8::EpiGU, pg8::StaticOrder, true, true>(lds + RING_OFF, g, So, E, tidq());
                if (bx >= 216) {
                    const int bi = bx - 216;
                    if (l == 0 && ty == T_GU1) { conv_range(0, R_DN1, R_DN2, 40, bi); conv_range(0, R_IN, R_OUT, 40, bi); }
                    if (l == 0 && ty == T_GU2) { conv_range(1, R_GU1, R_GU2, 40, bi); }
                    if (l == 1 && ty == T_GU1) { conv_range(1, R_DN1, R_DN2, 40, bi); conv_range(1, R_IN, R_OUT, 40, bi); }
                }
            } else if (ty == T_DN1 || ty == T_DN2 || ty == T_OUT) {
                const bf16_t* A = (ty == T_OUT) ? Y : HB; const int K = (ty == T_OUT) ? D : DFF;
                const bf16_t* Bt = Wl + (ty == T_DN1 ? OFF_DN1 : ty == T_DN2 ? OFF_DN2 : OFF_OUT);
                {
                    pg8::Gemm g{A, Bt, M, D, K, K}; pg8::DnOrder So; So.so.init(ML, D, G, bx); So.ns = (mrows == M) ? K / 256 : 0; So.KS = 256; So.ntl = K / 64;
                    pg8::EpiDn E{pg8::EpiRes{pg8::EpiCtx{wsi, outi, kin, l, ty}, (LAS float*)(lds + EPI_OFF)}, pg8::EpiResAt{pg8::EpiCtx{wsi, outi, kin, l, ty}}};
                    pg8::gemm_phase<pg8::EpiDn, pg8::DnOrder, true, true>(lds + RING_OFF, g, So, E, tidq());
                }
                if (ty == T_DN1 && bx < 80)  { sw_rows(l, 1, 80, bx); conv_range(l, R_OUT, I_LAYER, 80, bx); }
                if (l == 0 && ty == T_OUT && bx < 192) { sw_rows(0, 2, 192, bx); sw_rows(1, 2, 192, bx); }
                if (l == 0 && ty == T_DN2 && bx < 80)  { sw_rows(1, 0, 80, bx); }
            } else if (ty == T_IN) {
                pg8::Gemm g{XN, Wl + OFF_IN, M, NIN, D, D}; pg8::StaticOrder So; So.init(M, NIN, G, bx);
                { const int tq = tidq(); *(LAS f32x4*)(lds + RING_OFF + pg8::STAGE_BYTES + 10240 + tq * 16) = *((const f32x4*)T->cosv + tq); asm volatile("s_waitcnt vmcnt(0) lgkmcnt(0)" ::: "memory"); __syncthreads(); }
                pg8::EpiIN E{pg8::EpiCtx{wsi, outi, kin, l, ty}, (const LAS float*)(lds + RING_OFF + pg8::STAGE_BYTES + 10240)};
                pg8::gemm_phase<pg8::EpiIN, pg8::StaticOrder, true, true>(lds + RING_OFF, g, So, E, tidq());
                if (bx >= 168) {
                    const int bi = bx - 168; if (l == 0) conv_range(0, R_GU2, R_DN1, 88, bi); conv_range(l, R_DN2, R_IN, 88, bi);
                }
            } else if (ty == T_M2) {
                return;
            } else if (ty == T_M1) {
              const float* cw = KIN(13) + (size_t)l * 1024; const float* cb = KIN(14) + (size_t)l * 256; const float* lbr = KIN(16) + (size_t)l * 512; const float* lbi = KIN(18) + (size_t)l * 512;
              float* SUMM = (float*)(wsp + WS_SUMM); unsigned* PH = (unsigned*)outp;
              gu32* lcnt = (gu32*)(wsp + WS_CTL) + 2048 + 64 * l;
              { unsigned nloc = 0;
                for (int u = vcu; u < 288; u += G) { int b, ck, mode; if (u < 256) { b = u >> 6; ck = 4 + (u & 63); mode = 0; } else { const int i2 = u - 256; b = i2 >> 3; ck = (i2 >> 1) & 3; mode = 1 + (i2 & 1); }
                    int tq = tid; asm volatile("" : "+v"(tq));
                    lru::lru_unit<false>(lds, PROJ, Y, Wl + OFF_LRU, cw, cb, lbr, lbi, T->lruc + l * 512, SUMM, PH, b, ck, mode, tq); ++nloc; }
                asm volatile("s_waitcnt vmcnt(0)" ::: "memory"); __syncthreads();
                if (wave == 0 && lane == 0) { __builtin_amdgcn_fence(__ATOMIC_RELEASE, "agent"); asm volatile("s_waitcnt vmcnt(0)" ::: "memory"); __hip_atomic_fetch_add(lcnt, nloc, __ATOMIC_RELAXED, __HIP_MEMORY_SCOPE_AGENT); }
              }
              {
                const float* sink = KIN(20) + l * 4;
                {
                    const int idx = vcu, b = idx >> 6, kvh = (idx >> 5) & 1, q0 = 128 * (idx & 31), g = wave >> 2, head = 2 * kvh + g;
                    att::TileSeq ts; ts.b = b; ts.mode = 1; ts.q0 = q0; ts.jlo = (q0 == 0) ? 2 : 0; { const int jh = (S - q0 + 128) / 64; ts.nt = 4 + ((jh < 6) ? jh : 6) - ts.jlo; }
                    { int tq = tid; asm volatile("" : "+v"(tq)); att::attn_unit<1, 2, 3, false>(lds, PROJ, Y, ts, b * S + q0 + 32 * (wave & 3), 512 + 64 * head, 768 + 64 * kvh, 896 + 64 * kvh, 256 + 64 * head, q0 + 32 * (wave & 3), sink[head] * LOG2E, 0.f, nullptr, 0.f, tq); }
                }
                if (!last && vcu >= 32 && vcu < 48) {
                    const int idx = vcu - 32, b = idx >> 2, kvh = (idx >> 1) & 1, qb = idx & 1, g = wave >> 2, head = 2 * kvh + g;
                    att::TileSeq ts; ts.b = b; ts.mode = 2; ts.q0 = 0; ts.jlo = 0; ts.nt = 4;
                    { int tq = tid; asm volatile("" : "+v"(tq)); att::attn_unit<1, 2, 3, false>(lds, PROJ, Y, ts, ML + b * LC + 128 * qb + 32 * (wave & 3), 512 + 64 * head, 768 + 64 * kvh, 896 + 64 * kvh, 256 + 64 * head, 0, sink[head] * LOG2E, 0.f, nullptr, 0.f, tq); }
                }
              }
              {
                const float lam = T->lam[l]; const float* subg = KIN(22) + l * 128; const float oml = 1.0f - (0.8f - 0.6f * __expf(-0.3f * (float)l));
                {
                    const int idx = vcu, b = idx >> 6, h = (idx >> 4) & 3, q0 = 256 * (idx & 15);
                    att::TileSeq ts; ts.b = b; ts.mode = 0; ts.q0 = 0; ts.jlo = 0; ts.nt = 68;
                    { int tq = tid; asm volatile("" : "+v"(tq)); att::attn_unit_pp<2, 4>(lds, PROJ, Y, ts, b * S + q0 + 32 * wave, 1024 + 128 * h, 1536 + 128 * h, 2048 + 128 * h, 512 + 128 * h, lam, subg, oml, tq); }
                }
                if (!last && vcu >= 48 && vcu < 64) {
                    const int idx = vcu - 48, b = idx >> 2, h = idx & 3;
                    att::TileSeq ts; ts.b = b; ts.mode = 2; ts.q0 = 0; ts.jlo = 0; ts.nt = 4;
                    { int tq = tid; asm volatile("" : "+v"(tq)); att::attn_unit_pp<2, 4>(lds, PROJ, Y, ts, ML + b * LC + 32 * wave, 1024 + 128 * h, 1536 + 128 * h, 2048 + 128 * h, 512 + 128 * h, lam, subg, oml, tq); }
                }
              }
              if (wave == 0) {
                  if (lane == 0) { unsigned spins = 0; while (__hip_atomic_load(lcnt, __ATOMIC_RELAXED, __HIP_MEMORY_SCOPE_AGENT) < 288u) { __builtin_amdgcn_s_sleep(8); if (++spins > (1u << 20)) break; } }
                  __builtin_amdgcn_fence(__ATOMIC_ACQUIRE, "agent"); asm volatile("s_waitcnt vmcnt(0)" ::: "memory");
              }
              __syncthreads();
              for (int u = vcu; u < 272; u += G) { const int b = u / 68, ck = u % 68; int tq = tid; asm volatile("" : "+v"(tq));
                  if (!(last && ck < 4)) lru::lru_final_unit(lds, PROJ, Y, SUMM, PH, b, ck, tq); }
              if (l == 0 && vcu >= 64) { __syncthreads(); conv_range(1, R_GU2, R_DN1, 192, vcu - 64); }
            }
        }
    if (PHI + 1 < kc.ph_end) xcd_barrier(kc.bar);
}
template <int... I> __device__ __forceinline__ void run_all(const KCtx& kc, std::integer_sequence<int, I...>) { (run_phase<I>(kc), ...); }

__global__ void __launch_bounds__(NWAVES * 64, 2) mk_fwd(Args args) {
    extern __shared__ __attribute__((aligned(16))) unsigned char lds_raw[];
    LAS unsigned char* lds = (LAS unsigned char*)lds_raw;
    volatile LAS unsigned* MISC = (volatile LAS unsigned*)(lds + MISC_OFF);
    const int tid0 = threadIdx.x; const int wave0 = __builtin_amdgcn_readfirstlane(tid0 >> 6);
    const int G = gridDim.x; const int bx = blockIdx.x; const int vcu = (G % 8 == 0) ? (bx % 8) * (G / 8) + bx / 8 : bx;
    unsigned char* ws = args.ws;
    gu32* ctl = (gu32*)(ws + WS_CTL);
    for (int u = tid0; u < (LDS_BYTES - LDSCTL_OFF) / 4; u += NWAVES * 64) ((LAS unsigned*)(lds + LDSCTL_OFF))[u] = 0u;
    __syncthreads();
    XcdBarrier bar = xcd_barrier_post((unsigned*)(ctl + CW_BAR) + args.li * XCD_BAR_WORDS, MISC + 8);

    const __attribute__((address_space(4))) unsigned long long* kin = (const __attribute__((address_space(4))) unsigned long long*)__builtin_amdgcn_kernarg_segment_ptr();
    const int NGW = G * NWAVES;

    if (args.ph_lo == PH_PRO && bx == 0) {
                const int tid = tid0; Tab* T = (Tab*)(ws + WS_TAB); const int kz = 0;
                const float* lru_lambda = KIN(19); const float* diff_lambda = KIN(21);
                for (int i = tid; i < 1024; i += NWAVES * 64) {
                    const int pos = i >> 4, f = i & 15;
                    const double q[4] = {1.0, 0.5623413251903491, 0.31622776601683794, 0.1778279410038923};
                    double inv = (f & 3) == 0 ? q[0] : (f & 3) == 1 ? q[1] : (f & 3) == 2 ? q[2] : q[3]; for (int j = 0; j < (f >> 2); ++j) inv *= 0.1;
                    const float ang = (float)pos * (float)inv;
                    double xx = (double)ang; const double TWO_PI = 6.283185307179586476925287, PI = 3.141592653589793238462643;
                    const double k = rint(xx * 0.15915494309189533577); double r = xx - k * TWO_PI;
                    double sgn = 1.0; if (r > PI * 0.5) { r = PI - r; sgn = -1.0; } else if (r < -PI * 0.5) { r = -PI - r; sgn = -1.0; }
                    const double r2 = r * r;
                    double ss = -1.9572941063391263e-20; ss = ss * r2 + 8.2206352466243295e-18; ss = ss * r2 - 2.8114572543455206e-15; ss = ss * r2 + 7.6471637318198164e-13; ss = ss * r2 - 1.6059043836821613e-10;
                    ss = ss * r2 + 2.5052108385441720e-08; ss = ss * r2 - 2.7557319223985893e-06; ss = ss * r2 + 1.9841269841269841e-04; ss = ss * r2 - 8.3333333333333332e-03; ss = ss * r2 + 1.6666666666666666e-01; ss = r - r * r2 * ss;
                    double cs = 4.1103176233121648e-19; cs = cs * r2 - 1.5619206968586226e-16; cs = cs * r2 + 4.7794773323873853e-14; cs = cs * r2 - 1.1470745597729725e-11; cs = cs * r2 + 2.0876756987868100e-09;
                    cs = cs * r2 - 2.7557319223985888e-07; cs = cs * r2 + 2.4801587301587302e-05; cs = cs * r2 - 1.3888888888888889e-03; cs = cs * r2 + 4.1666666666666664e-02; cs = cs * r2 - 0.5; cs = cs * r2 + 1.0;
                    T->cosv[i] = (float)(sgn * cs); T->sinv[i] = (float)ss;
                    T->lruc[i] = -8.0f * log1pf(expf(-lru_lambda[i]));
                }
                if (tid < 2) { const float* dl = diff_lambda + tid * 256; float s0 = 0.f, s1 = 0.f;
                    for (int j = 0; j < 64; ++j) { s0 += dl[j] * dl[64 + j]; s1 += dl[128 + j] * dl[192 + j]; }
                    T->lam[tid] = expf(s0) - expf(s1) + (0.8f - 0.6f * expf(-0.3f * (float)tid)); }
            }
    KCtx kc; kc.lds = lds; kc.ws = ws; kc.out = args.out; kc.kin = kin; kc.wave0 = wave0; kc.vcu = vcu; kc.G = G; kc.bx = bx; kc.ph_lo = args.ph_lo; kc.ph_end = args.ph_hi + (MK_REPEAT_PH >= 0 ? 1 : 0); kc.bar = bar;
    run_all(kc, std::make_integer_sequence<int, NPH + (MK_REPEAT_PH >= 0 ? 1 : 0)>{});
}

static void launch_seg(const Args& base, int lo, int hi, int& li, int grid, hipStream_t stream) {
    Args a = base; a.ph_lo = lo; a.ph_hi = hi; a.li = li++; a.rep = 0;
    void* kargs[] = {&a};
    hipError_t e = hipLaunchCooperativeKernel((const void*)mk_fwd, dim3(grid), dim3(NWAVES * 64), kargs, LDS_BYTES, stream);
    if (e != hipSuccess) fprintf(stderr, "kernel_launch: cooperative launch failed: %s (grid %d)\n", hipGetErrorString(e), grid);
}
extern "C" void kernel_launch(void* const* d_in, const int* in_sizes, int n_in, void* d_out, int out_size, void* d_ws, size_t ws_size, hipStream_t stream) {
    static int grid = 0;
    if (grid == 0) {
        if (n_in != 24 || ws_size < WS_END || out_size != ML * D) { fprintf(stderr, "kernel_launch: unexpected shapes (n_in %d, ws %zu need %zu, out %d)\n", n_in, ws_size, (size_t)WS_END, out_size); grid = -1; return; }
        int dev = 0, cus = 0, per_cu = 0;
        hipGetDevice(&dev); hipDeviceGetAttribute(&cus, hipDeviceAttributeMultiprocessorCount, dev);
        if (hipFuncSetAttribute((const void*)mk_fwd, hipFuncAttributeMaxDynamicSharedMemorySize, LDS_BYTES) != hipSuccess) { fprintf(stderr, "kernel_launch: hipFuncSetAttribute failed\n"); grid = -1; return; }
        if (hipOccupancyMaxActiveBlocksPerMultiprocessor(&per_cu, (const void*)mk_fwd, NWAVES * 64, LDS_BYTES) != hipSuccess || per_cu < 1) { fprintf(stderr, "kernel_launch: occupancy query says %d blocks per CU\n", per_cu); grid = -1; return; }
        (void)hipGetLastError();
        if (cus != 256) { fprintf(stderr, "kernel_launch: built for a 256-CU device (one workgroup per CU; the unit maps of the mixer phases assume it); found %d CUs; nothing launched\n", cus); grid = -1; return; }
        grid = cus;
    }
    if (grid < 0) return;
    hipMemsetAsync((char*)d_ws + WS_CTL, 0, 1u << 20, stream);
    Args a{};
    for (int i = 0; i < 24; ++i) a.in[i] = (const float*)d_in[i];
    a.out = (float*)d_out; a.ws = (unsigned char*)d_ws;
    int li = 0, lo = 0;
    launch_seg(a, lo, NPH, li, grid, stream);
}
```

```cpp
#include <hip/hip_runtime.h>
#include <cstdio>
#include <cstdint>
#include <cmath>

typedef unsigned short bf16_t;
constexpr int D = 1024, NB = 4, S = 4096, LC = 256, DFF = 2816, NIN = 2560;
constexpr int ML = NB * S, MC = NB * LC, M = ML + MC;
constexpr int NMODW = 9 * D;
constexpr float C2 = 0.125f * 1.4426950408889634f;
constexpr float LOG2E = 1.4426950408889634f;

__device__ __forceinline__ float bf2f(bf16_t v) { return __uint_as_float((unsigned)v << 16); }
__device__ __forceinline__ bf16_t f2bf(float f) { unsigned u = __float_as_uint(f); return (bf16_t)((u + 0x7fffu + ((u >> 16) & 1u)) >> 16); }
__device__ __forceinline__ unsigned cvtpk2(float lo, float hi) { typedef float f2_t __attribute__((ext_vector_type(2))); typedef __bf16 b2_t __attribute__((ext_vector_type(2))); f2_t v = {lo, hi}; b2_t b = __builtin_convertvector(v, b2_t); return __builtin_bit_cast(unsigned, b); }
__device__ __forceinline__ int bidx(int row) { return row < ML ? (row >> 12) : 4; }
__device__ __forceinline__ float silu_f(float x) { return x / (1.f + __expf(-x)); }
__device__ __forceinline__ float gelu_tanh_f(float x) { const float u = 0.7978845608028654f * (x + 0.044715f * x * x * x); return 0.5f * x * (1.f + tanhf(u)); }
__device__ __forceinline__ float sigmoid_f(float x) { return 1.f / (1.f + __expf(-x)); }

constexpr size_t MiB = 1u << 20;
constexpr size_t WS_CTL = 0;
constexpr size_t WS_MOD = 1 * MiB;
constexpr size_t WS_TAB = WS_MOD + 512 * 1024;
constexpr size_t WS_SUMM = 2 * MiB;
constexpr size_t WS_SSQ = 3 * MiB + 256 * 1024;
constexpr size_t WS_GS = 3 * MiB + 512 * 1024;
constexpr size_t WS_SW = 3 * MiB + 768 * 1024;
constexpr size_t WS_W = 5 * MiB;
constexpr size_t W_GU = (size_t)2 * DFF * D, W_DN = (size_t)D * DFF, W_IN = (size_t)NIN * D, W_OUT = (size_t)D * D, W_LRU = 2 * 4 * 2 * 64 * 64;
constexpr size_t W_LAYER = 2 * W_GU + 2 * W_DN + W_IN + W_OUT + W_LRU;
constexpr size_t OFF_GU1 = 0, OFF_DN1 = OFF_GU1 + W_GU, OFF_IN = OFF_DN1 + W_DN, OFF_OUT = OFF_IN + W_IN, OFF_GU2 = OFF_OUT + W_OUT, OFF_DN2 = OFF_GU2 + W_GU, OFF_LRU = OFF_DN2 + W_DN;
constexpr size_t WS_H = WS_W + ((2 * W_LAYER * 2 + MiB - 1) / MiB) * MiB;
constexpr size_t WS_R = WS_H + (((size_t)M * D * 4 + MiB - 1) / MiB) * MiB;
constexpr size_t R_PROJ = 0, R_Y = (size_t)M * NIN * 2, R_BYTES = (size_t)M * NIN * 2 + (size_t)M * D * 2;
constexpr size_t WS_NAIVE = WS_R + ((R_BYTES + MiB - 1) / MiB) * MiB;
constexpr size_t WS_END = WS_NAIVE + (size_t)M * 256 * 4;

enum { T_GU1 = 0, T_DN1, T_NC1, T_IN, T_M1, T_M2, T_OUT, T_NC2, T_GU2, T_DN2, T_NC3 };
struct Tab { float cosv[1024]; float sinv[1024]; float lam[2]; float pad[2]; float lruc[2 * 2 * 256]; };

__device__ __forceinline__ int dest_row(int kind, int n) {
    if (kind == 1) { const int s = n >= DFF ? 1 : 0, j = n - s * DFF; return 256 * (j >> 7) + 128 * s + (j & 127); }
    if (kind == 2) {
        const int pn = n >> 8, w = n & 255;
        if (pn == 2 || (pn >= 4 && pn <= 7)) { const int hh = w >> 6, x = (w >> 5) & 1, i = w & 31; return 256 * pn + 128 * x + 32 * hh + i; }
        if (pn == 3) { if (w < 128) { const int hh = w >> 6, x = (w >> 5) & 1, i = w & 31; return 768 + 128 * x + 32 * hh + i; } const int v = w - 128; return 768 + 128 * (v >> 6) + 64 + (v & 63); }
        return n;
    }
    return n;
}
namespace pg8 {
#define PG8_LAS __attribute__((address_space(3)))
typedef unsigned short bf16_t;
typedef short bf16x8 __attribute__((ext_vector_type(8)));
typedef float f32x4 __attribute__((ext_vector_type(4)));
typedef unsigned u32x4 __attribute__((ext_vector_type(4)));
constexpr int BM = 256, BK = 64, HALF = 128, HTB = HALF * BK * 2  , STAGE_BYTES = 8 * HTB, NXCD = 8, WGM = 4;

__host__ __device__ __forceinline__ int lds_byte(int r, int c) { const int st = (r >> 4) * 2 + (c >> 5), rr = r & 15, cc = c & 31, ob = rr * 64 + cc * 2; return st * 1024 + (ob ^ (((ob >> 9) & 1) << 5)); }
__host__ __device__ __forceinline__ void stage_rc(int b, int& R, int& C) { const int st = b / 1024, sb = b % 1024, swz = sb ^ (((sb >> 9) & 1) << 5); R = (st >> 1) * 16 + swz / 64; C = (st & 1) * 32 + (swz % 64) / 2; }
__host__ __device__ __forceinline__ int perm32(int rho) { const int n = rho >> 4, i = rho & 15; return 8 * (i >> 2) + 4 * n + (i & 3); }

struct Unit { int pm, pn, ko, nt; };
struct Gemm { const bf16_t* A; const bf16_t* Bt; int M, N, K, ld; };

struct StaticOrder {
    static constexpr bool VAR_NT = false;
    int nM, nN, nwg, G, c;
    __host__ __device__ void init(int M, int N, int G_, int c_) { nM = M / BM; nN = N / BM; nwg = nM * nN; G = G_; c = c_; }
    __host__ __device__ bool next(int i, Unit& u) const {
        const long L = (long)i * G + c; if (L >= nwg) return false;
        int wgid = (int)L; { const int q = nwg / NXCD, r = nwg % NXCD, xcd = wgid % NXCD, off = wgid / NXCD; wgid = (xcd < r ? xcd * (q + 1) : r * (q + 1) + (xcd - r) * q) + off; }
        const int nig = WGM * nN, gid = wgid / nig, fm = gid * WGM, gsz = (nM - fm) < WGM ? (nM - fm) : WGM;
        u.pm = fm + ((wgid % nig) % gsz); u.pn = (wgid % nig) / gsz; u.ko = 0; return true;
    }
    __device__ __forceinline__ void a_ready(const Unit&) const {}
    __device__ __forceinline__ void done(const Unit&) const {}
};
struct SliceOrder {
    static constexpr bool VAR_NT = false;
    int ns, KS, G, c;
    __host__ __device__ bool next(int i, Unit& u) const { const int L = i * G + (G - 1 - c); if (L >= 16 * ns) return false; const int tile = L / ns, sl = L % ns; u.pm = 64 + (tile >> 2); u.pn = tile & 3; u.ko = sl * KS; return true; }
    __device__ __forceinline__ void a_ready(const Unit&) const {}
    __device__ __forceinline__ void done(const Unit&) const {}
};

struct DnOrder {
    static constexpr bool VAR_NT = true;
    StaticOrder so; int ns, KS, ntl;
    __host__ __device__ bool next(int i, Unit& u) const {
        const int Ls = so.G - 1 - so.c; const bool hs = Ls < 16 * ns;
        if (hs && i == 0) { const int tile = Ls / ns, sl = Ls % ns; u.pm = 64 + (tile >> 2); u.pn = tile & 3; u.ko = sl * KS; u.nt = KS / BK; return true; }
        if (!so.next(hs ? i - 1 : i, u)) return false;
        u.nt = ntl; return true;
    }
    __device__ __forceinline__ void a_ready(const Unit&) const {}
    __device__ __forceinline__ void done(const Unit&) const {}
};

__device__ __forceinline__ unsigned cvt_pk_bf16(float lo, float hi) { unsigned r; asm volatile("v_cvt_pk_bf16_f32 %0, %1, %2" : "=v"(r) : "v"(lo), "v"(hi)); return r; }
__device__ __forceinline__ float fast_silu(float x) { return x * __builtin_amdgcn_rcpf(1.0f + __builtin_amdgcn_exp2f(-1.4426950408889634f * x)); }
__device__ __forceinline__ float fast_gelu_tanh(float x) {
    const float u = 0.7978845608028654f * (x + 0.044715f * x * x * x);
    return x * __builtin_amdgcn_rcpf(1.0f + __builtin_amdgcn_exp2f(-2.0f * 1.4426950408889634f * u));
}
struct EpiCtx { unsigned long long wsi, outi; const __attribute__((address_space(4))) unsigned long long* kin; int l, ty; };
#define PG8_GAS __attribute__((address_space(1)))
__device__ __forceinline__ unsigned char* ectx_ws(const EpiCtx& c) { return (unsigned char*)(PG8_GAS unsigned char*)c.wsi; }
__device__ __forceinline__ const float* ectx_in(const EpiCtx& c, int i) { return (const float*)(const PG8_GAS float*)(c.kin[i]); }
__device__ __forceinline__ int hw_lane() { unsigned z = 0u; asm volatile("" : "+v"(z)); return (int)__builtin_amdgcn_mbcnt_hi(~0u, __builtin_amdgcn_mbcnt_lo(~0u, z)); }
__device__ __forceinline__ void epi_stage_params(PG8_LAS unsigned char* par, const float* ssq_tile, const float* sw_tile, int wid, int) {
    const int lane = hw_lane();
    if (wid < 4) __builtin_amdgcn_global_load_lds((const unsigned*)(ssq_tile + (size_t)(wid * 64 + lane) * 4), (PG8_LAS unsigned*)(par + wid * 1024), 16, 0, 0);
    else if (wid == 4) __builtin_amdgcn_global_load_lds((const unsigned*)(sw_tile + lane * 4), (PG8_LAS unsigned*)(par + 4096), 16, 0, 0);
}
struct EpiGU {
    static constexpr bool PERM = true, AFTER_DRAIN = false, PARAMS = true, LOOSE = true; static constexpr int NST = 8;
    EpiCtx cx;
    __device__ __forceinline__ void stage(PG8_LAS unsigned char* par, const Unit& u, int wid, int lane) const {
        if (u.pm >= 64) return;
        unsigned char* wsb = ectx_ws(cx);
        epi_stage_params(par, (const float*)(wsb + WS_SSQ) + (size_t)u.pm * BM * 4, (const float*)(wsb + WS_SW) + (size_t)(cx.l * 3 + (cx.ty == T_GU1 ? 0 : 2)) * 4 * 5632 + (size_t)(u.pm >> 4) * 5632 + u.pn * 256, wid, lane);
    }
    __device__ __forceinline__ void operator()(const f32x4 (&acc)[2][2][4][2], const Unit& u, int wr, int wc, int fr_in, int fq_in, const PG8_LAS unsigned char* par) const {
        const int ln_ = hw_lane(); const int fr = ln_ & 15, fq = ln_ >> 4;
        unsigned char* wsb = ectx_ws(cx); bf16_t* HB = (bf16_t*)(wsb + WS_R);
        const int row0 = u.pm * BM + wr * 64 + fr, col0 = u.pn * 128 + wc * 32 + 8 * fq; const bool lat = u.pm < 64;
        float rs[2][4];
        { f32x4 sq[2][4];
#pragma unroll
          for (int ai = 0; ai < 2; ++ai)
#pragma unroll
            for (int m = 0; m < 4; ++m) sq[ai][m] = *(const PG8_LAS f32x4*)(par + (wr * 64 + fr + ai * HALF + m * 16) * 16);
#pragma unroll
          for (int ai = 0; ai < 2; ++ai)
#pragma unroll
            for (int m = 0; m < 4; ++m) rs[ai][m] = lat ? __builtin_amdgcn_rsqf(((sq[ai][m][0] + sq[ai][m][1]) + (sq[ai][m][2] + sq[ai][m][3])) * (1.0f / 1024.0f) + 1e-6f) : 1.0f; }
        f32x4 sv[2][2];
#pragma unroll
        for (int bj = 0; bj < 2; ++bj)
#pragma unroll
            for (int n = 0; n < 2; ++n) { const f32x4 t = *(const PG8_LAS f32x4*)(par + 4096 + (bj * 128 + wc * 32 + 8 * fq + 4 * n) * 4); sv[bj][n] = lat ? t : (f32x4){0.f, 0.f, 0.f, 0.f}; }
        f32x4 svg[2], svu[2];
#pragma unroll
        for (int n = 0; n < 2; ++n) { svg[n] = sv[0][n] * -1.4426950408889634f; svu[n] = sv[1][n] * -0.6931471805599453f; }
#pragma unroll
        for (int ai = 0; ai < 2; ++ai)
#pragma unroll
            for (int m = 0; m < 4; ++m) {
                const int row = row0 + ai * HALF + m * 16; bf16_t* rowp = HB + (size_t)row * 2816 + col0; const float rstd = rs[ai][m];
                const float rg = rstd * -1.4426950408889634f, ru = rstd * -0.6931471805599453f;
                const f32x4 g0 = acc[ai][0][m][0] * rg + svg[0], g1 = acc[ai][0][m][1] * rg + svg[1], u0 = acc[ai][1][m][0] * ru + svu[0], u1 = acc[ai][1][m][1] * ru + svu[1];
#define GU_F(g_, u_) (((g_) * (u_)) * __builtin_amdgcn_rcpf(1.0f + __builtin_amdgcn_exp2f(g_)))
                u32x4 w;
                w.x = cvt_pk_bf16(GU_F(g0[0], u0[0]), GU_F(g0[1], u0[1])); w.y = cvt_pk_bf16(GU_F(g0[2], u0[2]), GU_F(g0[3], u0[3]));
                w.z = cvt_pk_bf16(GU_F(g1[0], u1[0]), GU_F(g1[1], u1[1])); w.w = cvt_pk_bf16(GU_F(g1[2], u1[2]), GU_F(g1[3], u1[3]));
#undef GU_F
                *(u32x4*)rowp = w;
            }
    }
};
struct EpiRes {
    static constexpr bool PERM = false, AFTER_DRAIN = false, PARAMS = false, LOOSE = false;
    EpiCtx cx; PG8_LAS float* part;
    __device__ __forceinline__ void operator()(const f32x4 (&acc)[2][2][4][2], const Unit& u, int wr, int wc, int fr_in, int fq_in, const PG8_LAS unsigned char* par) const {
        const int ln_ = hw_lane(); const int fr = ln_ & 15, fq = ln_ >> 4;
        unsigned char* wsb = ectx_ws(cx); const int l = cx.l, ty = cx.ty;
        const bool hasAN = !(l == 1 && ty == T_DN2);
        const float coef = (ty == T_OUT) ? 1.0f : 0.5f;
        float* ssq = (float*)(wsb + WS_SSQ);
        const int pc0 = wc * 32 + 4 * fq;
        const size_t tb = ((size_t)u.pm * BM) * 1024 + (size_t)u.pn * BM;
        char* hbt = (char*)((bf16_t*)(wsb + WS_H) + tb); char* ant = (char*)((bf16_t*)(PG8_GAS bf16_t*)cx.outi + tb);
        const int r0 = wr * 64 + fr;
        unsigned ro[2][4];
#pragma unroll
        for (int ai = 0; ai < 2; ++ai)
#pragma unroll
            for (int m = 0; m < 4; ++m) ro[ai][m] = (unsigned)((r0 + ai * HALF + m * 16) * 1024 + pc0) * 2u;
        typedef unsigned u32x2w __attribute__((ext_vector_type(2)));
        u32x2w hq[2][4][2][2];
#pragma unroll
        for (int ai = 0; ai < 2; ++ai)
#pragma unroll
            for (int m = 0; m < 4; ++m)
#pragma unroll
                for (int bj = 0; bj < 2; ++bj)
#pragma unroll
                    for (int n = 0; n < 2; ++n) hq[ai][m][bj][n] = *(const u32x2w*)(hbt + (size_t)ro[ai][m] + (bj * HALF + n * 16) * 2);
#pragma unroll
        for (int ai = 0; ai < 2; ++ai)
#pragma unroll
            for (int m = 0; m < 4; ++m) { float sqr = 0.f;
#pragma unroll
                for (int bj = 0; bj < 2; ++bj)
#pragma unroll
                    for (int n = 0; n < 2; ++n) { const int co = bj * HALF + n * 16;
                        const f32x4 gv = *(const PG8_LAS f32x4*)(par + (pc0 + co) * 4) * coef;
                        const u32x2w hw0 = hq[ai][m][bj][n]; const f32x4 hin = (f32x4){__uint_as_float(hw0.x << 16), __uint_as_float(hw0.x & 0xffff0000u), __uint_as_float(hw0.y << 16), __uint_as_float(hw0.y & 0xffff0000u)};
                        const f32x4 v = hin + gv * acc[ai][bj][m][n];
                        { u32x2w hw; hw.x = cvt_pk_bf16(v[0], v[1]); hw.y = cvt_pk_bf16(v[2], v[3]); *(u32x2w*)(hbt + (size_t)ro[ai][m] + co * 2) = hw; }
                        if (hasAN) { const f32x4 gs = *(const PG8_LAS f32x4*)(par + 1024 + (pc0 + co) * 4);
                            sqr += (v[0] * v[0] + v[1] * v[1]) + (v[2] * v[2] + v[3] * v[3]); const f32x4 a = v * gs;
                            u32x2w w; w.x = cvt_pk_bf16(a[0], a[1]); w.y = cvt_pk_bf16(a[2], a[3]);
                            *(u32x2w*)(ant + (size_t)ro[ai][m] + co * 2) = w; } }
                if (hasAN) { float s = sqr;
                    s += __int_as_float(__builtin_amdgcn_ds_bpermute((ln_ ^ 16) << 2, __float_as_int(s))); s += __int_as_float(__builtin_amdgcn_ds_bpermute((ln_ ^ 32) << 2, __float_as_int(s)));
                    if (fq == 0) part[(ai * HALF + wr * 64 + m * 16 + fr) * 4 + wc] = s; }
            }
        if (hasAN) { const int lane = ln_;
            asm volatile("s_waitcnt lgkmcnt(0)" ::: "memory"); __builtin_amdgcn_s_barrier(); asm volatile("" ::: "memory");
            const int tid = (wr * 4 + wc) * 64 + lane;
            if (tid < 256) { const f32x4 p = *(const PG8_LAS f32x4*)(part + tid * 4); ssq[(size_t)(u.pm * BM + tid) * 4 + u.pn] = (p[0] + p[1]) + (p[2] + p[3]); }
        }
    }
};
__device__ __forceinline__ float* slab_ptr(unsigned long long wsi, unsigned long long outi, int s) {
    return s < 7 ? (float*)(PG8_GAS float*)(outi + ((size_t)34 << 20) + ((size_t)s << 22)) : (float*)(PG8_GAS float*)(wsi + WS_R + ((size_t)94 << 20) + ((size_t)(s - 7) << 22)); }
struct EpiResAt {
    static constexpr bool PERM = false, AFTER_DRAIN = false, PARAMS = false, LOOSE = false;
    EpiCtx cx;
    __device__ __forceinline__ void operator()(const f32x4 (&acc)[2][2][4][2], const Unit& u, int wr, int wc, int fr_in, int fq_in, const PG8_LAS unsigned char* par) const {
        const int ln_ = hw_lane(); const int fr = ln_ & 15, fq = ln_ >> 4;
        const int ty = cx.ty;
        const float coef = (ty == T_OUT) ? 1.0f : 0.5f;
        float* dst = (float*)((bf16_t*)slab_ptr(cx.wsi, cx.outi, u.ko >> 8) + (size_t)(u.pm - 64) * BM * 1024); const int col0 = u.pn * BM + wc * 32 + 4 * fq, r0 = wr * 64 + fr;
        f32x4 gv[2][2];
#pragma unroll
        for (int bj = 0; bj < 2; ++bj)
#pragma unroll
            for (int n = 0; n < 2; ++n) gv[bj][n] = *(const PG8_LAS f32x4*)(par + (wc * 32 + 4 * fq + bj * HALF + n * 16) * 4) * coef;
#pragma unroll
        for (int ai = 0; ai < 2; ++ai)
#pragma unroll
            for (int m = 0; m < 4; ++m) { bf16_t* rp = (bf16_t*)dst + (size_t)(r0 + ai * HALF + m * 16) * 1024 + col0;
#pragma unroll
                for (int bj = 0; bj < 2; ++bj)
#pragma unroll
                    for (int n = 0; n < 2; ++n) { const f32x4 t = gv[bj][n] * acc[ai][bj][m][n]; typedef unsigned u32x2s __attribute__((ext_vector_type(2)));
                        u32x2s w; w.x = cvt_pk_bf16(t[0], t[1]); w.y = cvt_pk_bf16(t[2], t[3]); *(u32x2s*)(rp + bj * HALF + n * 16) = w; } }
    }
};
struct EpiDn {
    static constexpr bool PERM = false, AFTER_DRAIN = false, PARAMS = true, LOOSE = true; static constexpr int NST = 32;
    EpiRes r; EpiResAt a;
    __device__ __forceinline__ void stage(PG8_LAS unsigned char* par, const Unit& u, int wid, int) const {
        if (wid >= 2) return;
        const int l = r.cx.l, ty = r.cx.ty; unsigned char* wsb = ectx_ws(r.cx); const int lane = hw_lane(); const bool ctxu = u.pm >= 64; const int b = ctxu ? 4 : (u.pm >> 4);
        if (wid == 0) { const int gk = (ty == T_DN1) ? 2 : (ty == T_OUT) ? 5 : 8;
            __builtin_amdgcn_global_load_lds((const unsigned*)((const float*)(wsb + WS_MOD) + (size_t)l * 5 * 9216 + (size_t)b * 9216 + gk * 1024 + u.pn * BM + lane * 4), (PG8_LAS unsigned*)par, 16, 0, 0); }
        else if (!ctxu && !(l == 1 && ty == T_DN2)) {
            const float* gsn = (const float*)(wsb + WS_GS) + (size_t)((ty == T_DN2 ? l + 1 : l) * 3 + (ty == T_DN1 ? 1 : ty == T_OUT ? 2 : 0)) * 5 * 1024;
            __builtin_amdgcn_global_load_lds((const unsigned*)(gsn + (size_t)b * 1024 + u.pn * BM + lane * 4), (PG8_LAS unsigned*)(par + 1024), 16, 0, 0); }
    }
    __device__ __forceinline__ void operator()(const f32x4 (&acc)[2][2][4][2], const Unit& u, int wr, int wc, int fr_in, int fq_in, const PG8_LAS unsigned char* par) const { if (u.pm >= 64) a(acc, u, wr, wc, fr_in, fq_in, par); else r(acc, u, wr, wc, fr_in, fq_in, par); }
};
struct EpiIN {
    static constexpr bool PERM = true, AFTER_DRAIN = false, PARAMS = true, LOOSE = true; static constexpr int NST = 16;
    EpiCtx cx; const PG8_LAS float* ropet;
    __device__ __forceinline__ void stage(PG8_LAS unsigned char* par, const Unit& u, int wid, int lane) const {
        if (u.pm >= 64) return;
        unsigned char* wsb = ectx_ws(cx);
        epi_stage_params(par, (const float*)(wsb + WS_SSQ) + (size_t)u.pm * BM * 4, (const float*)(wsb + WS_SW) + (size_t)(cx.l * 3 + 1) * 4 * 5632 + (size_t)(u.pm >> 4) * 5632 + u.pn * 256, wid, lane);
    }
    __device__ __forceinline__ void operator()(const f32x4 (&acc)[2][2][4][2], const Unit& u, int wr, int wc, int fr_in, int fq_in, const PG8_LAS unsigned char* par) const {
        const int ln_ = hw_lane(); const int fr = ln_ & 15, fq = ln_ >> 4;
        unsigned char* wsb = ectx_ws(cx); bf16_t* PROJ = (bf16_t*)(wsb + WS_R + R_PROJ); const PG8_LAS float* cosv = ropet; const PG8_LAS float* sinv = ropet + 1024;
        const int pn = u.pn; const int row0 = u.pm * BM + wr * 64 + fr; const int j0 = wc * 32 + 8 * fq;
        const bool rope_tile = (pn == 2) || (pn >= 4 && pn <= 7) || (pn == 3 && wc < 2);
        const float C2q = 0.125f * 1.4426950408889634f;
        const bool lat = u.pm < 64;
        f32x4 sv[2][2];
#pragma unroll
        for (int bj = 0; bj < 2; ++bj)
#pragma unroll
            for (int n = 0; n < 2; ++n) { const f32x4 t = *(const PG8_LAS f32x4*)(par + 4096 + (bj * 128 + j0 + 4 * n) * 4); sv[bj][n] = lat ? t : (f32x4){0.f, 0.f, 0.f, 0.f}; }
        float rs[2][4];
        { f32x4 sq[2][4];
#pragma unroll
          for (int ai = 0; ai < 2; ++ai)
#pragma unroll
            for (int m = 0; m < 4; ++m) sq[ai][m] = *(const PG8_LAS f32x4*)(par + (wr * 64 + fr + ai * HALF + m * 16) * 16);
#pragma unroll
          for (int ai = 0; ai < 2; ++ai)
#pragma unroll
            for (int m = 0; m < 4; ++m) rs[ai][m] = lat ? __builtin_amdgcn_rsqf(((sq[ai][m][0] + sq[ai][m][1]) + (sq[ai][m][2] + sq[ai][m][3])) * (1.0f / 1024.0f) + 1e-6f) : 1.0f; }
#define EPIIN_SV
#define EPIIN_RSTD(row_) const float rstd = rs[ai][m];
        if (!rope_tile) {
            int cbase[2];
            if (pn == 3) { cbase[0] = 896 + (j0 - 64); cbase[1] = 896 + 64 + (j0 - 64); } else { cbase[0] = 256 * pn + j0; cbase[1] = 256 * pn + 128 + j0; }
#pragma unroll
            for (int ai = 0; ai < 2; ++ai)
#pragma unroll
                for (int m = 0; m < 4; ++m) { bf16_t* rowp = PROJ + (size_t)(row0 + ai * HALF + m * 16) * 2560; EPIIN_RSTD(row0 + ai * HALF + m * 16) EPIIN_SV
#pragma unroll
                    for (int bj = 0; bj < 2; ++bj) { f32x4 v0 = acc[ai][bj][m][0] * rstd + sv[bj][0], v1 = acc[ai][bj][m][1] * rstd + sv[bj][1];
                        if (pn == 1) {
#pragma unroll
                            for (int e = 0; e < 4; ++e) { v0[e] = fast_gelu_tanh(v0[e]); v1[e] = fast_gelu_tanh(v1[e]); } }
                        u32x4 w; w.x = cvt_pk_bf16(v0[0], v0[1]); w.y = cvt_pk_bf16(v0[2], v0[3]); w.z = cvt_pk_bf16(v1[0], v1[1]); w.w = cvt_pk_bf16(v1[2], v1[3]);
                        *(u32x4*)(rowp + cbase[bj]) = w; } }
        } else {
            const bool latent = lat; const float qs = (pn == 2 || pn == 4 || pn == 5) ? C2q : 1.0f;
            const int c1 = (pn == 3 ? 768 : 256 * pn) + 64 * wc + 8 * fq;
            const int fo = 8 * (fq & 1);
#pragma unroll
            for (int ai = 0; ai < 2; ++ai) {
                const int posr = (4 * u.pm + 2 * ai + wr) & 63;
#pragma unroll
                for (int m = 0; m < 4; ++m) { bf16_t* rowp = PROJ + (size_t)(row0 + ai * HALF + m * 16) * 2560 + c1;
                    const int pos = (fq < 2) ? posr : (16 * m + fr); EPIIN_RSTD(row0 + ai * HALF + m * 16) EPIIN_SV
                    f32x4 x1a = acc[ai][0][m][0] * rstd + sv[0][0], x1b = acc[ai][0][m][1] * rstd + sv[0][1], x2a = acc[ai][1][m][0] * rstd + sv[1][0], x2b = acc[ai][1][m][1] * rstd + sv[1][1];
                    if (latent) {
                        const f32x4 ca = *(const PG8_LAS f32x4*)(cosv + pos * 16 + fo), cb = *(const PG8_LAS f32x4*)(cosv + pos * 16 + fo + 4), sa = *(const PG8_LAS f32x4*)(sinv + pos * 16 + fo), sb = *(const PG8_LAS f32x4*)(sinv + pos * 16 + fo + 4);
                        const f32x4 o1a = x1a * ca - x2a * sa, o1b = x1b * cb - x2b * sb, o2a = x1a * sa + x2a * ca, o2b = x1b * sb + x2b * cb;
                        x1a = o1a; x1b = o1b; x2a = o2a; x2b = o2b;
                    }
                    x1a = x1a * qs; x1b = x1b * qs; x2a = x2a * qs; x2b = x2b * qs;
                    u32x4 w1, w2; w1.x = cvt_pk_bf16(x1a[0], x1a[1]); w1.y = cvt_pk_bf16(x1a[2], x1a[3]); w1.z = cvt_pk_bf16(x1b[0], x1b[1]); w1.w = cvt_pk_bf16(x1b[2], x1b[3]);
                    w2.x = cvt_pk_bf16(x2a[0], x2a[1]); w2.y = cvt_pk_bf16(x2a[2], x2a[3]); w2.z = cvt_pk_bf16(x2b[0], x2b[1]); w2.w = cvt_pk_bf16(x2b[2], x2b[3]);
                    *(u32x4*)rowp = w1; *(u32x4*)(rowp + 32) = w2; }
            }
        }
    }
};
#undef EPIIN_RSTD
#undef EPIIN_SV

template <class Epi, class Sched, bool ALIGN_EPI = false, bool SP2 = false>
__device__ __forceinline__ void gemm_phase(PG8_LAS unsigned char* lds, const Gemm g, const Sched& S, const Epi& E, const int tid_in) {
    const int tid = tid_in, wid = __builtin_amdgcn_readfirstlane(tid >> 6), lane = tid & 63, wr = wid >> 2, wc = wid & 3, fr = lane & 15, fq = lane >> 4;
    const int K = g.K, LD = g.ld; int nt = K / BK;
    unsigned voffA[2], voffB[2];
#pragma unroll
    for (int i = 0; i < 2; ++i) { int R, C; stage_rc(tid * 16 + i * 8192, R, C); const int Rb = Epi::PERM ? ((R & ~31) + perm32(R & 31)) : R;
        voffA[i] = (unsigned)(R * LD + C) * 2u; voffB[i] = (unsigned)(Rb * LD + C) * 2u; }
    const size_t kstep = (size_t)(BK * 2);
    const size_t hstep = (size_t)HALF * LD * 2;
    const size_t tstep = 2 * hstep;
    const unsigned ldsw = (unsigned)wid * 1024u;
    const int aoff = lds_byte(wr * 64 + fr, fq * 8), boff = lds_byte(wc * 32 + fr, fq * 8);
#define PG8_SA(b, h) (((b) * 2 + (h)) * HTB)
#define PG8_SB(b, h) ((4 + (b) * 2 + (h)) * HTB)
#define PG8_STAGE(bufoff, gbase, voff) do { _Pragma("unroll") for (int _i = 0; _i < 2; ++_i) { unsigned vo_ = (voff)[_i]; asm volatile("" : "+v"(vo_));   \
        __builtin_amdgcn_global_load_lds((const unsigned*)((const char*)(gbase) + vo_), (PG8_LAS unsigned*)(lds + (bufoff) + ldsw + _i * 8192), 16, 0, 0); } } while (0)
#define PG8_LDA(dst, b, h) do { _Pragma("unroll") for (int m = 0; m < 4; ++m) _Pragma("unroll") for (int k = 0; k < 2; ++k) dst[m][k] = *(const PG8_LAS bf16x8*)(lds + PG8_SA(b, h) + aoff + m * 2048 + k * 1024); } while (0)
#define PG8_LDB(dst, b, h) do { _Pragma("unroll") for (int n = 0; n < 2; ++n) _Pragma("unroll") for (int k = 0; k < 2; ++k) dst[n][k] = *(const PG8_LAS bf16x8*)(lds + PG8_SB(b, h) + boff + n * 2048 + k * 1024); } while (0)
#define PG8_MMA(ai, bj, At, Bt) do { __builtin_amdgcn_s_setprio(1); _Pragma("unroll") for (int m = 0; m < 4; ++m) _Pragma("unroll") for (int n = 0; n < 2; ++n) _Pragma("unroll") for (int k = 0; k < 2; ++k) \
        acc[ai][bj][m][n] = __builtin_amdgcn_mfma_f32_16x16x32_bf16(Bt[n][k], At[m][k], acc[ai][bj][m][n], 0, 0, 0); __builtin_amdgcn_s_setprio(0); } while (0)
#define PG8_WAIT_V(n) asm volatile("s_waitcnt vmcnt(" #n ")" ::: "memory")
#define PG8_WAIT_L(n) asm volatile("s_waitcnt lgkmcnt(" #n ")" ::: "memory")
#define PG8_WAIT_VN(n) asm volatile("s_waitcnt vmcnt(%0)" :: "n"(n) : "memory")
#define PG8_BAR __builtin_amdgcn_s_barrier()
#define PG8_SCHED __builtin_amdgcn_sched_barrier(0)
    Unit cur, nxt; int ui = 0;
    if (!S.next(0, cur)) return;
    f32x4 acc[2][2][4][2];
#pragma unroll
    for (int a = 0; a < 2; ++a)
#pragma unroll
        for (int b = 0; b < 2; ++b)
#pragma unroll
            for (int m = 0; m < 4; ++m)
#pragma unroll
                for (int n = 0; n < 2; ++n) acc[a][b][m][n] = (f32x4){0.f, 0.f, 0.f, 0.f};
    bf16x8 At[4][2], B0[2][2], B1[2][2];
    const char* cA = (const char*)g.A + (size_t)cur.pm * tstep + (size_t)cur.ko * 2; const char* cB = (const char*)g.Bt + (size_t)cur.pn * tstep + (size_t)cur.ko * 2;
    if constexpr (Sched::VAR_NT) nt = cur.nt;
    S.a_ready(cur);
    if constexpr (SP2) {
        PG8_STAGE(PG8_SB(0, 0), cB, voffB); PG8_STAGE(PG8_SB(0, 1), cB + hstep, voffB); PG8_STAGE(PG8_SA(0, 0), cA, voffA); PG8_STAGE(PG8_SA(0, 1), cA + hstep, voffA);
        if (wr == 1) PG8_BAR;
        PG8_WAIT_V(2); PG8_BAR;
        PG8_STAGE(PG8_SB(1, 0), cB + kstep, voffB); PG8_STAGE(PG8_SA(1, 0), cA + kstep, voffA); PG8_STAGE(PG8_SB(1, 1), cB + hstep + kstep, voffB);
        PG8_WAIT_V(6); PG8_BAR;
    } else {
        PG8_STAGE(PG8_SB(0, 0), cB, voffB); PG8_STAGE(PG8_SA(0, 0), cA, voffA); PG8_STAGE(PG8_SB(0, 1), cB + hstep, voffB); PG8_STAGE(PG8_SA(0, 1), cA + hstep, voffA);
        if (wr == 1) PG8_BAR;
        PG8_WAIT_V(4); PG8_BAR;
        PG8_STAGE(PG8_SB(1, 0), cB + kstep, voffB); PG8_STAGE(PG8_SA(1, 0), cA + kstep, voffA); PG8_STAGE(PG8_SB(1, 1), cB + hstep + kstep, voffB);
        PG8_WAIT_V(6); PG8_BAR;
    }
    if constexpr (Epi::PARAMS) E.stage(lds + STAGE_BYTES, cur, wid, lane);
    for (;;) {
        const bool has_next = S.next(ui + 1, nxt);
        const char* nA = has_next ? (const char*)g.A + (size_t)nxt.pm * tstep + (size_t)nxt.ko * 2 : cA; const char* nB = has_next ? (const char*)g.Bt + (size_t)nxt.pn * tstep + (size_t)nxt.ko * 2 : cB;
        int t0 = 0;
        if constexpr (Epi::LOOSE) { if (ui > 0) {
            const char* a2 = cA + 2 * kstep; const char* b2 = cB + 2 * kstep; asm volatile("" : "+s"(a2), "+s"(b2));
            const char* a3 = a2 + kstep; const char* b3 = b2 + kstep; asm volatile("" : "+s"(a3), "+s"(b3));
            PG8_LDB(B0, 0, 0); PG8_LDB(B1, 0, 1); PG8_SCHED; PG8_LDA(At, 0, 0);
            PG8_WAIT_VN(8 + Epi::NST); PG8_WAIT_L(0); PG8_BAR; PG8_MMA(0, 0, At, B0); PG8_MMA(0, 1, At, B1); PG8_BAR; PG8_SCHED;
            PG8_LDA(At, 0, 1); PG8_STAGE(PG8_SB(0, 0), b2, voffB); PG8_STAGE(PG8_SB(0, 1), b2 + hstep, voffB); PG8_STAGE(PG8_SA(0, 0), a2, voffA);
            PG8_WAIT_VN(8 + Epi::NST); PG8_WAIT_L(0); PG8_BAR; PG8_MMA(1, 0, At, B0); PG8_MMA(1, 1, At, B1); PG8_BAR; PG8_SCHED;
            PG8_LDB(B0, 1, 0); PG8_LDB(B1, 1, 1); PG8_SCHED; PG8_LDA(At, 1, 0); PG8_STAGE(PG8_SA(0, 1), a2 + hstep, voffA);
            PG8_WAIT_VN(8 + Epi::NST); PG8_WAIT_L(0); PG8_BAR; PG8_MMA(0, 0, At, B0); PG8_MMA(0, 1, At, B1); PG8_BAR; PG8_SCHED;
            PG8_LDA(At, 1, 1); PG8_STAGE(PG8_SB(1, 0), b3, voffB); PG8_STAGE(PG8_SB(1, 1), b3 + hstep, voffB); PG8_STAGE(PG8_SA(1, 0), a3, voffA);
            PG8_WAIT_V(8); PG8_WAIT_L(0); PG8_BAR; PG8_MMA(1, 0, At, B0); PG8_MMA(1, 1, At, B1); PG8_BAR; PG8_SCHED;
            t0 = 2; } }
        for (int t = t0; t < nt; t += 2) {
            const bool last = (t == nt - 2);
            const char* a1 = cA + (size_t)(t + 1) * kstep;
            const char* a2 = last ? nA : cA + (size_t)(t + 2) * kstep; const char* b2 = last ? nB : cB + (size_t)(t + 2) * kstep;
            const char* a3 = a2 + kstep; const char* b3 = b2 + kstep;
            if (last && has_next) S.a_ready(nxt);
            if constexpr (SP2) {
            PG8_LDB(B0, 0, 0); PG8_LDB(B1, 0, 1); PG8_SCHED; PG8_LDA(At, 0, 0); PG8_STAGE(PG8_SA(1, 1), a1 + hstep, voffA);
            PG8_WAIT_V(8); PG8_WAIT_L(0); PG8_BAR; PG8_MMA(0, 0, At, B0); PG8_MMA(0, 1, At, B1); PG8_BAR; PG8_SCHED;
            PG8_LDA(At, 0, 1); PG8_STAGE(PG8_SB(0, 0), b2, voffB); PG8_STAGE(PG8_SB(0, 1), b2 + hstep, voffB); PG8_STAGE(PG8_SA(0, 0), a2, voffA);
            PG8_WAIT_V(8); PG8_WAIT_L(0); PG8_BAR; PG8_MMA(1, 0, At, B0); PG8_MMA(1, 1, At, B1); PG8_BAR; PG8_SCHED;
            PG8_LDB(B0, 1, 0); PG8_LDB(B1, 1, 1); PG8_SCHED; PG8_LDA(At, 1, 0); PG8_STAGE(PG8_SA(0, 1), a2 + hstep, voffA);
            PG8_WAIT_V(8); PG8_WAIT_L(0); PG8_BAR; PG8_MMA(0, 0, At, B0); PG8_MMA(0, 1, At, B1); PG8_BAR; PG8_SCHED;
            PG8_LDA(At, 1, 1); PG8_STAGE(PG8_SB(1, 0), b3, voffB); PG8_STAGE(PG8_SB(1, 1), b3 + hstep, voffB); PG8_STAGE(PG8_SA(1, 0), a3, voffA);
            PG8_WAIT_V(8); PG8_WAIT_L(0); PG8_BAR; PG8_MMA(1, 0, At, B0); PG8_MMA(1, 1, At, B1); PG8_BAR; PG8_SCHED;
            } else {
            PG8_LDB(B0, 0, 0); PG8_SCHED; PG8_LDA(At, 0, 0); PG8_STAGE(PG8_SA(1, 1), a1 + hstep, voffA);
            PG8_WAIT_L(8); PG8_BAR; PG8_WAIT_L(0); PG8_MMA(0, 0, At, B0); PG8_BAR; PG8_SCHED;
            PG8_LDB(B1, 0, 1); PG8_STAGE(PG8_SB(0, 0), b2, voffB);
            PG8_BAR; PG8_WAIT_L(0); PG8_MMA(0, 1, At, B1); PG8_BAR;
            PG8_LDA(At, 0, 1); PG8_STAGE(PG8_SA(0, 0), a2, voffA);
            PG8_BAR; PG8_WAIT_L(0); PG8_MMA(1, 0, At, B0); PG8_BAR; PG8_SCHED;
            PG8_STAGE(PG8_SB(0, 1), b2 + hstep, voffB);
            PG8_WAIT_V(6); PG8_BAR; PG8_MMA(1, 1, At, B1); PG8_BAR;
            PG8_LDB(B0, 1, 0); PG8_SCHED; PG8_LDA(At, 1, 0); PG8_STAGE(PG8_SA(0, 1), a2 + hstep, voffA);
            PG8_WAIT_L(8); PG8_BAR; PG8_WAIT_L(0); PG8_MMA(0, 0, At, B0); PG8_BAR; PG8_SCHED;
            PG8_LDB(B1, 1, 1); PG8_STAGE(PG8_SB(1, 0), b3, voffB);
            PG8_BAR; PG8_WAIT_L(0); PG8_MMA(0, 1, At, B1); PG8_BAR;
            PG8_LDA(At, 1, 1); PG8_STAGE(PG8_SA(1, 0), a3, voffA);
            PG8_BAR; PG8_WAIT_L(0); PG8_MMA(1, 0, At, B0); PG8_BAR; PG8_SCHED;
            PG8_STAGE(PG8_SB(1, 1), b3 + hstep, voffB);
            PG8_WAIT_V(6); PG8_BAR; PG8_MMA(1, 1, At, B1); PG8_BAR;
            }
        }
        if constexpr (Epi::PARAMS || Epi::LOOSE) { if (has_next) { if constexpr (Epi::LOOSE) { const char* xa = nA + kstep + hstep; asm volatile("" : "+s"(xa)); PG8_STAGE(PG8_SA(1, 1), xa, voffA); } if constexpr (Epi::PARAMS) E.stage(lds + STAGE_BYTES + ((ui + 1) & 1) * 5120, nxt, wid, lane); } }
        if constexpr (ALIGN_EPI) { if (wr == 0) PG8_BAR; }
        if constexpr (!Epi::AFTER_DRAIN) { if constexpr (Epi::PARAMS) E(acc, cur, wr, wc, fr, fq, lds + STAGE_BYTES + (ui & 1) * 5120); else E(acc, cur, wr, wc, fr, fq); S.done(cur); }
        if (!has_next) break;
#pragma unroll
        for (int a = 0; a < 2; ++a)
#pragma unroll
            for (int b = 0; b < 2; ++b)
#pragma unroll
                for (int m = 0; m < 4; ++m)
#pragma unroll
                    for (int n = 0; n < 2; ++n) acc[a][b][m][n] = (f32x4){0.f, 0.f, 0.f, 0.f};
        cur = nxt; cA = nA; cB = nB; ++ui; if constexpr (Sched::VAR_NT) nt = cur.nt;
        if constexpr (ALIGN_EPI) { if (wr == 1) PG8_BAR; }
    }
    PG8_WAIT_V(0);
    if constexpr (!ALIGN_EPI) { if (wr == 0) PG8_BAR; }
    PG8_BAR;
    if constexpr (Epi::AFTER_DRAIN) { E.fused(acc, cur, wr, wc, fr, fq, lds, wid, lane); S.done(cur); }
#undef PG8_SA
#undef PG8_SB
#undef PG8_STAGE
#undef PG8_LDA
#undef PG8_LDB
#undef PG8_MMA
#undef PG8_WAIT_V
#undef PG8_WAIT_L
#undef PG8_WAIT_VN
#undef PG8_BAR
#undef PG8_SCHED
}
}

#define GAS __attribute__((address_space(1)))
#define LAS __attribute__((address_space(3)))
typedef unsigned short bf16;
typedef unsigned v4u __attribute__((ext_vector_type(4)));
typedef float f32x4 __attribute__((ext_vector_type(4)));
typedef short bf16x8 __attribute__((ext_vector_type(8)));
typedef GAS unsigned gu32;
typedef GAS unsigned long long gu64;
#define RLX_AGENT __ATOMIC_RELAXED, __HIP_MEMORY_SCOPE_AGENT
#define LDS_WAIT() asm volatile("s_waitcnt lgkmcnt(0)" ::: "memory")
#define VM_WAIT() asm volatile("s_waitcnt vmcnt(0)" ::: "memory")
__device__ __forceinline__ unsigned long long rt() { return __builtin_amdgcn_s_memrealtime(); }
#define XB_TMO      128
#define XB_XCNT(j)  (256  + 64 * (j))
#define XB_XSUB(j)  (1280 + 64 * (j))
#define XB_XGEN(j)  (2304 + 64 * (j))
#define XB_TOP      3328
#define XB_TOPGEN   3392
#define XCD_BAR_WORDS 3456
#define XB_SPIN_CAP (1u << 18)

__device__ __forceinline__ unsigned xb_ld(unsigned* p)              { return __hip_atomic_load(p, __ATOMIC_RELAXED, __HIP_MEMORY_SCOPE_AGENT); }
__device__ __forceinline__ unsigned xb_add(unsigned* p, unsigned v) { return __hip_atomic_fetch_add(p, v, __ATOMIC_RELAXED, __HIP_MEMORY_SCOPE_AGENT); }
__device__ __forceinline__ unsigned xb_xcc_id() { return (unsigned)__builtin_amdgcn_s_getreg((3 << 11) | 20) & 0xFu; }
#define XB_SPIN(cond, bar) do { unsigned _sp = 0; while (cond) { __builtin_amdgcn_s_sleep(1); \
    if ((++_sp & 255u) == 0u) { if (xb_ld(&(bar)[XB_TMO])) break; if (_sp > XB_SPIN_CAP) { atomicAdd(&(bar)[XB_TMO], 1u); break; } } } } while (0)

struct XcdBarrier {
    unsigned* bar; unsigned x; int w0;
    volatile LAS unsigned* st;
};

__device__ __forceinline__ XcdBarrier xcd_barrier_post(unsigned* bar, volatile LAS unsigned* st) {
    XcdBarrier b; b.bar = bar; b.x = xb_xcc_id(); b.st = st; b.w0 = __builtin_amdgcn_readfirstlane(threadIdx.x >> 6);
    if (threadIdx.x == 0) (void)xb_add(&bar[XB_XCNT(b.x)], 1u);
    return b;
}
__device__ __forceinline__ void xcd_barrier_complete(unsigned* bar, unsigned x, unsigned& nloc, unsigned& nx) {
    const unsigned G = gridDim.x * gridDim.y * gridDim.z;
    unsigned sum, cnt, mine, sp = 0u;
    for (;;) {
        sum = 0u; cnt = 0u; mine = 0u;
#pragma unroll
        for (unsigned j = 0; j < 16; ++j) { const unsigned c = xb_ld(&bar[XB_XCNT(j)]); sum += c; cnt += (c > 0u) ? 1u : 0u; mine = (j == x) ? c : mine; }
        if (sum == G) break;
        __builtin_amdgcn_s_sleep(1);
        if ((++sp & 255u) == 0u) { if (xb_ld(&bar[XB_TMO])) break; if (sp > XB_SPIN_CAP) { atomicAdd(&bar[XB_TMO], 1u); break; } }
    }
    nloc = mine > 0u ? mine : 1u; nx = cnt > 0u ? cnt : 1u;
}

__device__ __forceinline__ void xcd_barrier(const XcdBarrier& b) {
    asm volatile("s_waitcnt vmcnt(0)" ::: "memory");
    __syncthreads();
    if (b.w0 == 0 && __builtin_amdgcn_mbcnt_hi(~0u, __builtin_amdgcn_mbcnt_lo(~0u, 0u)) == 0u) {
        unsigned* bar = b.bar;
        __builtin_amdgcn_s_waitcnt(0);
        unsigned nloc = b.st[0], nx = b.st[1];
        if (nloc == 0u) { xcd_barrier_complete(bar, b.x, nloc, nx); b.st[0] = nloc; b.st[1] = nx; }
        const unsigned old = xb_add(&bar[XB_XSUB(b.x)], 1u);
        const unsigned gen = old / nloc;
        if (old + 1u == (gen + 1u) * nloc) {
            __builtin_amdgcn_fence(__ATOMIC_RELEASE, "agent");
            asm volatile("s_waitcnt vmcnt(0)" ::: "memory");
            const unsigned og = xb_add(&bar[XB_TOP], 1u);
            const unsigned tg = og / nx;
            if (og + 1u == (tg + 1u) * nx) xb_add(&bar[XB_TOPGEN], 1u);
            else XB_SPIN(xb_ld(&bar[XB_TOPGEN]) == tg, bar);
            __builtin_amdgcn_fence(__ATOMIC_ACQUIRE, "agent");
            xb_add(&bar[XB_XGEN(b.x)], 1u);
            asm volatile("s_waitcnt vmcnt(0)" ::: "memory");
        } else {
            XB_SPIN(xb_ld(&bar[XB_XGEN(b.x)]) == gen, bar);
            __builtin_amdgcn_fence(__ATOMIC_ACQUIRE, "agent");
            asm volatile("s_waitcnt vmcnt(0)" ::: "memory");
        }
    }
    __syncthreads();
}


namespace att {
typedef float f32x16 __attribute__((ext_vector_type(16)));
typedef short s16x4 __attribute__((ext_vector_type(4)));
typedef short v4i16_t __attribute__((ext_vector_type(4)));
typedef short bf16x8 __attribute__((ext_vector_type(8)));
typedef unsigned u32x4 __attribute__((ext_vector_type(4)));
#define ATT_LAS __attribute__((address_space(3)))
__device__ __forceinline__ int crow(int r, int hi) { return (r & 3) + 8 * (r >> 2) + 4 * hi; }
__device__ __forceinline__ unsigned cvtpk(float lo, float hi) { typedef float f2 __attribute__((ext_vector_type(2))); typedef __bf16 b2 __attribute__((ext_vector_type(2))); f2 v = {lo, hi}; b2 b = __builtin_convertvector(v, b2); return __builtin_bit_cast(unsigned, b); }
__device__ __forceinline__ float swapmax(float m) { auto rr = __builtin_amdgcn_permlane32_swap(__float_as_uint(m), __float_as_uint(m), false, false); return fmaxf(__uint_as_float(rr[0]), __uint_as_float(rr[1])); }
__device__ __forceinline__ float swapsum(float m) { auto rr = __builtin_amdgcn_permlane32_swap(__float_as_uint(m), __float_as_uint(m), false, false); return __uint_as_float(rr[0]) + __uint_as_float(rr[1]); }
__device__ __forceinline__ float sx(float v, int mask, int lane) { return __int_as_float(__builtin_amdgcn_ds_bpermute((lane ^ mask) << 2, __float_as_int(v))); }
constexpr float THR = 8.0f;
constexpr int NOMASK = -1000000;

struct TileSeq {
    int b, nt, mode  , q0, jlo;
    __device__ __forceinline__ int row(int t, int& kabs0) const {
        if (t < 4) { kabs0 = NOMASK; return 16384 + b * 256 + 64 * t; }
        if (mode == 0) { kabs0 = NOMASK; return b * 4096 + 64 * (t - 4); }
        const int j = jlo + t - 4; kabs0 = q0 - 128 + 64 * j; return b * 4096 + kabs0;
    }
};

__device__ __forceinline__ void dma16(const void* g, ATT_LAS unsigned char* l) {
    asm volatile("s_mov_b32 m0, %1\n\ts_nop 0\n\tglobal_load_lds_dwordx4 %0, off" :: "v"(g), "s"((unsigned)(unsigned long)l) : "memory", "m0");
}
template <int NS, int ND> __device__ __forceinline__ void issue_tile(ATT_LAS unsigned char* stage, const unsigned short* PROJ, int krow0, int kcol, int vcol, int wave, int lane) {
#pragma unroll
    for (int i = 0; i < NS; ++i) { const int p = wave + 8 * i, s = p >> 3, c = p & 7;
        const unsigned short* src = PROJ + (size_t)(krow0 + lane) * 2560 + kcol + 64 * s + 8 * c;
        dma16(src, stage + s * 8192 + c * 1024); }
#pragma unroll
    for (int i = 0; i < ND / 2; ++i) { const int p = wave + 8 * i, dblk = p >> 2, rg = p & 3;
        const unsigned short* src = PROJ + (size_t)(krow0 + 16 * rg + (lane >> 2)) * 2560 + vcol + 32 * dblk + 8 * (lane & 3);
        dma16(src, stage + NS * 8192 + (dblk * 4 + rg) * 1024); }
}
__device__ __forceinline__ s16x4 vtr(const ATT_LAS unsigned char* p) { return __builtin_bit_cast(s16x4, __builtin_amdgcn_ds_read_tr16_b64_v4i16((ATT_LAS v4i16_t*)p)); }

#define AT_ROWS_OUT(Ts_, ND_, Y_, qrow_, ycol_, lane_) do { asm volatile("s_waitcnt lgkmcnt(0)" ::: "memory"); \
        _Pragma("unroll") for (int j_ = 0; j_ < 2 * (ND_); ++j_) { const int idx_ = (lane_) + 64 * j_, row_ = idx_ / (4 * (ND_)), ch_ = idx_ % (4 * (ND_)); \
            const u32x4 v_ = *(const ATT_LAS u32x4*)((Ts_) + row_ * (64 * (ND_)) + ch_ * 16); \
            *(u32x4*)((Y_) + (size_t)((qrow_) + row_) * 1024 + (ycol_) + 8 * ch_) = v_; } } while (0)
#define AT_MX3(a, b, c) __builtin_fmaxf(__builtin_fmaxf((a), (b)), (c))
template <int NS, int ND> __device__ __forceinline__ void pv_step(f32x16 (&o)[NS][ND], const u32x4 (&pf)[NS][4], const ATT_LAS unsigned char* Vs);
template <int NS, int ND, int NSTG, bool QLDS>
__device__ __forceinline__ void attn_unit(ATT_LAS unsigned char* lds, const unsigned short* PROJ, unsigned short* Y, const TileSeq ts, int qrow, int qcol, int kcol, int vcol, int ycol,
                                          int qabs, float sinkl2, float lam, const float* subg, float oml, int tid) {
    constexpr int STAGE = NS * 8192 + ND * 4096, NDMA = NS + ND / 2;
    const int lane = tid & 63, r32 = lane & 31, hi = lane >> 5; const int wave = __builtin_amdgcn_readfirstlane(tid >> 6);
    constexpr int QBYTES = QLDS ? 8 * NS * 4096 : 0;
    ATT_LAS unsigned char* Qs = lds + NSTG * STAGE + wave * (NS * 4096);
    ATT_LAS float* wsf = (ATT_LAS float*)(lds + NSTG * STAGE + QBYTES) + wave * 64;
    int ka;
    { const int kr = ts.row(0, ka); issue_tile<NS, ND>(lds, PROJ, kr, kcol, vcol, wave, lane); }
    if (NSTG == 3 && ts.nt > 1) { const int kr = ts.row(1, ka); issue_tile<NS, ND>(lds + STAGE, PROJ, kr, kcol, vcol, wave, lane); }
    bf16x8 qf[NS][4];
#pragma unroll
    for (int s = 0; s < NS; ++s)
#pragma unroll
        for (int d0 = 0; d0 < 4; ++d0) { qf[s][d0] = *(const bf16x8*)(PROJ + (size_t)(qrow + r32) * 2560 + qcol + 64 * s + 16 * d0 + 8 * hi);
            if (QLDS) *(ATT_LAS bf16x8*)(Qs + (s * 8 + 2 * d0 + hi) * 512 + r32 * 16) = qf[s][d0]; }
    f32x16 o[NS][ND];
#pragma unroll
    for (int s = 0; s < NS; ++s)
#pragma unroll
        for (int d = 0; d < ND; ++d)
#pragma unroll
            for (int r = 0; r < 16; ++r) o[s][d][r] = 0.f;
    float mref[NS], lsum[NS];
#pragma unroll
    for (int s = 0; s < NS; ++s) { mref[s] = (NS == 1) ? sinkl2 : -1e30f; lsum[s] = (NS == 1 && hi == 0) ? 1.0f : 0.f; }
    const int koff = hi * 1024 + r32 * 16;
    const int voff = ((lane >> 4) & 1) * 32 + (lane & 3) * 8 + (4 * hi + ((lane & 15) >> 2)) * 64;
    __builtin_amdgcn_s_waitcnt(0x0F70);
    int st = 0;
    for (int t = 0; t < ts.nt; ++t) {
        if (NSTG == 3 && t + 1 < ts.nt) asm volatile("s_waitcnt vmcnt(%0)" ::"n"(NDMA) : "memory"); else asm volatile("s_waitcnt vmcnt(0)" ::: "memory");
        asm volatile("s_waitcnt lgkmcnt(0)" ::: "memory");
        __builtin_amdgcn_s_barrier();
        asm volatile("" ::: "memory");
        if (NSTG == 3) { if (t + 2 < ts.nt) { int k2; const int kr = ts.row(t + 2, k2); const int s2 = (st >= 1) ? st - 1 : 2; issue_tile<NS, ND>(lds + s2 * STAGE, PROJ, kr, kcol, vcol, wave, lane); } }
        else { if (t + 1 < ts.nt) { int k2; const int kr = ts.row(t + 1, k2); issue_tile<NS, ND>(lds + (st ^ 1) * STAGE, PROJ, kr, kcol, vcol, wave, lane); } }
        int kabs0; (void)ts.row(t, kabs0);
        const ATT_LAS unsigned char* Ks = lds + st * STAGE; const ATT_LAS unsigned char* Vs = Ks + NS * 8192;
        u32x4 pf[NS][4];
#pragma unroll
        for (int s = 0; s < NS; ++s) {
            f32x16 p0, p1;
#pragma unroll
            for (int r = 0; r < 16; ++r) { p0[r] = 0.f; p1[r] = 0.f; }
            bf16x8 kA[4], kB[4];
#pragma unroll
            for (int d0 = 0; d0 < 4; ++d0) { kA[d0] = *(const ATT_LAS bf16x8*)(Ks + s * 8192 + koff + d0 * 2048); kB[d0] = *(const ATT_LAS bf16x8*)(Ks + s * 8192 + koff + d0 * 2048 + 512); }
            __builtin_amdgcn_sched_group_barrier(0x100, 8, 0);
#pragma unroll
            for (int d0 = 0; d0 < 4; ++d0) {
                const bf16x8 qv = QLDS ? *(const ATT_LAS bf16x8*)(Qs + (s * 8 + 2 * d0 + hi) * 512 + r32 * 16) : qf[s][d0];
                p0 = __builtin_amdgcn_mfma_f32_32x32x16_bf16(kA[d0], qv, p0, 0, 0, 0);
                p1 = __builtin_amdgcn_mfma_f32_32x32x16_bf16(kB[d0], qv, p1, 0, 0, 0);
            }
            __builtin_amdgcn_sched_group_barrier(0x008, 8, 0);
            if (NS == 1 && kabs0 != NOMASK) {
                const int dq = qabs + r32 - kabs0 - 4 * hi;
#pragma unroll
                for (int r = 0; r < 16; ++r) { const int dk = dq - ((r & 3) + 8 * (r >> 2)); if (dk > 128 || dk < -128) p0[r] = -1e30f; if (dk - 32 > 128 || dk - 32 < -128) p1[r] = -1e30f; }
            }
            float rm; { float a_ = AT_MX3(p0[0], p0[1], p1[0]), b_ = AT_MX3(p0[2], p0[3], p1[1]); a_ = AT_MX3(a_, p1[2], p1[3]);
#pragma unroll
                for (int r = 4; r < 16; r += 4) { a_ = AT_MX3(a_, p0[r], p0[r + 1]); b_ = AT_MX3(b_, p0[r + 2], p0[r + 3]); a_ = AT_MX3(a_, p1[r], p1[r + 1]); b_ = AT_MX3(b_, p1[r + 2], p1[r + 3]); }
                rm = __builtin_fmaxf(a_, b_); }
            rm = swapmax(rm);
            if (__any(rm > mref[s] + THR)) {
                const float mn = fmaxf(mref[s], rm), f = __builtin_amdgcn_exp2f(mref[s] - mn);
                lsum[s] *= f; mref[s] = mn;
                if (hi == 0) wsf[r32] = f;
                float fr[16];
#pragma unroll
                for (int r = 0; r < 16; ++r) fr[r] = wsf[crow(r, hi)];
#pragma unroll
                for (int d = 0; d < ND; ++d)
#pragma unroll
                    for (int r = 0; r < 16; ++r) o[s][d][r] *= fr[r];
            }
            float sacc = lsum[s];
#pragma unroll
            for (int r = 0; r < 16; ++r) { p0[r] = __builtin_amdgcn_exp2f(p0[r] - mref[s]); p1[r] = __builtin_amdgcn_exp2f(p1[r] - mref[s]); sacc = sacc + p0[r]; sacc = sacc + p1[r]; }
            lsum[s] = sacc;
            pf[s][0] = (u32x4){cvtpk(p0[0], p0[1]), cvtpk(p0[2], p0[3]), cvtpk(p0[4], p0[5]), cvtpk(p0[6], p0[7])};
            pf[s][1] = (u32x4){cvtpk(p0[8], p0[9]), cvtpk(p0[10], p0[11]), cvtpk(p0[12], p0[13]), cvtpk(p0[14], p0[15])};
            pf[s][2] = (u32x4){cvtpk(p1[0], p1[1]), cvtpk(p1[2], p1[3]), cvtpk(p1[4], p1[5]), cvtpk(p1[6], p1[7])};
            pf[s][3] = (u32x4){cvtpk(p1[8], p1[9]), cvtpk(p1[10], p1[11]), cvtpk(p1[12], p1[13]), cvtpk(p1[14], p1[15])};
        }
        __builtin_amdgcn_sched_barrier(0);
        pv_step<NS, ND>(o, pf, Vs + voff);
        __builtin_amdgcn_sched_barrier(0);
        st = (NSTG == 3) ? ((st == 2) ? 0 : st + 1) : (st ^ 1);
    }
    unsigned lz_ = 0u; asm volatile("" : "+v"(lz_)); const int lane_e = (int)__builtin_amdgcn_mbcnt_hi(~0u, __builtin_amdgcn_mbcnt_lo(~0u, lz_));
    const int r32e = lane_e & 31, hie = lane_e >> 5;
    float inv[NS][16];
#pragma unroll
    for (int s = 0; s < NS; ++s) {
        const float lt = swapsum(lsum[s]);
        if (hie == 0) wsf[s * 32 + r32e] = 1.0f / lt;
    }
#pragma unroll
    for (int s = 0; s < NS; ++s)
#pragma unroll
        for (int r = 0; r < 16; ++r) inv[s][r] = wsf[s * 32 + crow(r, hie)];
    if (NS == 1) {
        ATT_LAS unsigned char* Ts = lds + NSTG * STAGE + QBYTES + 2048 + wave * (32 * 64 * ND);
#pragma unroll
        for (int r = 0; r < 16; ++r)
#pragma unroll
            for (int d = 0; d < ND; ++d) *(ATT_LAS unsigned short*)(Ts + crow(r, hie) * (64 * ND) + (32 * d + r32e) * 2) = f2bf(o[0][d][r] * inv[0][r]);
        AT_ROWS_OUT(Ts, ND, Y, qrow, ycol, lane_e);
    } else {
        float gsub[ND];
#pragma unroll
        for (int d = 0; d < ND; ++d) gsub[d] = subg[32 * d + r32e] * oml;
#pragma unroll
        for (int r = 0; r < 16; ++r) {
            float ss = 0.f; float ov[ND];
#pragma unroll
            for (int d = 0; d < ND; ++d) { ov[d] = o[0][d][r] * inv[0][r] - lam * (o[NS - 1][d][r] * inv[NS - 1][r]); ss += ov[d] * ov[d]; }
            ss += sx(ss, 1, lane_e); ss += sx(ss, 2, lane_e); ss += sx(ss, 4, lane_e); ss += sx(ss, 8, lane_e); ss += sx(ss, 16, lane_e);
            const float rstd = 1.0f / sqrtf(ss * (1.0f / (32 * ND)) + 1e-6f);
            unsigned short* yp = Y + (size_t)(qrow + crow(r, hie)) * 1024 + ycol + r32e;
#pragma unroll
            for (int d = 0; d < ND; ++d) yp[32 * d] = f2bf(ov[d] * rstd * gsub[d]);
        }
    }
    asm volatile("s_waitcnt lgkmcnt(0)" ::: "memory");
    __builtin_amdgcn_s_barrier();
    asm volatile("" ::: "memory");
}

#define ATT_MX3(a, b, c) __builtin_fmaxf(__builtin_fmaxf((a), (b)), (c))
constexpr int PVDEP = 3;
#define PV_LD1(vf_, Vs_, ND_, i_) do { const int ks_ = (i_) / (ND_), d_ = (i_) % (ND_); const s16x4 lo_ = vtr((Vs_) + d_ * 4096 + ks_ * 1024), hh_ = vtr((Vs_) + d_ * 4096 + ks_ * 1024 + 512); \
        (vf_)[i_] = (bf16x8){lo_[0], lo_[1], lo_[2], lo_[3], hh_[0], hh_[1], hh_[2], hh_[3]}; } while (0)
template <int ND> __device__ __forceinline__ void pv_prefetch(bf16x8 (&vf)[4 * ND], const ATT_LAS unsigned char* Vs) {
#pragma unroll
    for (int i = 0; i < PVDEP; ++i) PV_LD1(vf, Vs, ND, i);
}
template <int NS, int ND> __device__ __forceinline__ void pv_run(f32x16 (&o)[NS][ND], const u32x4 (&pf)[NS][4], bf16x8 (&vf)[4 * ND], const ATT_LAS unsigned char* Vs) {
    constexpr int NF = 4 * ND;
    __builtin_amdgcn_s_setprio(1);
#pragma unroll
    for (int i = 0; i < NF; ++i) {
        if (i + PVDEP < NF) PV_LD1(vf, Vs, ND, i + PVDEP);
#pragma unroll
        for (int s = 0; s < NS; ++s) o[s][i % ND] = __builtin_amdgcn_mfma_f32_32x32x16_bf16(__builtin_bit_cast(bf16x8, pf[s][i / ND]), vf[i], o[s][i % ND], 0, 0, 0);
        if (i + PVDEP < NF) __builtin_amdgcn_sched_group_barrier(0x100, 2, 0);
        __builtin_amdgcn_sched_group_barrier(0x008, NS, 0);
    }
    __builtin_amdgcn_s_setprio(0);
}
template <int NS, int ND> __device__ __forceinline__ void pv_step(f32x16 (&o)[NS][ND], const u32x4 (&pf)[NS][4], const ATT_LAS unsigned char* Vs) {
    bf16x8 vf[4 * ND]; pv_prefetch<ND>(vf, Vs); __builtin_amdgcn_sched_group_barrier(0x100, 2 * PVDEP, 0); pv_run<NS, ND>(o, pf, vf, Vs);
}
template <int NS, int ND>
__device__ __forceinline__ void attn_unit_pp(ATT_LAS unsigned char* lds, const unsigned short* PROJ, unsigned short* Y, const TileSeq ts, int qrow, int qcol, int kcol, int vcol, int ycol,
                                             float lam, const float* subg, float oml, int tid) {
    constexpr int KB = NS * 8192, VB = ND * 4096, OFF_V = 2 * KB, OFF_Q = 2 * KB + 3 * VB, OFF_W = OFF_Q + 8 * NS * 4096;
    const int lane = tid & 63, r32 = lane & 31, hi = lane >> 5; const int wave = __builtin_amdgcn_readfirstlane(tid >> 6); const bool grpB = wave >= 4;
    ATT_LAS unsigned char* Qs = lds + OFF_Q + wave * (NS * 4096);
    ATT_LAS float* wsf = (ATT_LAS float*)(lds + OFF_W) + wave * 64;
#define PP_ISSUE(t_, kslot_, vslot_) do { int ka_; const int kr_ = ts.row((t_), ka_); \
        _Pragma("unroll") for (int i_ = 0; i_ < NS; ++i_) { const int p_ = wave + 8 * i_, s_ = p_ >> 3, c_ = p_ & 7; \
            dma16(PROJ + (size_t)(kr_ + lane) * 2560 + kcol + 64 * s_ + 8 * c_, lds + (kslot_) * KB + s_ * 8192 + c_ * 1024); } \
        _Pragma("unroll") for (int i_ = 0; i_ < ND / 2; ++i_) { const int p_ = wave + 8 * i_, db_ = p_ >> 2, rg_ = p_ & 3; \
            dma16(PROJ + (size_t)(kr_ + 16 * rg_ + (lane >> 2)) * 2560 + vcol + 32 * db_ + 8 * (lane & 3), lds + OFF_V + (vslot_) * VB + (db_ * 4 + rg_) * 1024); } } while (0)
    PP_ISSUE(0, 0, 0);
#pragma unroll
    for (int s = 0; s < NS; ++s)
#pragma unroll
        for (int d0 = 0; d0 < 4; ++d0) *(ATT_LAS bf16x8*)(Qs + (s * 8 + 2 * d0 + hi) * 512 + r32 * 16) = *(const bf16x8*)(PROJ + (size_t)(qrow + r32) * 2560 + qcol + 64 * s + 16 * d0 + 8 * hi);
    f32x16 o[NS][ND];
#pragma unroll
    for (int s = 0; s < NS; ++s)
#pragma unroll
        for (int d = 0; d < ND; ++d)
#pragma unroll
            for (int r = 0; r < 16; ++r) o[s][d][r] = 0.f;
    float mref[NS], lsum[NS];
#pragma unroll
    for (int s = 0; s < NS; ++s) { mref[s] = 0.f; lsum[s] = 0.f; }
    u32x4 pf[NS][4];
#pragma unroll
    for (int s = 0; s < NS; ++s)
#pragma unroll
        for (int k = 0; k < 4; ++k) pf[s][k] = (u32x4){0u, 0u, 0u, 0u};
    const int koff = hi * 1024 + r32 * 16;
    const int voff = ((lane >> 4) & 1) * 32 + (lane & 3) * 8 + (4 * hi + ((lane & 15) >> 2)) * 64;
#define PP_QKSM(Ks_, MID_, PRE_) do { \
        _Pragma("unroll") for (int s = 0; s < NS; ++s) { \
            f32x16 p0, p1; \
            _Pragma("unroll") for (int r = 0; r < 16; ++r) { p0[r] = -mref[s]; p1[r] = -mref[s]; } \
            bf16x8 kA_[4], kB_[4], qq_[4];        \
            _Pragma("unroll") for (int d0 = 0; d0 < 2; ++d0) { \
                kA_[d0] = *(const ATT_LAS bf16x8*)((Ks_) + s * 8192 + koff + d0 * 2048); kB_[d0] = *(const ATT_LAS bf16x8*)((Ks_) + s * 8192 + koff + d0 * 2048 + 512); \
                qq_[d0] = *(const ATT_LAS bf16x8*)(Qs + (s * 8 + 2 * d0 + hi) * 512 + r32 * 16); } \
            __builtin_amdgcn_sched_group_barrier(0x100, 6, 0); \
            _Pragma("unroll") for (int d0 = 0; d0 < 4; ++d0) { \
                if (d0 + 2 < 4) { kA_[d0 + 2] = *(const ATT_LAS bf16x8*)((Ks_) + s * 8192 + koff + (d0 + 2) * 2048); kB_[d0 + 2] = *(const ATT_LAS bf16x8*)((Ks_) + s * 8192 + koff + (d0 + 2) * 2048 + 512); \
                    qq_[d0 + 2] = *(const ATT_LAS bf16x8*)(Qs + (s * 8 + 2 * (d0 + 2) + hi) * 512 + r32 * 16); } \
                p0 = __builtin_amdgcn_mfma_f32_32x32x16_bf16(kA_[d0], qq_[d0], p0, 0, 0, 0); \
                p1 = __builtin_amdgcn_mfma_f32_32x32x16_bf16(kB_[d0], qq_[d0], p1, 0, 0, 0); \
                __builtin_amdgcn_sched_group_barrier(0x008, 2, 0); \
                if (d0 + 2 < 4) __builtin_amdgcn_sched_group_barrier(0x100, 3, 0); } \
            if (s == NS - 1) { PRE_; } \
            float rm; { float a_ = ATT_MX3(p0[0], p0[1], p1[0]), b_ = ATT_MX3(p0[2], p0[3], p1[1]); a_ = ATT_MX3(a_, p1[2], p1[3]); \
                _Pragma("unroll") for (int r = 4; r < 16; r += 4) { a_ = ATT_MX3(a_, p0[r], p0[r + 1]); b_ = ATT_MX3(b_, p0[r + 2], p0[r + 3]); a_ = ATT_MX3(a_, p1[r], p1[r + 1]); b_ = ATT_MX3(b_, p1[r + 2], p1[r + 3]); } \
                rm = __builtin_fmaxf(a_, b_); } \
            rm = swapmax(rm); \
            if (__any(rm > THR || firstf != 0.f)) { const float dl = fmaxf(rm, (firstf != 0.f) ? -100.f : 0.f), f = __builtin_amdgcn_exp2f(-dl); mref[s] += dl; lsum[s] *= f; \
                _Pragma("unroll") for (int r = 0; r < 16; ++r) { p0[r] -= dl; p1[r] -= dl; } \
                if (hi == 0) wsf[r32] = f; \
                _Pragma("unroll") for (int r = 0; r < 16; ++r) { const float fr = wsf[crow(r, hi)]; _Pragma("unroll") for (int d = 0; d < ND; ++d) o[s][d][r] *= fr; } } \
            float sacc = lsum[s];        \
            _Pragma("unroll") for (int r = 0; r < 16; ++r) { p0[r] = __builtin_amdgcn_exp2f(p0[r]); p1[r] = __builtin_amdgcn_exp2f(p1[r]); sacc = sacc + p0[r]; sacc = sacc + p1[r]; } \
            lsum[s] = sacc; \
            pf[s][0] = (u32x4){cvtpk(p0[0], p0[1]), cvtpk(p0[2], p0[3]), cvtpk(p0[4], p0[5]), cvtpk(p0[6], p0[7])}; \
            pf[s][1] = (u32x4){cvtpk(p0[8], p0[9]), cvtpk(p0[10], p0[11]), cvtpk(p0[12], p0[13]), cvtpk(p0[14], p0[15])}; \
            pf[s][2] = (u32x4){cvtpk(p1[0], p1[1]), cvtpk(p1[2], p1[3]), cvtpk(p1[4], p1[5]), cvtpk(p1[6], p1[7])}; \
            pf[s][3] = (u32x4){cvtpk(p1[8], p1[9]), cvtpk(p1[10], p1[11]), cvtpk(p1[12], p1[13]), cvtpk(p1[14], p1[15])}; \
            if (s == 0) { MID_; }        \
        } \
        firstf = 0.f; asm volatile("" : "+v"(firstf)); } while (0)
#define PP_TOP() do { asm volatile("s_waitcnt vmcnt(0)" ::: "memory"); asm volatile("s_waitcnt lgkmcnt(0)" ::: "memory"); __builtin_amdgcn_s_barrier(); asm volatile("" ::: "memory"); } while (0)
    int kst = 0, vst = 0, vprev = 2;
    float firstf = 1.f; asm volatile("" : "+v"(firstf));
    if (!grpB) {
        for (int t = 0; t < ts.nt; ++t) {
            PP_TOP();
            const int vnext = (vst == 2) ? 0 : vst + 1;
            bf16x8 vfa[4 * ND];
            PP_QKSM(lds + kst * KB, if (t + 1 < ts.nt) PP_ISSUE(t + 1, kst ^ 1, vnext), pv_prefetch<ND>(vfa, lds + OFF_V + vst * VB + voff));
            __builtin_amdgcn_sched_barrier(0);
            pv_run<NS, ND>(o, pf, vfa, lds + OFF_V + vst * VB + voff);
            vst = vnext; kst ^= 1;
        }
    } else {
        bf16x8 vfb[4 * ND];
        for (int t = 0; t < ts.nt; ++t) {
            PP_TOP();
            const int vnext = (vst == 2) ? 0 : vst + 1;
            if (t > 0) pv_run<NS, ND>(o, pf, vfb, lds + OFF_V + vprev * VB + voff);
            __builtin_amdgcn_sched_barrier(0);
            PP_QKSM(lds + kst * KB, if (t + 1 < ts.nt) PP_ISSUE(t + 1, kst ^ 1, vnext), pv_prefetch<ND>(vfb, lds + OFF_V + vst * VB + voff));
            vprev = vst; vst = vnext; kst ^= 1;
        }
        pv_run<NS, ND>(o, pf, vfb, lds + OFF_V + vprev * VB + voff);
    }
#undef PP_QKSM
#undef PP_TOP
#undef PP_ISSUE
    unsigned lz_ = 0u; asm volatile("" : "+v"(lz_)); const int lane_e = (int)__builtin_amdgcn_mbcnt_hi(~0u, __builtin_amdgcn_mbcnt_lo(~0u, lz_));
    const int r32e = lane_e & 31, hie = lane_e >> 5;
    float inv[NS][16];
#pragma unroll
    for (int s = 0; s < NS; ++s) {
        const float lt = swapsum(lsum[s]);
        if (hie == 0) wsf[s * 32 + r32e] = 1.0f / lt;
    }
#pragma unroll
    for (int s = 0; s < NS; ++s)
#pragma unroll
        for (int r = 0; r < 16; ++r) inv[s][r] = wsf[s * 32 + crow(r, hie)];
    if (NS == 1) {
#pragma unroll
        for (int r = 0; r < 16; ++r) { unsigned short* yp = Y + (size_t)(qrow + crow(r, hie)) * 1024 + ycol + r32e;
#pragma unroll
            for (int d = 0; d < ND; ++d) yp[32 * d] = f2bf(o[0][d][r] * inv[0][r]); }
    } else {
        float gsub[ND];
#pragma unroll
        for (int d = 0; d < ND; ++d) gsub[d] = subg[32 * d + r32e] * oml;
#pragma unroll
        for (int r = 0; r < 16; ++r) {
            float ss = 0.f; float ov[ND];
#pragma unroll
            for (int d = 0; d < ND; ++d) { ov[d] = o[0][d][r] * inv[0][r] - lam * (o[NS - 1][d][r] * inv[NS - 1][r]); ss += ov[d] * ov[d]; }
            ss += sx(ss, 1, lane_e); ss += sx(ss, 2, lane_e); ss += sx(ss, 4, lane_e); ss += sx(ss, 8, lane_e); ss += sx(ss, 16, lane_e);
            const float rstd = 1.0f / sqrtf(ss * (1.0f / (32 * ND)) + 1e-6f);
#pragma unroll
            for (int d = 0; d < ND; ++d) *(ATT_LAS unsigned short*)(Qs + crow(r, hie) * (64 * ND) + (32 * d + r32e) * 2) = f2bf(ov[d] * rstd * gsub[d]);
        }
        AT_ROWS_OUT(Qs, ND, Y, qrow, ycol, lane_e);
    }
    asm volatile("s_waitcnt lgkmcnt(0)" ::: "memory");
    __builtin_amdgcn_s_barrier();
    asm volatile("" ::: "memory");
}
}

namespace lru {
typedef short bf16x8 __attribute__((ext_vector_type(8)));
typedef float f32x4 __attribute__((ext_vector_type(4)));
typedef unsigned u32x4 __attribute__((ext_vector_type(4)));
#define LRU_LAS __attribute__((address_space(3)))
constexpr int LXS = 528, UBS = 528, HSS = 1040;
constexpr int OFF_HS = 0, OFF_LX = 0, OFF_UB = 66560, OFF_HIN = 66560 + 33792;
__device__ __forceinline__ float sxl(float v, int srclane) { return __int_as_float(__builtin_amdgcn_ds_bpermute(srclane << 2, __float_as_int(v))); }
__device__ __forceinline__ float fsig(float x) { return __builtin_amdgcn_rcpf(1.0f + __builtin_amdgcn_exp2f(-1.4426950408889634f * x)); }


template <bool FINAL, int DIR>
__device__ __forceinline__ void lru_scan_part(LRU_LAS unsigned char* lds, const unsigned short* WL, const float* br, const float* bi, const float* lruc, float* SUMM, unsigned* PH, int rowbase, int b, int ck, int blk, int lane, int nt0, int nt1) {
    constexpr int dir = DIR;
    const int c16 = lane & 15, g = lane >> 4;
    const unsigned short* wbase = WL + (size_t)((dir * 4 + blk) * 2) * 4096;
#pragma unroll 2
    for (int nt = nt0; nt < nt1; ++nt) {
        const int ch = blk * 64 + 16 * nt + c16;
        bf16x8 bw[2][2];
#pragma unroll
        for (int gt = 0; gt < 2; ++gt)
#pragma unroll
            for (int ks = 0; ks < 2; ++ks) bw[gt][ks] = *(const bf16x8*)(wbase + (size_t)gt * 4096 + (16 * nt + c16) * 64 + 32 * ks + 8 * g);
        f32x4 ar[4], ai[4];
#pragma unroll
        for (int m = 0; m < 4; ++m) {
            ar[m] = (f32x4){0.f, 0.f, 0.f, 0.f}; ai[m] = ar[m];
#pragma unroll
            for (int ks = 0; ks < 2; ++ks) { const bf16x8 af = *(const LRU_LAS bf16x8*)(lds + OFF_UB + (16 * m + c16) * UBS + (blk * 64 + 32 * ks + 8 * g) * 2);
                ar[m] = __builtin_amdgcn_mfma_f32_16x16x32_bf16(af, bw[0][ks], ar[m], 0, 0, 0); ai[m] = __builtin_amdgcn_mfma_f32_16x16x32_bf16(af, bw[1][ks], ai[m], 0, 0, 0); }
        }
        const float brv = br[dir * 256 + ch], biv = bi[dir * 256 + ch], cdec = lruc[dir * 256 + ch];
        float Pi[4][4], Hi[4][4], Ps[4], Hs[4];
#pragma unroll
        for (int m = 0; m < 4; ++m) {
            float P = 1.f, Hh = 0.f;
#pragma unroll
            for (int ee = 0; ee < 4; ++ee) { constexpr int dummy = 0; const int e = dir ? 3 - ee : ee;
                const int tok = 16 * m + 4 * g + e;
                const float r = fsig(ar[m][e] + brv), iv = fsig(ai[m][e] + biv), la = r * cdec, a = __builtin_amdgcn_exp2f(1.4426950408889634f * la);
                const float uval = __uint_as_float((unsigned)(*(const LRU_LAS unsigned short*)(lds + OFF_UB + tok * UBS + ch * 2)) << 16);
                const float bb = __builtin_amdgcn_sqrtf((1.f - a) * (1.f + a)) * iv * uval;
                Hh = a * Hh + bb; P = P * a; Pi[m][e] = P; Hi[m][e] = Hh; }
            Ps[m] = P; Hs[m] = Hh;
        }
        float Pc = 1.f, Hc = 0.f;
#pragma unroll
        for (int mm = 0; mm < 4; ++mm) { const int m = dir ? 3 - mm : mm;
            float P = Ps[m], Hh = Hs[m];
            {
                const int src = dir ? lane + 16 : lane - 16; const bool ok = dir ? (g <= 2) : (g >= 1);
                const float Pp = sxl(P, src & 63), Hp = sxl(Hh, src & 63); if (ok) { Hh = P * Hp + Hh; P = P * Pp; } }
            {
                const int src = dir ? lane + 32 : lane - 32; const bool ok = dir ? (g <= 1) : (g >= 2);
                const float Pp = sxl(P, src & 63), Hp = sxl(Hh, src & 63); if (ok) { Hh = P * Hp + Hh; P = P * Pp; } }
            float Pe, He;
            { const int src = dir ? lane + 16 : lane - 16; const bool ok = dir ? (g <= 2) : (g >= 1); const float Pp = sxl(P, src & 63), Hp = sxl(Hh, src & 63); Pe = ok ? Pp : 1.f; He = ok ? Hp : 0.f; }
            const int lastl = (dir ? 0 : 48) + c16; const float Pt = sxl(P, lastl), Ht = sxl(Hh, lastl);
            { const float Pb = Pe * Pc, Hb = Pe * Hc + He;
#pragma unroll
              for (int e = 0; e < 4; ++e) { const int tok = 16 * m + 4 * g + e; const float pt = Pi[m][e] * Pb, ht = Pi[m][e] * Hb + Hi[m][e];
                  PH[((size_t)dir * 17408 + rowbase + tok) * 256 + ch] = cvtpk2(pt, ht); } }
            Hc = Pt * Hc + Ht; Pc = Pt * Pc;
        }
        if (!FINAL) { if (g == 0) { float2 o; o.x = Pc; o.y = Hc; *(float2*)(SUMM + ((size_t)(b * 2 + dir) * 68 + ck) * 512 + 2 * ch) = o; } }
    }
}
template <bool FINAL>
__device__ __forceinline__ void lru_unit(LRU_LAS unsigned char* lds, const unsigned short* PROJ, unsigned short* Y, const unsigned short* WL, const float* cw, const float* cb,
                                         const float* br, const float* bi, const float* lruc, float* SUMM, unsigned* PH, int b, int ck, int mode, int tid) {
    const int lane = tid & 63; const int wave = __builtin_amdgcn_readfirstlane(tid >> 6);
    const int seqbase = (ck < 4) ? 16384 + b * 256 : b * 4096, pos0 = (ck < 4) ? 64 * ck : 64 * (ck - 4), len = (ck < 4) ? 256 : 4096;
    {
        u32x4 v[5];
#pragma unroll
        for (int k = 0; k < 5; ++k) { int it = tid + 512 * k; it = (it < 67 * 32) ? it : 67 * 32 - 1; const int i = it >> 5, c = it & 31, p = pos0 - 2 + i; const int pc = p < 0 ? 0 : (p >= len ? len - 1 : p);
            v[k] = *(const u32x4*)(PROJ + (size_t)(seqbase + pc) * 2560 + 8 * c); }
#pragma unroll
        for (int k = 0; k < 5; ++k) { const int it = tid + 512 * k; const int i = it >> 5, c = it & 31, p = pos0 - 2 + i; const bool ok = (p >= 0 && p < len);
            const u32x4 z = {0u, 0u, 0u, 0u}; if (it < 67 * 32) *(LRU_LAS u32x4*)(lds + OFF_LX + i * LXS + c * 16) = ok ? v[k] : z; }
    }
    __syncthreads();
    {
        const int ch2 = tid & 127, tg = tid >> 7; float w0[4], w1[4];
#pragma unroll
        for (int k = 0; k < 4; ++k) { w0[k] = cw[k * 256 + 2 * ch2]; w1[k] = cw[k * 256 + 2 * ch2 + 1]; }
        const float b0 = cb[2 * ch2], b1 = cb[2 * ch2 + 1];
        float x0[4], x1[4];
#pragma unroll
        for (int k = 0; k < 3; ++k) { const unsigned v = *(const LRU_LAS unsigned*)(lds + OFF_LX + (tg * 16 + k) * LXS + ch2 * 4); x0[k + 1] = __uint_as_float(v << 16); x1[k + 1] = __uint_as_float(v & 0xffff0000u); }
#pragma unroll
        for (int t = 0; t < 16; ++t) {
            x0[0] = x0[1]; x0[1] = x0[2]; x0[2] = x0[3]; x1[0] = x1[1]; x1[1] = x1[2]; x1[2] = x1[3];
            const unsigned v = *(const LRU_LAS unsigned*)(lds + OFF_LX + (tg * 16 + t + 3) * LXS + ch2 * 4); x0[3] = __uint_as_float(v << 16); x1[3] = __uint_as_float(v & 0xffff0000u);
            const float u0 = b0 + w0[0] * x0[0] + w0[1] * x0[1] + w0[2] * x0[2] + w0[3] * x0[3], u1 = b1 + w1[0] * x1[0] + w1[1] * x1[1] + w1[2] * x1[2] + w1[3] * x1[3];
            *(LRU_LAS unsigned*)(lds + OFF_UB + (tg * 16 + t) * UBS + ch2 * 4) = cvtpk2(u0, u1);
        }
    }
    __syncthreads();
    { const int dsel = (mode == 0) ? (wave & 1) : (mode - 1), nt0 = (mode == 0) ? 0 : 2 * (wave & 1), nt1 = (mode == 0) ? 4 : nt0 + 2;
      if (dsel) lru_scan_part<FINAL, 1>(lds, WL, br, bi, lruc, SUMM, PH, seqbase + pos0, b, ck, wave >> 1, lane, nt0, nt1);
      else      lru_scan_part<FINAL, 0>(lds, WL, br, bi, lruc, SUMM, PH, seqbase + pos0, b, ck, wave >> 1, lane, nt0, nt1); }
    __syncthreads();
}

__device__ __forceinline__ void lru_final_unit(LRU_LAS unsigned char* lds, const unsigned short* PROJ, unsigned short* Y, const float* SUMM, const unsigned* PH, int b, int ck, int tid) {
    const int seqbase = (ck < 4) ? 16384 + b * 256 : b * 4096, pos0 = (ck < 4) ? 64 * ck : 64 * (ck - 4);
    { const int ch = tid & 255, dir = tid >> 8; const float* sp = SUMM + ((size_t)(b * 2 + dir) * 68) * 512 + 2 * ch;
      const int np = dir ? ((ck < 4) ? 3 - ck : 4 + (67 - ck)) : ck; float hin = 0.f;
      for (int p0 = 0; p0 < np; p0 += 16) { float2 v[16];
#pragma unroll
          for (int j = 0; j < 16; ++j) { int p = p0 + j; p = (p < np) ? p : np - 1; const int c = dir ? ((p < 4) ? 3 - p : 67 - (p - 4)) : p; v[j] = *(const float2*)(sp + (size_t)c * 512); }
#pragma unroll
          for (int j = 0; j < 16; ++j) { const bool ok = (p0 + j) < np; const float px = ok ? v[j].x : 1.f, hy = ok ? v[j].y : 0.f; hin = px * hin + hy; } }
      *(LRU_LAS float*)(lds + tid * 4) = hin; }
    __syncthreads();
    const int tok = tid >> 3, cg = tid & 7; const size_t row = (size_t)seqbase + pos0 + tok;
#pragma unroll
    for (int j = 0; j < 4; ++j) { const int c0 = 32 * cg + 8 * j;
        const u32x4 f0 = *(const u32x4*)(PH + row * 256 + c0), f1 = *(const u32x4*)(PH + row * 256 + c0 + 4), r0 = *(const u32x4*)(PH + ((size_t)17408 + row) * 256 + c0), r1 = *(const u32x4*)(PH + ((size_t)17408 + row) * 256 + c0 + 4);
        const u32x4 lg = *(const u32x4*)(PROJ + row * 2560 + 256 + c0);
        const unsigned ff[8] = {f0.x, f0.y, f0.z, f0.w, f1.x, f1.y, f1.z, f1.w}, rr[8] = {r0.x, r0.y, r0.z, r0.w, r1.x, r1.y, r1.z, r1.w}; const unsigned lgw[4] = {lg.x, lg.y, lg.z, lg.w};
        float y[8];
#pragma unroll
        for (int k = 0; k < 8; ++k) { const float hf = *(const LRU_LAS float*)(lds + (c0 + k) * 4), hr = *(const LRU_LAS float*)(lds + (256 + c0 + k) * 4);
            const float h = (__uint_as_float(ff[k] & 0xffff0000u) + __uint_as_float(ff[k] << 16) * hf) + (__uint_as_float(rr[k] & 0xffff0000u) + __uint_as_float(rr[k] << 16) * hr);
            const float g = (k & 1) ? __uint_as_float(lgw[k >> 1] & 0xffff0000u) : __uint_as_float(lgw[k >> 1] << 16); y[k] = h * g; }
        u32x4 o; o.x = cvtpk2(y[0], y[1]); o.y = cvtpk2(y[2], y[3]); o.z = cvtpk2(y[4], y[5]); o.w = cvtpk2(y[6], y[7]);
        *(u32x4*)(Y + row * 1024 + c0) = o; }
    __syncthreads();
}
}

#include <utility>
constexpr int NWAVES = 8;
constexpr int RING_OFF = 0, RING_BYTES = 150528;
constexpr int LDSCTL_OFF = RING_BYTES, MISC_OFF = LDSCTL_OFF + 320;
constexpr int LDS_BYTES = 155648;
constexpr int CW_BAR = 4096;
constexpr int MAX_LAUNCHES = 16;
static_assert((CW_BAR + MAX_LAUNCHES * XCD_BAR_WORDS) * 4 <= (int)(1u << 20), "CTL words inside the memset region");

constexpr int PH_PRO = 0, PH_PRO2 = 1, PH_L0 = 2, PH_PER_LAYER = 11, PH_FINAL = PH_L0 + 2 * PH_PER_LAYER, NPH = PH_FINAL + 1;
constexpr int EPI_OFF = LDSCTL_OFF + 1024;

#ifndef MK_REPEAT_PH
#define MK_REPEAT_PH (-1)
#endif
struct Args { const float* in[24]; float* out; unsigned char* ws; int ph_lo, ph_hi, li, rep; };

__device__ __forceinline__ float shfl_xor_l(float v, int mask, int lane) { return __int_as_float(__builtin_amdgcn_ds_bpermute((lane ^ mask) << 2, __float_as_int(v))); }
__device__ __forceinline__ float wave_sum(float v, int lane) {
#pragma unroll
    for (int o = 1; o < 64; o <<= 1) v += shfl_xor_l(v, o, lane);
    return v;
}
__device__ __forceinline__ unsigned pk2(float lo, float hi) { return cvtpk2(lo, hi); }

__device__ __forceinline__ void p0_transpose_item(const float* W, int K, int N, bf16_t* WT, int kind, LAS float* scr, int item, int lane) {
    const int nblk = N / 64, kb = item / nblk, nb = item % nblk, k0 = 64 * kb, n0 = 64 * nb;
    const int rr = lane >> 4, cq = lane & 15;
    f32x4 v[16];
#pragma unroll
    for (int i = 0; i < 16; ++i) v[i] = *(const f32x4*)(W + (size_t)(k0 + 4 * i + rr) * N + n0 + 4 * cq);
#pragma unroll
    for (int i = 0; i < 16; ++i) { LAS float* p = scr + (4 * i + rr) * 65 + 4 * cq; p[0] = v[i].x; p[1] = v[i].y; p[2] = v[i].z; p[3] = v[i].w; }
    LDS_WAIT(); asm volatile("" ::: "memory");
    const int c = lane & 7;
#pragma unroll
    for (int j = 0; j < 8; ++j) { const int n = (lane >> 3) + 8 * j; const LAS float* s = scr + (8 * c) * 65 + n;
        v4u o; o.x = pk2(s[0 * 65], s[1 * 65]); o.y = pk2(s[2 * 65], s[3 * 65]); o.z = pk2(s[4 * 65], s[5 * 65]); o.w = pk2(s[6 * 65], s[7 * 65]);
        *(GAS v4u*)(WT + (size_t)dest_row(kind, n0 + n) * K + k0 + 8 * c) = o; }
    LDS_WAIT(); asm volatile("" ::: "memory");
}

struct ConvDesc { const float* W; bf16_t* WT; int K, N, kind, item; };
__device__ __forceinline__ void p0_load(const ConvDesc& d, f32x4 (&v)[16], int lane) {
    const int nblk = d.N / 64, kb = d.item / nblk, nb = d.item % nblk, k0 = 64 * kb, n0 = 64 * nb; const int rr = lane >> 4, cq = lane & 15;
#pragma unroll
    for (int i = 0; i < 16; ++i) v[i] = *(const f32x4*)(d.W + (size_t)(k0 + 4 * i + rr) * d.N + n0 + 4 * cq);
}
__device__ __forceinline__ void p0_finish(const ConvDesc& d, const f32x4 (&v)[16], LAS float* scr, int lane) {
    const int nblk = d.N / 64, kb = d.item / nblk, nb = d.item % nblk, k0 = 64 * kb, n0 = 64 * nb; const int rr = lane >> 4, cq = lane & 15;
#pragma unroll
    for (int i = 0; i < 16; ++i) { LAS float* p = scr + (4 * i + rr) * 65 + 4 * cq; p[0] = v[i].x; p[1] = v[i].y; p[2] = v[i].z; p[3] = v[i].w; }
    LDS_WAIT(); asm volatile("" ::: "memory");
    const int c = lane & 7;
#pragma unroll
    for (int j = 0; j < 8; ++j) { const int n = (lane >> 3) + 8 * j; const LAS float* s = scr + (8 * c) * 65 + n;
        v4u o; o.x = pk2(s[0 * 65], s[1 * 65]); o.y = pk2(s[2 * 65], s[3 * 65]); o.z = pk2(s[4 * 65], s[5 * 65]); o.w = pk2(s[6 * 65], s[7 * 65]);
        *(GAS v4u*)(d.WT + (size_t)dest_row(d.kind, n0 + n) * d.K + k0 + 8 * c) = o; }
    LDS_WAIT(); asm volatile("" ::: "memory");
}

__device__ __forceinline__ void norm_row(const float* src, const float* g, const float* shift, const float* scale, bf16_t* orow, int lane) {
    const f32x4* xr = (const f32x4*)src + lane; f32x4 v[4]; float s = 0.f;
#pragma unroll
    for (int j = 0; j < 4; ++j) { v[j] = xr[64 * j]; s += (v[j].x * v[j].x + v[j].y * v[j].y) + (v[j].z * v[j].z + v[j].w * v[j].w); }
    const float rstd = 1.0f / sqrtf(wave_sum(s, lane) * (1.0f / D) + 1e-6f);
    unsigned long long* o8 = (unsigned long long*)orow + lane;
#pragma unroll
    for (int j = 0; j < 4; ++j) { const int c0 = (lane + 64 * j) * 4; const f32x4 gg = *(const f32x4*)(g + c0), sc = *(const f32x4*)(scale + c0), sh = *(const f32x4*)(shift + c0);
        const f32x4 y = v[j] * rstd * gg * (sc + 1.0f) + sh;
        o8[64 * j] = (unsigned long long)pk2(y.x, y.y) | ((unsigned long long)pk2(y.z, y.w) << 32); }
}

__device__ __forceinline__ void norm_regs(const f32x4 (&v)[4], const float* g, const float* shift, const float* scale, bf16_t* orow, int lane) {
    float s = 0.f;
#pragma unroll
    for (int j = 0; j < 4; ++j) s += (v[j].x * v[j].x + v[j].y * v[j].y) + (v[j].z * v[j].z + v[j].w * v[j].w);
    const float rstd = 1.0f / sqrtf(wave_sum(s, lane) * (1.0f / D) + 1e-6f);
    unsigned long long* o8 = (unsigned long long*)orow + lane;
#pragma unroll
    for (int j = 0; j < 4; ++j) { const int c0 = (lane + 64 * j) * 4; const f32x4 gg = *(const f32x4*)(g + c0), sc = *(const f32x4*)(scale + c0), sh = *(const f32x4*)(shift + c0);
        const f32x4 y = v[j] * rstd * gg * (sc + 1.0f) + sh;
        o8[64 * j] = (unsigned long long)pk2(y.x, y.y) | ((unsigned long long)pk2(y.z, y.w) << 32); }
}

constexpr int I_GU = (D / 64) * (2 * DFF / 64), I_DN = (DFF / 64) * (D / 64), I_IN = (D / 64) * (NIN / 64), I_OUT = (D / 64) * (D / 64);
constexpr int R_GU1 = 0, R_GU2 = I_GU, R_DN1 = 2 * I_GU, R_DN2 = R_DN1 + I_DN, R_IN = R_DN2 + I_DN, R_OUT = R_IN + I_IN, I_LAYER = R_OUT + I_OUT;

struct KCtx { LAS unsigned char* lds; unsigned char* ws; float* out; const __attribute__((address_space(4))) unsigned long long* kin; int wave0, vcu, G, bx, ph_lo, ph_end; XcdBarrier bar; };
#define tidq() ({ int tq_ = tid; asm volatile("" : "+v"(tq_)); tq_; })
#define KIN(i) ((const float*)(const GAS float*)(kin[(i) + kz]))
template <int PHI> __device__ __forceinline__ void run_phase(const KCtx& kc) {
    if (PHI < kc.ph_lo || PHI >= kc.ph_end) return;
    constexpr int ph = (MK_REPEAT_PH >= 0 && PHI > MK_REPEAT_PH) ? PHI - 1 : PHI;
    LAS unsigned char* lds = kc.lds; unsigned char* ws = kc.ws; const __attribute__((address_space(4))) unsigned long long* kin = kc.kin;
    const int wave0 = kc.wave0, vcu = kc.vcu, G = kc.G, bx = kc.bx, NGW = kc.G * NWAVES;
    struct { float* out; } args; args.out = kc.out;
        unsigned lz = 0u; asm volatile("" : "+v"(lz)); const int lane_o = (int)__builtin_amdgcn_mbcnt_hi(~0u, __builtin_amdgcn_mbcnt_lo(~0u, lz));
        const int lane = lane_o, wave = wave0, tid = wave0 * 64 + lane_o, gw = vcu * NWAVES + wave;
        int kz = 0; asm volatile("" : "+s"(kz));
        unsigned long long wsi = (unsigned long long)ws; asm volatile("" : "+s"(wsi)); unsigned char* wsp = (unsigned char*)(GAS unsigned char*)wsi;
        float* MOD = (float*)(wsp + WS_MOD); Tab* T = (Tab*)(wsp + WS_TAB); bf16_t* W = (bf16_t*)(wsp + WS_W); float* H = (float*)(wsp + WS_H);
        bf16_t* HB = (bf16_t*)(wsp + WS_R); bf16_t* PROJ = (bf16_t*)(wsp + WS_R + R_PROJ); bf16_t* Y = (bf16_t*)(wsp + WS_R + R_Y);
        unsigned long long outi = (unsigned long long)args.out; asm volatile("" : "+s"(outi)); float* outp = (float*)(GAS float*)outi; bf16_t* XN = (bf16_t*)outp;
        auto conv_desc = [&](int l, int r) -> ConvDesc {
            const float* src; int K_, N_, kind; size_t off;
            if (r < R_GU2)      {             src = KIN(7)  + (size_t)l * D * 2 * DFF; K_ = D;   N_ = 2 * DFF; kind = 1; off = OFF_GU1; }
            else if (r < R_DN1) { r -= R_GU2; src = KIN(9)  + (size_t)l * D * 2 * DFF; K_ = D;   N_ = 2 * DFF; kind = 1; off = OFF_GU2; }
            else if (r < R_DN2) { r -= R_DN1; src = KIN(8)  + (size_t)l * DFF * D;     K_ = DFF; N_ = D;       kind = 0; off = OFF_DN1; }
            else if (r < R_IN)  { r -= R_DN2; src = KIN(10) + (size_t)l * DFF * D;     K_ = DFF; N_ = D;       kind = 0; off = OFF_DN2; }
            else if (r < R_OUT) { r -= R_IN;  src = KIN(11) + (size_t)l * D * NIN;     K_ = D;   N_ = NIN;     kind = 2; off = OFF_IN; }
            else                { r -= R_OUT; src = KIN(12) + (size_t)l * D * D;       K_ = D;   N_ = D;       kind = 0; off = OFF_OUT; }
            return ConvDesc{src, W + (size_t)l * W_LAYER + off, K_, N_, kind, r};
        };
        auto conv_range = [&](int l, int r0, int r1, int nb, int bi) {
            const int step = nb * NWAVES; int r = r0 + bi * NWAVES + wave; if (r >= r1) return;
            LAS float* scr = (LAS float*)(lds + wave * 16896);
            ConvDesc dc = conv_desc(l, r); f32x4 vc[16]; p0_load(dc, vc, lane);
            for (;;) {
                const int rn = r + step; const bool hn = rn < r1; ConvDesc dn = conv_desc(l, hn ? rn : r); f32x4 vn[16];
                if (hn) p0_load(dn, vn, lane);
                p0_finish(dc, vc, scr, lane);
                if (!hn) break;
#pragma unroll
                for (int i = 0; i < 16; ++i) vc[i] = vn[i];
                dc = dn; r = rn;
            }
        };
        auto sw_rows = [&](int l, int k, int nb, int bi) {
            const int N = (k == 1) ? NIN : 2 * DFF; const bf16_t* Wt = W + (size_t)l * W_LAYER + (k == 0 ? OFF_GU1 : k == 1 ? OFF_IN : OFF_GU2); float* SWp = (float*)(wsp + WS_SW) + (size_t)(l * 3 + k) * 4 * 5632;
            f32x4 sh[4][4];
#pragma unroll
            for (int b = 0; b < 4; ++b)
#pragma unroll
                for (int j = 0; j < 4; ++j) sh[b][j] = *(const f32x4*)(MOD + (size_t)l * 5 * NMODW + (size_t)b * NMODW + (3 * k) * D + lane * 16 + 4 * j);
            const int stride = nb * NWAVES;
            for (int p0 = bi * NWAVES + wave; p0 < N; p0 += 4 * stride) {
                int pr[4]; bool hv[4]; v4u w0[4], w1[4];
#pragma unroll
                for (int q = 0; q < 4; ++q) { pr[q] = p0 + q * stride; hv[q] = pr[q] < N; const int pc = hv[q] ? pr[q] : p0; w0[q] = *(const v4u*)(Wt + (size_t)pc * D + lane * 16); w1[q] = *(const v4u*)(Wt + (size_t)pc * D + lane * 16 + 8); }
                float a[4][4];
#pragma unroll
                for (int q = 0; q < 4; ++q) { const unsigned ww[8] = {w0[q].x, w0[q].y, w0[q].z, w0[q].w, w1[q].x, w1[q].y, w1[q].z, w1[q].w};
#pragma unroll
                    for (int b = 0; b < 4; ++b) a[q][b] = 0.f;
#pragma unroll
                    for (int j = 0; j < 8; ++j) { const float lo = __uint_as_float(ww[j] << 16), hi = __uint_as_float(ww[j] & 0xffff0000u);
#pragma unroll
                        for (int b = 0; b < 4; ++b) a[q][b] += lo * sh[b][j >> 1][(2 * j) & 3] + hi * sh[b][j >> 1][(2 * j + 1) & 3]; } }
#pragma unroll
                for (int q = 0; q < 4; ++q)
#pragma unroll
                    for (int b = 0; b < 4; ++b) { const float sa = wave_sum(a[q][b], lane); if (lane == 0 && hv[q]) SWp[(size_t)b * 5632 + pr[q]] = sa; }
            }
        };
        if (ph == PH_PRO) {
            const float* cc = KIN(1); const float* c_ctx = KIN(3); const float* w_ada = KIN(4); const float* b_ada = KIN(5);
            LAS float* sc = (LAS float*)lds; LAS float* red = (LAS float*)(lds + 20480);
            for (int i = tid; i < 5 * 1024; i += NWAVES * 64) { const int b = i >> 10, k = i & 1023; const float v = b < 4 ? cc[b * 1024 + k] : c_ctx[k]; sc[i] = v / (1.f + __expf(-v)); }
            __syncthreads();
            for (int item = bx; item < 288; item += G) {
                const int l = item / 144, col0 = (item % 144) * 64, cq = tid & 15, kg = tid >> 4;
                const float* wp = w_ada + (size_t)l * D * NMODW + (size_t)(kg * 32) * NMODW + col0 + 4 * cq;
                f32x4 a0 = {0, 0, 0, 0}, a1 = a0, a2 = a0, a3 = a0, a4 = a0;
#pragma unroll 8
                for (int k = 0; k < 32; ++k) { const f32x4 wv = *(const f32x4*)(wp + (size_t)k * NMODW); const int kk = kg * 32 + k;
                    a0 += wv * sc[kk]; a1 += wv * sc[1024 + kk]; a2 += wv * sc[2048 + kk]; a3 += wv * sc[3072 + kk]; a4 += wv * sc[4096 + kk]; }
                LAS f32x4* rp = (LAS f32x4*)(red + (size_t)kg * 320 + 4 * cq);
                rp[0] = a0; rp[16] = a1; rp[32] = a2; rp[48] = a3; rp[64] = a4;
                __syncthreads();
                if (tid < 320) { float s = 0.f;
#pragma unroll 8
                    for (int k = 0; k < 32; ++k) s += red[k * 320 + tid];
                    const int b = tid >> 6, cidx = tid & 63; MOD[(size_t)l * 5 * NMODW + (size_t)b * NMODW + col0 + cidx] = s + b_ada[l * NMODW + col0 + cidx]; }
                __syncthreads();
            }
            for (int i = (bx * NWAVES * 64 + tid); i < 2 * 65536; i += G * NWAVES * 64) {
                const int l = i >> 16, r = i & 65535; const int c = r & 63, d = (r >> 6) & 63, ri = (r >> 12) & 1, blk = (r >> 13) & 3, dir = r >> 15;
                const float* src = (ri ? KIN(17) : KIN(15)) + (size_t)l * 32768;
                W[(size_t)l * W_LAYER + OFF_LRU + r] = f2bf(src[((size_t)(dir * 4 + blk) * 64 + c) * 64 + d]);
            }
            conv_range(0, R_GU1, R_GU2, G, bx);
        } else if (ph == PH_FINAL) {
            const float* fg = KIN(23); const bf16_t* Hb = (const bf16_t*)(wsp + WS_H);
            for (int row = gw; row < ML; row += NGW) {
                const v4u w0 = *(const v4u*)(Hb + (size_t)row * D + lane * 16), w1 = *(const v4u*)(Hb + (size_t)row * D + lane * 16 + 8);
                const unsigned ww[8] = {w0.x, w0.y, w0.z, w0.w, w1.x, w1.y, w1.z, w1.w}; float v[16]; float sq = 0.f;
#pragma unroll
                for (int j = 0; j < 8; ++j) { v[2 * j] = __uint_as_float(ww[j] << 16); v[2 * j + 1] = __uint_as_float(ww[j] & 0xffff0000u); sq += v[2 * j] * v[2 * j] + v[2 * j + 1] * v[2 * j + 1]; }
                const float rstd = 1.0f / sqrtf(wave_sum(sq, lane) * (1.0f / D) + 1e-6f);
#pragma unroll
                for (int j = 0; j < 4; ++j) { const f32x4 g4 = *(const f32x4*)(fg + lane * 16 + 4 * j); f32x4 o; o.x = v[4 * j] * rstd * g4.x; o.y = v[4 * j + 1] * rstd * g4.y; o.z = v[4 * j + 2] * rstd * g4.z; o.w = v[4 * j + 3] * rstd * g4.w;
                    *(f32x4*)(outp + (size_t)row * D + lane * 16 + 4 * j) = o; }
            }
        } else if (ph == PH_PRO2) {
            float* GS = (float*)(wsp + WS_GS); float* SW = (float*)(wsp + WS_SW); float* SSQ = (float*)(wsp + WS_SSQ);
            for (int i = bx * NWAVES * 64 + tid; i < 2 * 3 * 5 * D; i += G * NWAVES * 64) { const int c = i & 1023, b = (i >> 10) % 5, k = ((i >> 10) / 5) % 3, l = (i >> 10) / 15;
                GS[i] = KIN(6)[(size_t)(l * 3 + k) * D + c] * (1.0f + MOD[(size_t)l * 5 * NMODW + (size_t)b * NMODW + (3 * k + 1) * D + c]); }
            sw_rows(0, 0, G, bx);
            { const float* x = KIN(0); const float* ctxp = KIN(2); const float* g0 = KIN(6);
              for (int row = gw; row < M; row += NGW) {
                if (row < ML) { const int b = row >> 12; const float* sc = MOD + (size_t)b * NMODW + D; const f32x4* xr = (const f32x4*)(x + (size_t)row * D) + lane; float s = 0.f;
                    unsigned long long* o8 = (unsigned long long*)(XN + (size_t)row * D) + lane; unsigned long long* h8 = (unsigned long long*)((bf16_t*)H + (size_t)row * D) + lane;
#pragma unroll
                    for (int j = 0; j < 4; ++j) { const f32x4 v = xr[64 * j]; const int c0 = (lane + 64 * j) * 4; s += (v.x * v.x + v.y * v.y) + (v.z * v.z + v.w * v.w);
                        h8[64 * j] = (unsigned long long)pk2(v.x, v.y) | ((unsigned long long)pk2(v.z, v.w) << 32);
                        const f32x4 y = v * *(const f32x4*)(g0 + c0) * (*(const f32x4*)(sc + c0) + 1.0f); o8[64 * j] = (unsigned long long)pk2(y.x, y.y) | ((unsigned long long)pk2(y.z, y.w) << 32); }
                    s = wave_sum(s, lane); if (lane == 0) *(f32x4*)(SSQ + (size_t)row * 4) = (f32x4){s, 0.f, 0.f, 0.f};
                } else { const float* src = ctxp + (size_t)(row - ML) * D; const float* shift = MOD + (size_t)4 * NMODW;
                    norm_row(src, g0, shift, shift + D, XN + (size_t)row * D, lane);
#pragma unroll
                    for (int j = 0; j < 4; ++j) ((f32x4*)(H + (size_t)row * D))[lane + 64 * j] = ((const f32x4*)src)[lane + 64 * j]; }
              } }
        } else {
            const int l = (ph - PH_L0) / PH_PER_LAYER, ty = (ph - PH_L0) % PH_PER_LAYER; const bool last = (l == 1);
            if (last && (ty == T_NC2 || ty == T_NC3)) return;
            bf16_t* Wl = W + (size_t)l * W_LAYER; const float* MODl = MOD + (size_t)l * 5 * NMODW;
            float* SSQ = (float*)(wsp + WS_SSQ); const float* GS = (const float*)(wsp + WS_GS); const float* SW = (const float*)(wsp + WS_SW);
            const int mrows = (last && ty >= T_OUT) ? ML : M;
            if (ty == T_NC1 || ty == T_NC2 || ty == T_NC3) {
                const int kk = (ty == T_NC1) ? 1 : (ty == T_NC2) ? 2 : 0, ln = (ty == T_NC3) ? l + 1 : l;
                const float* shift = MOD + (size_t)ln * 5 * NMODW + (size_t)4 * NMODW + (3 * kk) * D; const float* ngn = KIN(6) + (size_t)(ln * 3 + kk) * D;
                const int ns = (ty == T_NC2) ? 4 : 11;
                for (int row = ML + gw; row < M; row += NGW) {
                    f32x4* hr = (f32x4*)(H + (size_t)row * D) + lane; f32x4 v[4];
#pragma unroll
                    for (int j = 0; j < 4; ++j) v[j] = hr[64 * j];
#define NC_ALL(cnt_) do { typedef unsigned u32x2n __attribute__((ext_vector_type(2))); u32x2n w_[cnt_][4]; \
                        _Pragma("unroll") for (int q_ = 0; q_ < (cnt_); ++q_) { const u32x2n* sp = (const u32x2n*)((const bf16_t*)pg8::slab_ptr(wsi, outi, q_) + (size_t)(row - ML) * D) + lane; \
                            _Pragma("unroll") for (int j = 0; j < 4; ++j) w_[q_][j] = sp[64 * j]; } \
                        _Pragma("unroll") for (int q_ = 0; q_ < (cnt_); ++q_) _Pragma("unroll") for (int j = 0; j < 4; ++j) { const u32x2n t_ = w_[q_][j]; \
                            v[j] += (f32x4){__uint_as_float(t_.x << 16), __uint_as_float(t_.x & 0xffff0000u), __uint_as_float(t_.y << 16), __uint_as_float(t_.y & 0xffff0000u)}; } } while (0)
                    if (ns == 11) { NC_ALL(11); } else { NC_ALL(4); }
#undef NC_ALL
                    norm_regs(v, ngn, shift, shift + D, XN + (size_t)row * D, lane);
#pragma unroll
                    for (int j = 0; j < 4; ++j) hr[64 * j] = v[j];
                }
            } else if (ty == T_GU1 || ty == T_GU2) {
                pg8::Gemm g{XN, Wl + (ty == T_GU1 ? OFF_GU1 : OFF_GU2), mrows, 2 * DFF, D, D}; pg8::StaticOrder So; So.init(mrows, 2 * DFF, G, bx);
                pg8::EpiGU E{pg8::EpiCtx{wsi, outi, kin, l, ty}};
                pg8::gemm_phase<pg8::EpiGU, pg8::StaticOrder, true, true>(lds + RING_OFF, g, So, E, tidq());
                if (bx >= 216) {
                    const int bi = bx - 216;
                    if (l == 0 && ty == T_GU1) { conv_range(0, R_DN1, R_DN2, 40, bi); conv_range(0, R_IN, R_OUT, 40, bi); }
                    if (l == 0 && ty == T_GU2) { conv_range(1, R_GU1, R_GU2, 40, bi); }
                    if (l == 1 && ty == T_GU1) { conv_range(1, R_DN1, R_DN2, 40, bi); conv_range(1, R_IN, R_OUT, 40, bi); }
                }
            } else if (ty == T_DN1 || ty == T_DN2 || ty == T_OUT) {
                const bf16_t* A = (ty == T_OUT) ? Y : HB; const int K = (ty == T_OUT) ? D : DFF;
                const bf16_t* Bt = Wl + (ty == T_DN1 ? OFF_DN1 : ty == T_DN2 ? OFF_DN2 : OFF_OUT);
                {
                    pg8::Gemm g{A, Bt, M, D, K, K}; pg8::DnOrder So; So.so.init(ML, D, G, bx); So.ns = (mrows == M) ? K / 256 : 0; So.KS = 256; So.ntl = K / 64;
                    pg8::EpiDn E{pg8::EpiRes{pg8::EpiCtx{wsi, outi, kin, l, ty}, (LAS float*)(lds + EPI_OFF)}, pg8::EpiResAt{pg8::EpiCtx{wsi, outi, kin, l, ty}}};
                    pg8::gemm_phase<pg8::EpiDn, pg8::DnOrder, true, true>(lds + RING_OFF, g, So, E, tidq());
                }
                if (ty == T_DN1 && bx < 80)  { sw_rows(l, 1, 80, bx); conv_range(l, R_OUT, I_LAYER, 80, bx); }
                if (l == 0 && ty == T_OUT && bx < 192) { sw_rows(0, 2, 192, bx); sw_rows(1, 2, 192, bx); }
                if (l == 0 && ty == T_DN2 && bx < 80)  { sw_rows(1, 0, 80, bx); }
            } else if (ty == T_IN) {
                pg8::Gemm g{XN, Wl + OFF_IN, M, NIN, D, D}; pg8::StaticOrder So; So.init(M, NIN, G, bx);
                { const int tq = tidq(); *(LAS f32x4*)(lds + RING_OFF + pg8::STAGE_BYTES + 10240 + tq * 16) = *((const f32x4*)T->cosv + tq); asm volatile("s_waitcnt vmcnt(0) lgkmcnt(0)" ::: "memory"); __syncthreads(); }
                pg8::EpiIN E{pg8::EpiCtx{wsi, outi, kin, l, ty}, (const LAS float*)(lds + RING_OFF + pg8::STAGE_BYTES + 10240)};
                pg8::gemm_phase<pg8::EpiIN, pg8::StaticOrder, true, true>(lds + RING_OFF, g, So, E, tidq());
                if (bx >= 168) {
                    const int bi = bx - 168; if (l == 0) conv_range(0, R_GU2, R_DN1, 88, bi); conv_range(l, R_DN2, R_IN, 88, bi);
                }
            } else if (ty == T_M2) {
                return;
            } else if (ty == T_M1) {
              const float* cw = KIN(13) + (size_t)l * 1024; const float* cb = KIN(14) + (size_t)l * 256; const float* lbr = KIN(16) + (size_t)l * 512; const float* lbi = KIN(18) + (size_t)l * 512;
              float* SUMM = (float*)(wsp + WS_SUMM); unsigned* PH = (unsigned*)outp;
              gu32* lcnt = (gu32*)(wsp + WS_CTL) + 2048 + 64 * l;
              { unsigned nloc = 0;
                for (int u = vcu; u < 288; u += G) { int b, ck, mode; if (u < 256) { b = u >> 6; ck = 4 + (u & 63); mode = 0; } else { const int i2 = u - 256; b = i2 >> 3; ck = (i2 >> 1) & 3; mode = 1 + (i2 & 1); }
                    int tq = tid; asm volatile("" : "+v"(tq));
                    lru::lru_unit<false>(lds, PROJ, Y, Wl + OFF_LRU, cw, cb, lbr, lbi, T->lruc + l * 512, SUMM, PH, b, ck, mode, tq); ++nloc; }
                asm volatile("s_waitcnt vmcnt(0)" ::: "memory"); __syncthreads();
                if (wave == 0 && lane == 0) { __builtin_amdgcn_fence(__ATOMIC_RELEASE, "agent"); asm volatile("s_waitcnt vmcnt(0)" ::: "memory"); __hip_atomic_fetch_add(lcnt, nloc, __ATOMIC_RELAXED, __HIP_MEMORY_SCOPE_AGENT); }
              }
              {
                const float* sink = KIN(20) + l * 4;
                {
                    const int idx = vcu, b = idx >> 6, kvh = (idx >> 5) & 1, q0 = 128 * (idx & 31), g = wave >> 2, head = 2 * kvh + g;
                    att::TileSeq ts; ts.b = b; ts.mode = 1; ts.q0 = q0; ts.jlo = (q0 == 0) ? 2 : 0; { const int jh = (S - q0 + 128) / 64; ts.nt = 4 + ((jh < 6) ? jh : 6) - ts.jlo; }
                    { int tq = tid; asm volatile("" : "+v"(tq)); att::attn_unit<1, 2, 3, false>(lds, PROJ, Y, ts, b * S + q0 + 32 * (wave & 3), 512 + 64 * head, 768 + 64 * kvh, 896 + 64 * kvh, 256 + 64 * head, q0 + 32 * (wave & 3), sink[head] * LOG2E, 0.f, nullptr, 0.f, tq); }
                }
                if (!last && vcu >= 32 && vcu < 48) {
                    const int idx = vcu - 32, b = idx >> 2, kvh = (idx >> 1) & 1, qb = idx & 1, g = wave >> 2, head = 2 * kvh + g;
                    att::TileSeq ts; ts.b = b; ts.mode = 2; ts.q0 = 0; ts.jlo = 0; ts.nt = 4;
                    { int tq = tid; asm volatile("" : "+v"(tq)); att::attn_unit<1, 2, 3, false>(lds, PROJ, Y, ts, ML + b * LC + 128 * qb + 32 * (wave & 3), 512 + 64 * head, 768 + 64 * kvh, 896 + 64 * kvh, 256 + 64 * head, 0, sink[head] * LOG2E, 0.f, nullptr, 0.f, tq); }
                }
              }
              {
                const float lam = T->lam[l]; const float* subg = KIN(22) + l * 128; const float oml = 1.0f - (0.8f - 0.6f * __expf(-0.3f * (float)l));
                {
                    const int idx = vcu, b = idx >> 6, h = (idx >> 4) & 3, q0 = 256 * (idx & 15);
                    att::TileSeq ts; ts.b = b; ts.mode = 0; ts.q0 = 0; ts.jlo = 0; ts.nt = 68;
                    { int tq = tid; asm volatile("" : "+v"(tq)); att::attn_unit_pp<2, 4>(lds, PROJ, Y, ts, b * S + q0 + 32 * wave, 1024 + 128 * h, 1536 + 128 * h, 2048 + 128 * h, 512 + 128 * h, lam, subg, oml, tq); }
                }
                if (!last && vcu >= 48 && vcu < 64) {
                    const int idx = vcu - 48, b = idx >> 2, h = idx & 3;
                    att::TileSeq ts; ts.b = b; ts.mode = 2; ts.q0 = 0; ts.jlo = 0; ts.nt = 4;
                    { int tq = tid; asm volatile("" : "+v"(tq)); att::attn_unit_pp<2, 4>(lds, PROJ, Y, ts, ML + b * LC + 32 * wave, 1024 + 128 * h, 1536 + 128 * h, 2048 + 128 * h, 512 + 128 * h, lam, subg, oml, tq); }
                }
              }
              if (wave == 0) {
                  if (lane == 0) { unsigned spins = 0; while (__hip_atomic_load(lcnt, __ATOMIC_RELAXED, __HIP_MEMORY_SCOPE_AGENT) < 288u) { __builtin_amdgcn_s_sleep(8); if (++spins > (1u << 20)) break; } }
                  __builtin_amdgcn_fence(__ATOMIC_ACQUIRE, "agent"); asm volatile("s_waitcnt vmcnt(0)" ::: "memory");
              }
              __syncthreads();
              for (int u = vcu; u < 272; u += G) { const int b = u / 68, ck = u % 68; int tq = tid; asm volatile("" : "+v"(tq));
                  if (!(last && ck < 4)) lru::lru_final_unit(lds, PROJ, Y, SUMM, PH, b, ck, tq); }
              if (l == 0 && vcu >= 64) { __syncthreads(); conv_range(1, R_GU2, R_DN1, 192, vcu - 64); }
            }
        }
    if (PHI + 1 < kc.ph_end) xcd_barrier(kc.bar);
}
template <int... I> __device__ __forceinline__ void run_all(const KCtx& kc, std::integer_sequence<int, I...>) { (run_phase<I>(kc), ...); }

__global__ void __launch_bounds__(NWAVES * 64, 2) mk_fwd(Args args) {
    extern __shared__ __attribute__((aligned(16))) unsigned char lds_raw[];
    LAS unsigned char* lds = (LAS unsigned char*)lds_raw;
    volatile LAS unsigned* MISC = (volatile LAS unsigned*)(lds + MISC_OFF);
    const int tid0 = threadIdx.x; const int wave0 = __builtin_amdgcn_readfirstlane(tid0 >> 6);
    const int G = gridDim.x; const int bx = blockIdx.x; const int vcu = (G % 8 == 0) ? (bx % 8) * (G / 8) + bx / 8 : bx;
    unsigned char* ws = args.ws;
    gu32* ctl = (gu32*)(ws + WS_CTL);
    for (int u = tid0; u < (LDS_BYTES - LDSCTL_OFF) / 4; u += NWAVES * 64) ((LAS unsigned*)(lds + LDSCTL_OFF))[u] = 0u;
    __syncthreads();
    XcdBarrier bar = xcd_barrier_post((unsigned*)(ctl + CW_BAR) + args.li * XCD_BAR_WORDS, MISC + 8);

    const __attribute__((address_space(4))) unsigned long long* kin = (const __attribute__((address_space(4))) unsigned long long*)__builtin_amdgcn_kernarg_segment_ptr();
    const int NGW = G * NWAVES;

    if (args.ph_lo == PH_PRO && bx == 0) {
                const int tid = tid0; Tab* T = (Tab*)(ws + WS_TAB); const int kz = 0;
                const float* lru_lambda = KIN(19); const float* diff_lambda = KIN(21);
                for (int i = tid; i < 1024; i += NWAVES * 64) {
                    const int pos = i >> 4, f = i & 15;
                    const double q[4] = {1.0, 0.5623413251903491, 0.31622776601683794, 0.1778279410038923};
                    double inv = (f & 3) == 0 ? q[0] : (f & 3) == 1 ? q[1] : (f & 3) == 2 ? q[2] : q[3]; for (int j = 0; j < (f >> 2); ++j) inv *= 0.1;
                    const float ang = (float)pos * (float)inv;
                    double xx = (double)ang; const double TWO_PI = 6.283185307179586476925287, PI = 3.141592653589793238462643;
                    const double k = rint(xx * 0.15915494309189533577); double r = xx - k * TWO_PI;
                    double sgn = 1.0; if (r > PI * 0.5) { r = PI - r; sgn = -1.0; } else if (r < -PI * 0.5) { r = -PI - r; sgn = -1.0; }
                    const double r2 = r * r;
                    double ss = -1.9572941063391263e-20; ss = ss * r2 + 8.2206352466243295e-18; ss = ss * r2 - 2.8114572543455206e-15; ss = ss * r2 + 7.6471637318198164e-13; ss = ss * r2 - 1.6059043836821613e-10;
                    ss = ss * r2 + 2.5052108385441720e-08; ss = ss * r2 - 2.7557319223985893e-06; ss = ss * r2 + 1.9841269841269841e-04; ss = ss * r2 - 8.3333333333333332e-03; ss = ss * r2 + 1.6666666666666666e-01; ss = r - r * r2 * ss;
                    double cs = 4.1103176233121648e-19; cs = cs * r2 - 1.5619206968586226e-16; cs = cs * r2 + 4.7794773323873853e-14; cs = cs * r2 - 1.1470745597729725e-11; cs = cs * r2 + 2.0876756987868100e-09;
                    cs = cs * r2 - 2.7557319223985888e-07; cs = cs * r2 + 2.4801587301587302e-05; cs = cs * r2 - 1.3888888888888889e-03; cs = cs * r2 + 4.1666666666666664e-02; cs = cs * r2 - 0.5; cs = cs * r2 + 1.0;
                    T->cosv[i] = (float)(sgn * cs); T->sinv[i] = (float)ss;
                    T->lruc[i] = -8.0f * log1pf(expf(-lru_lambda[i]));
                }
                if (tid < 2) { const float* dl = diff_lambda + tid * 256; float s0 = 0.f, s1 = 0.f;
                    for (int j = 0; j < 64; ++j) { s0 += dl[j] * dl[64 + j]; s1 += dl[128 + j] * dl[192 + j]; }
                    T->lam[tid] = expf(s0) - expf(s1) + (0.8f - 0.6f * expf(-0.3f * (float)tid)); }
            }
    KCtx kc; kc.lds = lds; kc.ws = ws; kc.out = args.out; kc.kin = kin; kc.wave0 = wave0; kc.vcu = vcu; kc.G = G; kc.bx = bx; kc.ph_lo = args.ph_lo; kc.ph_end = args.ph_hi + (MK_REPEAT_PH >= 0 ? 1 : 0); kc.bar = bar;
    run_all(kc, std::make_integer_sequence<int, NPH + (MK_REPEAT_PH >= 0 ? 1 : 0)>{});
}

static void launch_seg(const Args& base, int lo, int hi, int& li, int grid, hipStream_t stream) {
    Args a = base; a.ph_lo = lo; a.ph_hi = hi; a.li = li++; a.rep = 0;
    void* kargs[] = {&a};
    hipError_t e = hipLaunchCooperativeKernel((const void*)mk_fwd, dim3(grid), dim3(NWAVES * 64), kargs, LDS_BYTES, stream);
    if (e != hipSuccess) fprintf(stderr, "kernel_launch: cooperative launch failed: %s (grid %d)\n", hipGetErrorString(e), grid);
}
extern "C" void kernel_launch(void* const* d_in, const int* in_sizes, int n_in, void* d_out, int out_size, void* d_ws, size_t ws_size, hipStream_t stream) {
    static int grid = 0;
    if (grid == 0) {
        if (n_in != 24 || ws_size < WS_END || out_size != ML * D) { fprintf(stderr, "kernel_launch: unexpected shapes (n_in %d, ws %zu need %zu, out %d)\n", n_in, ws_size, (size_t)WS_END, out_size); grid = -1; return; }
        int dev = 0, cus = 0, per_cu = 0;
        hipGetDevice(&dev); hipDeviceGetAttribute(&cus, hipDeviceAttributeMultiprocessorCount, dev);
        if (hipFuncSetAttribute((const void*)mk_fwd, hipFuncAttributeMaxDynamicSharedMemorySize, LDS_BYTES) != hipSuccess) { fprintf(stderr, "kernel_launch: hipFuncSetAttribute failed\n"); grid = -1; return; }
        if (hipOccupancyMaxActiveBlocksPerMultiprocessor(&per_cu, (const void*)mk_fwd, NWAVES * 64, LDS_BYTES) != hipSuccess || per_cu < 1) { fprintf(stderr, "kernel_launch: occupancy query says %d blocks per CU\n", per_cu); grid = -1; return; }
        (void)hipGetLastError();
        if (cus != 256) { fprintf(stderr, "kernel_launch: built for a 256-CU device (one workgroup per CU; the unit maps of the mixer phases assume it); found %d CUs; nothing launched\n", cus); grid = -1; return; }
        grid = cus;
    }
    if (grid < 0) return;
    hipMemsetAsync((char*)d_ws + WS_CTL, 0, 1u << 20, stream);
    Args a{};
    for (int i = 0; i < 24; ++i) a.in[i] = (const float*)d_in[i];
    a.out = (float*)d_out; a.ws = (unsigned char*)d_ws;
    int li = 0, lo = 0;
    launch_seg(a, lo, NPH, li, grid, stream);
}
```

```cpp
#include <hip/hip_runtime.h>
#include <cstdio>
#include <cstdint>
#include <cmath>

typedef unsigned short bf16_t;
constexpr int D = 1024, NB = 4, S = 4096, LC = 256, DFF = 2816, NIN = 2560;
constexpr int ML = NB * S, MC = NB * LC, M = ML + MC;
constexpr int NMODW = 9 * D;
constexpr float C2 = 0.125f * 1.4426950408889634f;
constexpr float LOG2E = 1.4426950408889634f;

__device__ __forceinline__ float bf2f(bf16_t v) { return __uint_as_float((unsigned)v << 16); }
__device__ __forceinline__ bf16_t f2bf(float f) { unsigned u = __float_as_uint(f); return (bf16_t)((u + 0x7fffu + ((u >> 16) & 1u)) >> 16); }
__device__ __forceinline__ unsigned cvtpk2(float lo, float hi) { typedef float f2_t __attribute__((ext_vector_type(2))); typedef __bf16 b2_t __attribute__((ext_vector_type(2))); f2_t v = {lo, hi}; b2_t b = __builtin_convertvector(v, b2_t); return __builtin_bit_cast(unsigned, b); }
__device__ __forceinline__ int bidx(int row) { return row < ML ? (row >> 12) : 4; }
__device__ __forceinline__ float silu_f(float x) { return x / (1.f + __expf(-x)); }
__device__ __forceinline__ float gelu_tanh_f(float x) { const float u = 0.7978845608028654f * (x + 0.044715f * x * x * x); return 0.5f * x * (1.f + tanhf(u)); }
__device__ __forceinline__ float sigmoid_f(float x) { return 1.f / (1.f + __expf(-x)); }

constexpr size_t MiB = 1u << 20;
constexpr size_t WS_CTL = 0;
constexpr size_t WS_MOD = 1 * MiB;
constexpr size_t WS_TAB = WS_MOD + 512 * 1024;
constexpr size_t WS_SUMM = 2 * MiB;
constexpr size_t WS_SSQ = 3 * MiB + 256 * 1024;
constexpr size_t WS_GS = 3 * MiB + 512 * 1024;
constexpr size_t WS_SW = 3 * MiB + 768 * 1024;
constexpr size_t WS_W = 5 * MiB;
constexpr size_t W_GU = (size_t)2 * DFF * D, W_DN = (size_t)D * DFF, W_IN = (size_t)NIN * D, W_OUT = (size_t)D * D, W_LRU = 2 * 4 * 2 * 64 * 64;
constexpr size_t W_LAYER = 2 * W_GU + 2 * W_DN + W_IN + W_OUT + W_LRU;
constexpr size_t OFF_GU1 = 0, OFF_DN1 = OFF_GU1 + W_GU, OFF_IN = OFF_DN1 + W_DN, OFF_OUT = OFF_IN + W_IN, OFF_GU2 = OFF_OUT + W_OUT, OFF_DN2 = OFF_GU2 + W_GU, OFF_LRU = OFF_DN2 + W_DN;
constexpr size_t WS_H = WS_W + ((2 * W_LAYER * 2 + MiB - 1) / MiB) * MiB;
constexpr size_t WS_R = WS_H + (((size_t)M * D * 4 + MiB - 1) / MiB) * MiB;
constexpr size_t R_PROJ = 0, R_Y = (size_t)M * NIN * 2, R_BYTES = (size_t)M * NIN * 2 + (size_t)M * D * 2;
constexpr size_t WS_NAIVE = WS_R + ((R_BYTES + MiB - 1) / MiB) * MiB;
constexpr size_t WS_END = WS_NAIVE + (size_t)M * 256 * 4;

enum { T_GU1 = 0, T_DN1, T_NC1, T_IN, T_M1, T_M2, T_OUT, T_NC2, T_GU2, T_DN2, T_NC3 };
struct Tab { float cosv[1024]; float sinv[1024]; float lam[2]; float pad[2]; float lruc[2 * 2 * 256]; };

__device__ __forceinline__ int dest_row(int kind, int n) {
    if (kind == 1) { const int s = n >= DFF ? 1 : 0, j = n - s * DFF; return 256 * (j >> 7) + 128 * s + (j & 127); }
    if (kind == 2) {
        const int pn = n >> 8, w = n & 255;
        if (pn == 2 || (pn >= 4 && pn <= 7)) { const int hh = w >> 6, x = (w >> 5) & 1, i = w & 31; return 256 * pn + 128 * x + 32 * hh + i; }
        if (pn == 3) { if (w < 128) { const int hh = w >> 6, x = (w >> 5) & 1, i = w & 31; return 768 + 128 * x + 32 * hh + i; } const int v = w - 128; return 768 + 128 * (v >> 6) + 64 + (v & 63); }
        return n;
    }
    return n;
}
namespace pg8 {
#define PG8_LAS __attribute__((address_space(3)))
typedef unsigned short bf16_t;
typedef short bf16x8 __attribute__((ext_vector_type(8)));
typedef float f32x4 __attribute__((ext_vector_type(4)));
typedef unsigned u32x4 __attribute__((ext_vector_type(4)));
constexpr int BM = 256, BK = 64, HALF = 128, HTB = HALF * BK * 2  , STAGE_BYTES = 8 * HTB, NXCD = 8, WGM = 4;

__host__ __device__ __forceinline__ int lds_byte(int r, int c) { const int st = (r >> 4) * 2 + (c >> 5), rr = r & 15, cc = c & 31, ob = rr * 64 + cc * 2; return st * 1024 + (ob ^ (((ob >> 9) & 1) << 5)); }
__host__ __device__ __forceinline__ void stage_rc(int b, int& R, int& C) { const int st = b / 1024, sb = b % 1024, swz = sb ^ (((sb >> 9) & 1) << 5); R = (st >> 1) * 16 + swz / 64; C = (st & 1) * 32 + (swz % 64) / 2; }
__host__ __device__ __forceinline__ int perm32(int rho) { const int n = rho >> 4, i = rho & 15; return 8 * (i >> 2) + 4 * n + (i & 3); }

struct Unit { int pm, pn, ko, nt; };
struct Gemm { const bf16_t* A; const bf16_t* Bt; int M, N, K, ld; };

struct StaticOrder {
    static constexpr bool VAR_NT = false;
    int nM, nN, nwg, G, c;
    __host__ __device__ void init(int M, int N, int G_, int c_) { nM = M / BM; nN = N / BM; nwg = nM * nN; G = G_; c = c_; }
    __host__ __device__ bool next(int i, Unit& u) const {
        const long L = (long)i * G + c; if (L >= nwg) return false;
        int wgid = (int)L; { const int q = nwg / NXCD, r = nwg % NXCD, xcd = wgid % NXCD, off = wgid / NXCD; wgid = (xcd < r ? xcd * (q + 1) : r * (q + 1) + (xcd - r) * q) + off; }
        const int nig = WGM * nN, gid = wgid / nig, fm = gid * WGM, gsz = (nM - fm) < WGM ? (nM - fm) : WGM;
        u.pm = fm + ((wgid % nig) % gsz); u.pn = (wgid % nig) / gsz; u.ko = 0; return true;
    }
    __device__ __forceinline__ void a_ready(const Unit&) const {}
    __device__ __forceinline__ void done(const Unit&) const {}
};
struct SliceOrder {
    static constexpr bool VAR_NT = false;
    int ns, KS, G, c;
    __host__ __device__ bool next(int i, Unit& u) const { const int L = i * G + (G - 1 - c); if (L >= 16 * ns) return false; const int tile = L / ns, sl = L % ns; u.pm = 64 + (tile >> 2); u.pn = tile & 3; u.ko = sl * KS; return true; }
    __device__ __forceinline__ void a_ready(const Unit&) const {}
    __device__ __forceinline__ void done(const Unit&) const {}
};

struct DnOrder {
    static constexpr bool VAR_NT = true;
    StaticOrder so; int ns, KS, ntl;
    __host__ __device__ bool next(int i, Unit& u) const {
        const int Ls = so.G - 1 - so.c; const bool hs = Ls < 16 * ns;
        if (hs && i == 0) { const int tile = Ls / ns, sl = Ls % ns; u.pm = 64 + (tile >> 2); u.pn = tile & 3; u.ko = sl * KS; u.nt = KS / BK; return true; }
        if (!so.next(hs ? i - 1 : i, u)) return false;
        u.nt = ntl; return true;
    }
    __device__ __forceinline__ void a_ready(const Unit&) const {}
    __device__ __forceinline__ void done(const Unit&) const {}
};

__device__ __forceinline__ unsigned cvt_pk_bf16(float lo, float hi) { unsigned r; asm volatile("v_cvt_pk_bf16_f32 %0, %1, %2" : "=v"(r) : "v"(lo), "v"(hi)); return r; }
__device__ __forceinline__ float fast_silu(float x) { return x * __builtin_amdgcn_rcpf(1.0f + __builtin_amdgcn_exp2f(-1.4426950408889634f * x)); }
__device__ __forceinline__ float fast_gelu_tanh(float x) {
    const float u = 0.7978845608028654f * (x + 0.044715f * x * x * x);
    return x * __builtin_amdgcn_rcpf(1.0f + __builtin_amdgcn_exp2f(-2.0f * 1.4426950408889634f * u));
}
struct EpiCtx { unsigned long long wsi, outi; const __attribute__((address_space(4))) unsigned long long* kin; int l, ty; };
#define PG8_GAS __attribute__((address_space(1)))
__device__ __forceinline__ unsigned char* ectx_ws(const EpiCtx& c) { return (unsigned char*)(PG8_GAS unsigned char*)c.wsi; }
__device__ __forceinline__ const float* ectx_in(const EpiCtx& c, int i) { return (const float*)(const PG8_GAS float*)(c.kin[i]); }
__device__ __forceinline__ int hw_lane() { unsigned z = 0u; asm volatile("" : "+v"(z)); return (int)__builtin_amdgcn_mbcnt_hi(~0u, __builtin_amdgcn_mbcnt_lo(~0u, z)); }
__device__ __forceinline__ void epi_stage_params(PG8_LAS unsigned char* par, const float* ssq_tile, const float* sw_tile, int wid, int) {
    const int lane = hw_lane();
    if (wid < 4) __builtin_amdgcn_global_load_lds((const unsigned*)(ssq_tile + (size_t)(wid * 64 + lane) * 4), (PG8_LAS unsigned*)(par + wid * 1024), 16, 0, 0);
    else if (wid == 4) __builtin_amdgcn_global_load_lds((const unsigned*)(sw_tile + lane * 4), (PG8_LAS unsigned*)(par + 4096), 16, 0, 0);
}
struct EpiGU {
    static constexpr bool PERM = true, AFTER_DRAIN = false, PARAMS = true, LOOSE = true; static constexpr int NST = 8;
    EpiCtx cx;
    __device__ __forceinline__ void stage(PG8_LAS unsigned char* par, const Unit& u, int wid, int lane) const {
        if (u.pm >= 64) return;
        unsigned char* wsb = ectx_ws(cx);
        epi_stage_params(par, (const float*)(wsb + WS_SSQ) + (size_t)u.pm * BM * 4, (const float*)(wsb + WS_SW) + (size_t)(cx.l * 3 + (cx.ty == T_GU1 ? 0 : 2)) * 4 * 5632 + (size_t)(u.pm >> 4) * 5632 + u.pn * 256, wid, lane);
    }
    __device__ __forceinline__ void operator()(const f32x4 (&acc)[2][2][4][2], const Unit& u, int wr, int wc, int fr_in, int fq_in, const PG8_LAS unsigned char* par) const {
        const int ln_ = hw_lane(); const int fr = ln_ & 15, fq = ln_ >> 4;
        unsigned char* wsb = ectx_ws(cx); bf16_t* HB = (bf16_t*)(wsb + WS_R);
        const int row0 = u.pm * BM + wr * 64 + fr, col0 = u.pn * 128 + wc * 32 + 8 * fq; const bool lat = u.pm < 64;
        float rs[2][4];
        { f32x4 sq[2][4];
#pragma unroll
          for (int ai = 0; ai < 2; ++ai)
#pragma unroll
            for (int m = 0; m < 4; ++m) sq[ai][m] = *(const PG8_LAS f32x4*)(par + (wr * 64 + fr + ai * HALF + m * 16) * 16);
#pragma unroll
          for (int ai = 0; ai < 2; ++ai)
#pragma unroll
            for (int m = 0; m < 4; ++m) rs[ai][m] = lat ? __builtin_amdgcn_rsqf(((sq[ai][m][0] + sq[ai][m][1]) + (sq[ai][m][2] + sq[ai][m][3])) * (1.0f / 1024.0f) + 1e-6f) : 1.0f; }
        f32x4 sv[2][2];
#pragma unroll
        for (int bj = 0; bj < 2; ++bj)
#pragma unroll
            for (int n = 0; n < 2; ++n) { const f32x4 t = *(const PG8_LAS f32x4*)(par + 4096 + (bj * 128 + wc * 32 + 8 * fq + 4 * n) * 4); sv[bj][n] = lat ? t : (f32x4){0.f, 0.f, 0.f, 0.f}; }
        f32x4 svg[2], svu[2];
#pragma unroll
        for (int n = 0; n < 2; ++n) { svg[n] = sv[0][n] * -1.4426950408889634f; svu[n] = sv[1][n] * -0.6931471805599453f; }
#pragma unroll
        for (int ai = 0; ai < 2; ++ai)
#pragma unroll
            for (int m = 0; m < 4; ++m) {
                const int row = row0 + ai * HALF + m * 16; bf16_t* rowp = HB + (size_t)row * 2816 + col0; const float rstd = rs[ai][m];
                const float rg = rstd * -1.4426950408889634f, ru = rstd * -0.6931471805599453f;
                const f32x4 g0 = acc[ai][0][m][0] * rg + svg[0], g1 = acc[ai][0][m][1] * rg + svg[1], u0 = acc[ai][1][m][0] * ru + svu[0], u1 = acc[ai][1][m][1] * ru + svu[1];
#define GU_F(g_, u_) (((g_) * (u_)) * __builtin_amdgcn_rcpf(1.0f + __builtin_amdgcn_exp2f(g_)))
                u32x4 w;
                w.x = cvt_pk_bf16(GU_F(g0[0], u0[0]), GU_F(g0[1], u0[1])); w.y = cvt_pk_bf16(GU_F(g0[2], u0[2]), GU_F(g0[3], u0[3]));
                w.z = cvt_pk_bf16(GU_F(g1[0], u1[0]), GU_F(g1[1], u1[1])); w.w = cvt_pk_bf16(GU_F(g1[2], u1[2]), GU_F(g1[3], u1[3]));
#undef GU_F
                *(u32x4*)rowp = w;
            }
    }
};
struct EpiRes {
    static constexpr bool PERM = false, AFTER_DRAIN = false, PARAMS = false, LOOSE = false;
    EpiCtx cx; PG8_LAS float* part;
    __device__ __forceinline__ void operator()(const f32x4 (&acc)[2][2][4][2], const Unit& u, int wr, int wc, int fr_in, int fq_in, const PG8_LAS unsigned char* par) const {
        const int ln_ = hw_lane(); const int fr = ln_ & 15, fq = ln_ >> 4;
        unsigned char* wsb = ectx_ws(cx); const int l = cx.l, ty = cx.ty;
        const bool hasAN = !(l == 1 && ty == T_DN2);
        const float coef = (ty == T_OUT) ? 1.0f : 0.5f;
        float* ssq = (float*)(wsb + WS_SSQ);
        const int pc0 = wc * 32 + 4 * fq;
        const size_t tb = ((size_t)u.pm * BM) * 1024 + (size_t)u.pn * BM;
        char* hbt = (char*)((bf16_t*)(wsb + WS_H) + tb); char* ant = (char*)((bf16_t*)(PG8_GAS bf16_t*)cx.outi + tb);
        const int r0 = wr * 64 + fr;
        unsigned ro[2][4];
#pragma unroll
        for (int ai = 0; ai < 2; ++ai)
#pragma unroll
            for (int m = 0; m < 4; ++m) ro[ai][m] = (unsigned)((r0 + ai * HALF + m * 16) * 1024 + pc0) * 2u;
        typedef unsigned u32x2w __attribute__((ext_vector_type(2)));
        u32x2w hq[2][4][2][2];
#pragma unroll
        for (int ai = 0; ai < 2; ++ai)
#pragma unroll
            for (int m = 0; m < 4; ++m)
#pragma unroll
                for (int bj = 0; bj < 2; ++bj)
#pragma unroll
                    for (int n = 0; n < 2; ++n) hq[ai][m][bj][n] = *(const u32x2w*)(hbt + (size_t)ro[ai][m] + (bj * HALF + n * 16) * 2);
#pragma unroll
        for (int ai = 0; ai < 2; ++ai)
#pragma unroll
            for (int m = 0; m < 4; ++m) { float sqr = 0.f;
#pragma unroll
                for (int bj = 0; bj < 2; ++bj)
#pragma unroll
                    for (int n = 0; n < 2; ++n) { const int co = bj * HALF + n * 16;
                        const f32x4 gv = *(const PG8_LAS f32x4*)(par + (pc0 + co) * 4) * coef;
                        const u32x2w hw0 = hq[ai][m][bj][n]; const f32x4 hin = (f32x4){__uint_as_float(hw0.x << 16), __uint_as_float(hw0.x & 0xffff0000u), __uint_as_float(hw0.y << 16), __uint_as_float(hw0.y & 0xffff0000u)};
                        const f32x4 v = hin + gv * acc[ai][bj][m][n];
                        { u32x2w hw; hw.x = cvt_pk_bf16(v[0], v[1]); hw.y = cvt_pk_bf16(v[2], v[3]); *(u32x2w*)(hbt + (size_t)ro[ai][m] + co * 2) = hw; }
                        if (hasAN) { const f32x4 gs = *(const PG8_LAS f32x4*)(par + 1024 + (pc0 + co) * 4);
                            sqr += (v[0] * v[0] + v[1] * v[1]) + (v[2] * v[2] + v[3] * v[3]); const f32x4 a = v * gs;
                            u32x2w w; w.x = cvt_pk_bf16(a[0], a[1]); w.y = cvt_pk_bf16(a[2], a[3]);
                            *(u32x2w*)(ant + (size_t)ro[ai][m] + co * 2) = w; } }
                if (hasAN) { float s = sqr;
                    s += __int_as_float(__builtin_amdgcn_ds_bpermute((ln_ ^ 16) << 2, __float_as_int(s))); s += __int_as_float(__builtin_amdgcn_ds_bpermute((ln_ ^ 32) << 2, __float_as_int(s)));
                    if (fq == 0) part[(ai * HALF + wr * 64 + m * 16 + fr) * 4 + wc] = s; }
            }
        if (hasAN) { const int lane = ln_;
            asm volatile("s_waitcnt lgkmcnt(0)" ::: "memory"); __builtin_amdgcn_s_barrier(); asm volatile("" ::: "memory");
            const int tid = (wr * 4 + wc) * 64 + lane;
            if (tid < 256) { const f32x4 p = *(const PG8_LAS f32x4*)(part + tid * 4); ssq[(size_t)(u.pm * BM + tid) * 4 + u.pn] = (p[0] + p[1]) + (p[2] + p[3]); }
        }
    }
};
__device__ __forceinline__ float* slab_ptr(unsigned long long wsi, unsigned long long outi, int s) {
    return s < 7 ? (float*)(PG8_GAS float*)(outi + ((size_t)34 << 20) + ((size_t)s << 22)) : (float*)(PG8_GAS float*)(wsi + WS_R + ((size_t)94 << 20) + ((size_t)(s - 7) << 22)); }
struct EpiResAt {
    static constexpr bool PERM = false, AFTER_DRAIN = false, PARAMS = false, LOOSE = false;
    EpiCtx cx;
    __device__ __forceinline__ void operator()(const f32x4 (&acc)[2][2][4][2], const Unit& u, int wr, int wc, int fr_in, int fq_in, const PG8_LAS unsigned char* par) const {
        const int ln_ = hw_lane(); const int fr = ln_ & 15, fq = ln_ >> 4;
        const int ty = cx.ty;
        const float coef = (ty == T_OUT) ? 1.0f : 0.5f;
        float* dst = (float*)((bf16_t*)slab_ptr(cx.wsi, cx.outi, u.ko >> 8) + (size_t)(u.pm - 64) * BM * 1024); const int col0 = u.pn * BM + wc * 32 + 4 * fq, r0 = wr * 64 + fr;
        f32x4 gv[2][2];
#pragma unroll
        for (int bj = 0; bj < 2; ++bj)
#pragma unroll
            for (int n = 0; n < 2; ++n) gv[bj][n] = *(const PG8_LAS f32x4*)(par + (wc * 32 + 4 * fq + bj * HALF + n * 16) * 4) * coef;
#pragma unroll
        for (int ai = 0; ai < 2; ++ai)
#pragma unroll
            for (int m = 0; m < 4; ++m) { bf16_t* rp = (bf16_t*)dst + (size_t)(r0 + ai * HALF + m * 16) * 1024 + col0;
#pragma unroll
                for (int bj = 0; bj < 2; ++bj)
#pragma unroll
                    for (int n = 0; n < 2; ++n) { const f32x4 t = gv[bj][n] * acc[ai][bj][m][n]; typedef unsigned u32x2s __attribute__((ext_vector_type(2)));
                        u32x2s w; w.x = cvt_pk_bf16(t[0], t[1]); w.y = cvt_pk_bf16(t[2], t[3]); *(u32x2s*)(rp + bj * HALF + n * 16) = w; } }
    }
};
struct EpiDn {
    static constexpr bool PERM = false, AFTER_DRAIN = false, PARAMS = true, LOOSE = true; static constexpr int NST = 32;
    EpiRes r; EpiResAt a;
    __device__ __forceinline__ void stage(PG8_LAS unsigned char* par, const Unit& u, int wid, int) const {
        if (wid >= 2) return;
        const int l = r.cx.l, ty = r.cx.ty; unsigned char* wsb = ectx_ws(r.cx); const int lane = hw_lane(); const bool ctxu = u.pm >= 64; const int b = ctxu ? 4 : (u.pm >> 4);
        if (wid == 0) { const int gk = (ty == T_DN1) ? 2 : (ty == T_OUT) ? 5 : 8;
            __builtin_amdgcn_global_load_lds((const unsigned*)((const float*)(wsb + WS_MOD) + (size_t)l * 5 * 9216 + (size_t)b * 9216 + gk * 1024 + u.pn * BM + lane * 4), (PG8_LAS unsigned*)par, 16, 0, 0); }
        else if (!ctxu && !(l == 1 && ty == T_DN2)) {
            const float* gsn = (const float*)(wsb + WS_GS) + (size_t)((ty == T_DN2 ? l + 1 : l) * 3 + (ty == T_DN1 ? 1 : ty == T_OUT ? 2 : 0)) * 5 * 1024;
            __builtin_amdgcn_global_load_lds((const unsigned*)(gsn + (size_t)b * 1024 + u.pn * BM + lane * 4), (PG8_LAS unsigned*)(par + 1024), 16, 0, 0); }
    }
    __device__ __forceinline__ void operator()(const f32x4 (&acc)[2][2][4][2], const Unit& u, int wr, int wc, int fr_in, int fq_in, const PG8_LAS unsigned char* par) const { if (u.pm >= 64) a(acc, u, wr, wc, fr_in, fq_in, par); else r(acc, u, wr, wc, fr_in, fq_in, par); }
};
struct EpiIN {
    static constexpr bool PERM = true, AFTER_DRAIN = false, PARAMS = true, LOOSE = true; static constexpr int NST = 16;
    EpiCtx cx; const PG8_LAS float* ropet;
    __device__ __forceinline__ void stage(PG8_LAS unsigned char* par, const Unit& u, int wid, int lane) const {
        if (u.pm >= 64) return;
        unsigned char* wsb = ectx_ws(cx);
        epi_stage_params(par, (const float*)(wsb + WS_SSQ) + (size_t)u.pm * BM * 4, (const float*)(wsb + WS_SW) + (size_t)(cx.l * 3 + 1) * 4 * 5632 + (size_t)(u.pm >> 4) * 5632 + u.pn * 256, wid, lane);
    }
    __device__ __forceinline__ void operator()(const f32x4 (&acc)[2][2][4][2], const Unit& u, int wr, int wc, int fr_in, int fq_in, const PG8_LAS unsigned char* par) const {
        const int ln_ = hw_lane(); const int fr = ln_ & 15, fq = ln_ >> 4;
        unsigned char* wsb = ectx_ws(cx); bf16_t* PROJ = (bf16_t*)(wsb + WS_R + R_PROJ); const PG8_LAS float* cosv = ropet; const PG8_LAS float* sinv = ropet + 1024;
        const int pn = u.pn; const int row0 = u.pm * BM + wr * 64 + fr; const int j0 = wc * 32 + 8 * fq;
        const bool rope_tile = (pn == 2) || (pn >= 4 && pn <= 7) || (pn == 3 && wc < 2);
        const float C2q = 0.125f * 1.4426950408889634f;
        const bool lat = u.pm < 64;
        f32x4 sv[2][2];
#pragma unroll
        for (int bj = 0; bj < 2; ++bj)
#pragma unroll
            for (int n = 0; n < 2; ++n) { const f32x4 t = *(const PG8_LAS f32x4*)(par + 4096 + (bj * 128 + j0 + 4 * n) * 4); sv[bj][n] = lat ? t : (f32x4){0.f, 0.f, 0.f, 0.f}; }
        float rs[2][4];
        { f32x4 sq[2][4];
#pragma unroll
          for (int ai = 0; ai < 2; ++ai)
#pragma unroll
            for (int m = 0; m < 4; ++m) sq[ai][m] = *(const PG8_LAS f32x4*)(par + (wr * 64 + fr + ai * HALF + m * 16) * 16);
#pragma unroll
          for (int ai = 0; ai < 2; ++ai)
#pragma unroll
            for (int m = 0; m < 4; ++m) rs[ai][m] = lat ? __builtin_amdgcn_rsqf(((sq[ai][m][0] + sq[ai][m][1]) + (sq[ai][m][2] + sq[ai][m][3])) * (1.0f / 1024.0f) + 1e-6f) : 1.0f; }
#define EPIIN_SV
#define EPIIN_RSTD(row_) const float rstd = rs[ai][m];
        if (!rope_tile) {
            int cbase[2];
            if (pn == 3) { cbase[0] = 896 + (j0 - 64); cbase[1] = 896 + 64 + (j0 - 64); } else { cbase[0] = 256 * pn + j0; cbase[1] = 256 * pn + 128 + j0; }
#pragma unroll
            for (int ai = 0; ai < 2; ++ai)
#pragma unroll
                for (int m = 0; m < 4; ++m) { bf16_t* rowp = PROJ + (size_t)(row0 + ai * HALF + m * 16) * 2560; EPIIN_RSTD(row0 + ai * HALF + m * 16) EPIIN_SV
#pragma unroll
                    for (int bj = 0; bj < 2; ++bj) { f32x4 v0 = acc[ai][bj][m][0] * rstd + sv[bj][0], v1 = acc[ai][bj][m][1] * rstd + sv[bj][1];
                        if (pn == 1) {
#pragma unroll
                            for (int e = 0; e < 4; ++e) { v0[e] = fast_gelu_tanh(v0[e]); v1[e] = fast_gelu_tanh(v1[e]); } }
                        u32x4 w; w.x = cvt_pk_bf16(v0[0], v0[1]); w.y = cvt_pk_bf16(v0[2], v0[3]); w.z = cvt_pk_bf16(v1[0], v1[1]); w.w = cvt_pk_bf16(v1[2], v1[3]);
                        *(u32x4*)(rowp + cbase[bj]) = w; } }
        } else {
            const bool latent = lat; const float qs = (pn == 2 || pn == 4 || pn == 5) ? C2q : 1.0f;
            const int c1 = (pn == 3 ? 768 : 256 * pn) + 64 * wc + 8 * fq;
            const int fo = 8 * (fq & 1);
#pragma unroll
            for (int ai = 0; ai < 2; ++ai) {
                const int posr = (4 * u.pm + 2 * ai + wr) & 63;
#pragma unroll
                for (int m = 0; m < 4; ++m) { bf16_t* rowp = PROJ + (size_t)(row0 + ai * HALF + m * 16) * 2560 + c1;
                    const int pos = (fq < 2) ? posr : (16 * m + fr); EPIIN_RSTD(row0 + ai * HALF + m * 16) EPIIN_SV
                    f32x4 x1a = acc[ai][0][m][0] * rstd + sv[0][0], x1b = acc[ai][0][m][1] * rstd + sv[0][1], x2a = acc[ai][1][m][0] * rstd + sv[1][0], x2b = acc[ai][1][m][1] * rstd + sv[1][1];
                    if (latent) {
                        const f32x4 ca = *(const PG8_LAS f32x4*)(cosv + pos * 16 + fo), cb = *(const PG8_LAS f32x4*)(cosv + pos * 16 + fo + 4), sa = *(const PG8_LAS f32x4*)(sinv + pos * 16 + fo), sb = *(const PG8_LAS f32x4*)(sinv + pos * 16 + fo + 4);
                        const f32x4 o1a = x1a * ca - x2a * sa, o1b = x1b * cb - x2b * sb, o2a = x1a * sa + x2a * ca, o2b = x1b * sb + x2b * cb;
                        x1a = o1a; x1b = o1b; x2a = o2a; x2b = o2b;
                    }
                    x1a = x1a * qs; x1b = x1b * qs; x2a = x2a * qs; x2b = x2b * qs;
                    u32x4 w1, w2; w1.x = cvt_pk_bf16(x1a[0], x1a[1]); w1.y = cvt_pk_bf16(x1a[2], x1a[3]); w1.z = cvt_pk_bf16(x1b[0], x1b[1]); w1.w = cvt_pk_bf16(x1b[2], x1b[3]);
                    w2.x = cvt_pk_bf16(x2a[0], x2a[1]); w2.y = cvt_pk_bf16(x2a[2], x2a[3]); w2.z = cvt_pk_bf16(x2b[0], x2b[1]); w2.w = cvt_pk_bf16(x2b[2], x2b[3]);
                    *(u32x4*)rowp = w1; *(u32x4*)(rowp + 32) = w2; }
            }
        }
    }
};
#undef EPIIN_RSTD
#undef EPIIN_SV

template <class Epi, class Sched, bool ALIGN_EPI = false, bool SP2 = false>
__device__ __forceinline__ void gemm_phase(PG8_LAS unsigned char* lds, const Gemm g, const Sched& S, const Epi& E, const int tid_in) {
    const int tid = tid_in, wid = __builtin_amdgcn_readfirstlane(tid >> 6), lane = tid & 63, wr = wid >> 2, wc = wid & 3, fr = lane & 15, fq = lane >> 4;
    const int K = g.K, LD = g.ld; int nt = K / BK;
    unsigned voffA[2], voffB[2];
#pragma unroll
    for (int i = 0; i < 2; ++i) { int R, C; stage_rc(tid * 16 + i * 8192, R, C); const int Rb = Epi::PERM ? ((R & ~31) + perm32(R & 31)) : R;
        voffA[i] = (unsigned)(R * LD + C) * 2u; voffB[i] = (unsigned)(Rb * LD + C) * 2u; }
    const size_t kstep = (size_t)(BK * 2);
    const size_t hstep = (size_t)HALF * LD * 2;
    const size_t tstep = 2 * hstep;
    const unsigned ldsw = (unsigned)wid * 1024u;
    const int aoff = lds_byte(wr * 64 + fr, fq * 8), boff = lds_byte(wc * 32 + fr, fq * 8);
#define PG8_SA(b, h) (((b) * 2 + (h)) * HTB)
#define PG8_SB(b, h) ((4 + (b) * 2 + (h)) * HTB)
#define PG8_STAGE(bufoff, gbase, voff) do { _Pragma("unroll") for (int _i = 0; _i < 2; ++_i) { unsigned vo_ = (voff)[_i]; asm volatile("" : "+v"(vo_));   \
        __builtin_amdgcn_global_load_lds((const unsigned*)((const char*)(gbase) + vo_), (PG8_LAS unsigned*)(lds + (bufoff) + ldsw + _i * 8192), 16, 0, 0); } } while (0)
#define PG8_LDA(dst, b, h) do { _Pragma("unroll") for (int m = 0; m < 4; ++m) _Pragma("unroll") for (int k = 0; k < 2; ++k) dst[m][k] = *(const PG8_LAS bf16x8*)(lds + PG8_SA(b, h) + aoff + m * 2048 + k * 1024); } while (0)
#define PG8_LDB(dst, b, h) do { _Pragma("unroll") for (int n = 0; n < 2; ++n) _Pragma("unroll") for (int k = 0; k < 2; ++k) dst[n][k] = *(const PG8_LAS bf16x8*)(lds + PG8_SB(b, h) + boff + n * 2048 + k * 1024); } while (0)
#define PG8_MMA(ai, bj, At, Bt) do { __builtin_amdgcn_s_setprio(1); _Pragma("unroll") for (int m = 0; m < 4; ++m) _Pragma("unroll") for (int n = 0; n < 2; ++n) _Pragma("unroll") for (int k = 0; k < 2; ++k) \
        acc[ai][bj][m][n] = __builtin_amdgcn_mfma_f32_16x16x32_bf16(Bt[n][k], At[m][k], acc[ai][bj][m][n], 0, 0, 0); __builtin_amdgcn_s_setprio(0); } while (0)
#define PG8_WAIT_V(n) asm volatile("s_waitcnt vmcnt(" #n ")" ::: "memory")
#define PG8_WAIT_L(n) asm volatile("s_waitcnt lgkmcnt(" #n ")" ::: "memory")
#define PG8_WAIT_VN(n) asm volatile("s_waitcnt vmcnt(%0)" :: "n"(n) : "memory")
#define PG8_BAR __builtin_amdgcn_s_barrier()
#define PG8_SCHED __builtin_amdgcn_sched_barrier(0)
    Unit cur, nxt; int ui = 0;
    if (!S.next(0, cur)) return;
    f32x4 acc[2][2][4][2];
#pragma unroll
    for (int a = 0; a < 2; ++a)
#pragma unroll
        for (int b = 0; b < 2; ++b)
#pragma unroll
            for (int m = 0; m < 4; ++m)
#pragma unroll
                for (int n = 0; n < 2; ++n) acc[a][b][m][n] = (f32x4){0.f, 0.f, 0.f, 0.f};
    bf16x8 At[4][2], B0[2][2], B1[2][2];
    const char* cA = (const char*)g.A + (size_t)cur.pm * tstep + (size_t)cur.ko * 2; const char* cB = (const char*)g.Bt + (size_t)cur.pn * tstep + (size_t)cur.ko * 2;
    if constexpr (Sched::VAR_NT) nt = cur.nt;
    S.a_ready(cur);
    if constexpr (SP2) {
        PG8_STAGE(PG8_SB(0, 0), cB, voffB); PG8_STAGE(PG8_SB(0, 1), cB + hstep, voffB); PG8_STAGE(PG8_SA(0, 0), cA, voffA); PG8_STAGE(PG8_SA(0, 1), cA + hstep, voffA);
        if (wr == 1) PG8_BAR;
        PG8_WAIT_V(2); PG8_BAR;
        PG8_STAGE(PG8_SB(1, 0), cB + kstep, voffB); PG8_STAGE(PG8_SA(1, 0), cA + kstep, voffA); PG8_STAGE(PG8_SB(1, 1), cB + hstep + kstep, voffB);
        PG8_WAIT_V(6); PG8_BAR;
    } else {
        PG8_STAGE(PG8_SB(0, 0), cB, voffB); PG8_STAGE(PG8_SA(0, 0), cA, voffA); PG8_STAGE(PG8_SB(0, 1), cB + hstep, voffB); PG8_STAGE(PG8_SA(0, 1), cA + hstep, voffA);
        if (wr == 1) PG8_BAR;
        PG8_WAIT_V(4); PG8_BAR;
        PG8_STAGE(PG8_SB(1, 0), cB + kstep, voffB); PG8_STAGE(PG8_SA(1, 0), cA + kstep, voffA); PG8_STAGE(PG8_SB(1, 1), cB + hstep + kstep, voffB);
        PG8_WAIT_V(6); PG8_BAR;
    }
    if constexpr (Epi::PARAMS) E.stage(lds + STAGE_BYTES, cur, wid, lane);
    for (;;) {
        const bool has_next = S.next(ui + 1, nxt);
        const char* nA = has_next ? (const char*)g.A + (size_t)nxt.pm * tstep + (size_t)nxt.ko * 2 : cA; const char* nB = has_next ? (const char*)g.Bt + (size_t)nxt.pn * tstep + (size_t)nxt.ko * 2 : cB;
        int t0 = 0;
        if constexpr (Epi::LOOSE) { if (ui > 0) {
            const char* a2 = cA + 2 * kstep; const char* b2 = cB + 2 * kstep; asm volatile("" : "+s"(a2), "+s"(b2));
            const char* a3 = a2 + kstep; const char* b3 = b2 + kstep; asm volatile("" : "+s"(a3), "+s"(b3));
            PG8_LDB(B0, 0, 0); PG8_LDB(B1, 0, 1); PG8_SCHED; PG8_LDA(At, 0, 0);
            PG8_WAIT_VN(8 + Epi::NST); PG8_WAIT_L(0); PG8_BAR; PG8_MMA(0, 0, At, B0); PG8_MMA(0, 1, At, B1); PG8_BAR; PG8_SCHED;
            PG8_LDA(At, 0, 1); PG8_STAGE(PG8_SB(0, 0), b2, voffB); PG8_STAGE(PG8_SB(0, 1), b2 + hstep, voffB); PG8_STAGE(PG8_SA(0, 0), a2, voffA);
            PG8_WAIT_VN(8 + Epi::NST); PG8_WAIT_L(0); PG8_BAR; PG8_MMA(1, 0, At, B0); PG8_MMA(1, 1, At, B1); PG8_BAR; PG8_SCHED;
            PG8_LDB(B0, 1, 0); PG8_LDB(B1, 1, 1); PG8_SCHED; PG8_LDA(At, 1, 0); PG8_STAGE(PG8_SA(0, 1), a2 + hstep, voffA);
            PG8_WAIT_VN(8 + Epi::NST); PG8_WAIT_L(0); PG8_BAR; PG8_MMA(0, 0, At, B0); PG8_MMA(0, 1, At, B1); PG8_BAR; PG8_SCHED;
            PG8_LDA(At, 1, 1); PG8_STAGE(PG8_SB(1, 0), b3, voffB); PG8_STAGE(PG8_SB(1, 1), b3 + hstep, voffB); PG8_STAGE(PG8_SA(1, 0), a3, voffA);
            PG8_WAIT_V(8); PG8_WAIT_L(0); PG8_BAR; PG8_MMA(1, 0, At, B0); PG8_MMA(1, 1, At, B1); PG8_BAR; PG8_SCHED;
            t0 = 2; } }
        for (int t = t0; t < nt; t += 2) {
            const bool last = (t == nt - 2);
            const char* a1 = cA + (size_t)(t + 1) * kstep;
            const char* a2 = last ? nA : cA + (size_t)(t + 2) * kstep; const char* b2 = last ? nB : cB + (size_t)(t + 2) * kstep;
            const char* a3 = a2 + kstep; const char* b3 = b2 + kstep;
            if (last && has_next) S.a_ready(nxt);
            if constexpr (SP2) {
            PG8_LDB(B0, 0, 0); PG8_LDB(B1, 0, 1); PG8_SCHED; PG8_LDA(At, 0, 0); PG8_STAGE(PG8_SA(1, 1), a1 + hstep, voffA);
            PG8_WAIT_V(8); PG8_WAIT_L(0); PG8_BAR; PG8_MMA(0, 0, At, B0); PG8_MMA(0, 1, At, B1); PG8_BAR; PG8_SCHED;
            PG8_LDA(At, 0, 1); PG8_STAGE(PG8_SB(0, 0), b2, voffB); PG8_STAGE(PG8_SB(0, 1), b2 + hstep, voffB); PG8_STAGE(PG8_SA(0, 0), a2, voffA);
            PG8_WAIT_V(8); PG8_WAIT_L(0); PG8_BAR; PG8_MMA(1, 0, At, B0); PG8_MMA(1, 1, At, B1); PG8_BAR; PG8_SCHED;
            PG8_LDB(B0, 1, 0); PG8_LDB(B1, 1, 1); PG8_SCHED; PG8_LDA(At, 1, 0); PG8_STAGE(PG8_SA(0, 1), a2 + hstep, voffA);
            PG8_WAIT_V(8); PG8_WAIT_L(0); PG8_BAR; PG8_MMA(0, 0, At, B0); PG8_MMA(0, 1, At, B1); PG8_BAR; PG8_SCHED;
            PG8_LDA(At, 1, 1); PG8_STAGE(PG8_SB(1, 0), b3, voffB); PG8_STAGE(PG8_SB(1, 1), b3 + hstep, voffB); PG8_STAGE(PG8_SA(1, 0), a3, voffA);
            PG8_WAIT_V(8); PG8_WAIT_L(0); PG8_BAR; PG8_MMA(1, 0, At, B0); PG8_MMA(1, 1, At, B1); PG8_BAR; PG8_SCHED;
            } else {
            PG8_LDB(B0, 0, 0); PG8_SCHED; PG8_LDA(At, 0, 0); PG8_STAGE(PG8_SA(1, 1), a1 + hstep, voffA);
            PG8_WAIT_L(8); PG8_BAR; PG8_WAIT_L(0); PG8_MMA(0, 0, At, B0); PG8_BAR; PG8_SCHED;
            PG8_LDB(B1, 0, 1); PG8_STAGE(PG8_SB(0, 0), b2, voffB);
            PG8_BAR; PG8_WAIT_L(0); PG8_MMA(0, 1, At, B1); PG8_BAR;
            PG8_LDA(At, 0, 1); PG8_STAGE(PG8_SA(0, 0), a2, voffA);
            PG8_BAR; PG8_WAIT_L(0); PG8_MMA(1, 0, At, B0); PG8_BAR; PG8_SCHED;
            PG8_STAGE(PG8_SB(0, 1), b2 + hstep, voffB);
            PG8_WAIT_V(6); PG8_BAR; PG8_MMA(1, 1, At, B1); PG8_BAR;
            PG8_LDB(B0, 1, 0); PG8_SCHED; PG8_LDA(At, 1, 0); PG8_STAGE(PG8_SA(0, 1), a2 + hstep, voffA);
            PG8_WAIT_L(8); PG8_BAR; PG8_WAIT_L(0); PG8_MMA(0, 0, At, B0); PG8_BAR; PG8_SCHED;
            PG8_LDB(B1, 1, 1); PG8_STAGE(PG8_SB(1, 0), b3, voffB);
            PG8_BAR; PG8_WAIT_L(0); PG8_MMA(0, 1, At, B1); PG8_BAR;
            PG8_LDA(At, 1, 1); PG8_STAGE(PG8_SA(1, 0), a3, voffA);
            PG8_BAR; PG8_WAIT_L(0); PG8_MMA(1, 0, At, B0); PG8_BAR; PG8_SCHED;
            PG8_STAGE(PG8_SB(1, 1), b3 + hstep, voffB);
            PG8_WAIT_V(6); PG8_BAR; PG8_MMA(1, 1, At, B1); PG8_BAR;
            }
        }
        if constexpr (Epi::PARAMS || Epi::LOOSE) { if (has_next) { if constexpr (Epi::LOOSE) { const char* xa = nA + kstep + hstep; asm volatile("" : "+s"(xa)); PG8_STAGE(PG8_SA(1, 1), xa, voffA); } if constexpr (Epi::PARAMS) E.stage(lds + STAGE_BYTES + ((ui + 1) & 1) * 5120, nxt, wid, lane); } }
        if constexpr (ALIGN_EPI) { if (wr == 0) PG8_BAR; }
        if constexpr (!Epi::AFTER_DRAIN) { if constexpr (Epi::PARAMS) E(acc, cur, wr, wc, fr, fq, lds + STAGE_BYTES + (ui & 1) * 5120); else E(acc, cur, wr, wc, fr, fq); S.done(cur); }
        if (!has_next) break;
#pragma unroll
        for (int a = 0; a < 2; ++a)
#pragma unroll
            for (int b = 0; b < 2; ++b)
#pragma unroll
                for (int m = 0; m < 4; ++m)
#pragma unroll
                    for (int n = 0; n < 2; ++n) acc[a][b][m][n] = (f32x4){0.f, 0.f, 0.f, 0.f};
        cur = nxt; cA = nA; cB = nB; ++ui; if constexpr (Sched::VAR_NT) nt = cur.nt;
        if constexpr (ALIGN_EPI) { if (wr == 1) PG8_BAR; }
    }
    PG8_WAIT_V(0);
    if constexpr (!ALIGN_EPI) { if (wr == 0) PG8_BAR; }
    PG8_BAR;
    if constexpr (Epi::AFTER_DRAIN) { E.fused(acc, cur, wr, wc, fr, fq, lds, wid, lane); S.done(cur); }
#undef PG8_SA
#undef PG8_SB
#undef PG8_STAGE
#undef PG8_LDA
#undef PG8_LDB
#undef PG8_MMA
#undef PG8_WAIT_V
#undef PG8_WAIT_L
#undef PG8_WAIT_VN
#undef PG8_BAR
#undef PG8_SCHED
}
}

#define GAS __attribute__((address_space(1)))
#define LAS __attribute__((address_space(3)))
typedef unsigned short bf16;
typedef unsigned v4u __attribute__((ext_vector_type(4)));
typedef float f32x4 __attribute__((ext_vector_type(4)));
typedef short bf16x8 __attribute__((ext_vector_type(8)));
typedef GAS unsigned gu32;
typedef GAS unsigned long long gu64;
#define RLX_AGENT __ATOMIC_RELAXED, __HIP_MEMORY_SCOPE_AGENT
#define LDS_WAIT() asm volatile("s_waitcnt lgkmcnt(0)" ::: "memory")
#define VM_WAIT() asm volatile("s_waitcnt vmcnt(0)" ::: "memory")
__device__ __forceinline__ unsigned long long rt() { return __builtin_amdgcn_s_memrealtime(); }
#define XB_TMO      128
#define XB_XCNT(j)  (256  + 64 * (j))
#define XB_XSUB(j)  (1280 + 64 * (j))
#define XB_XGEN(j)  (2304 + 64 * (j))
#define XB_TOP      3328
#define XB_TOPGEN   3392
#define XCD_BAR_WORDS 3456
#define XB_SPIN_CAP (1u << 18)

__device__ __forceinline__ unsigned xb_ld(unsigned* p)              { return __hip_atomic_load(p, __ATOMIC_RELAXED, __HIP_MEMORY_SCOPE_AGENT); }
__device__ __forceinline__ unsigned xb_add(unsigned* p, unsigned v) { return __hip_atomic_fetch_add(p, v, __ATOMIC_RELAXED, __HIP_MEMORY_SCOPE_AGENT); }
__device__ __forceinline__ unsigned xb_xcc_id() { return (unsigned)__builtin_amdgcn_s_getreg((3 << 11) | 20) & 0xFu; }
#define XB_SPIN(cond, bar) do { unsigned _sp = 0; while (cond) { __builtin_amdgcn_s_sleep(1); \
    if ((++_sp & 255u) == 0u) { if (xb_ld(&(bar)[XB_TMO])) break; if (_sp > XB_SPIN_CAP) { atomicAdd(&(bar)[XB_TMO], 1u); break; } } } } while (0)

struct XcdBarrier {
    unsigned* bar; unsigned x; int w0;
    volatile LAS unsigned* st;
};

__device__ __forceinline__ XcdBarrier xcd_barrier_post(unsigned* bar, volatile LAS unsigned* st) {
    XcdBarrier b; b.bar = bar; b.x = xb_xcc_id(); b.st = st; b.w0 = __builtin_amdgcn_readfirstlane(threadIdx.x >> 6);
    if (threadIdx.x == 0) (void)xb_add(&bar[XB_XCNT(b.x)], 1u);
    return b;
}
__device__ __forceinline__ void xcd_barrier_complete(unsigned* bar, unsigned x, unsigned& nloc, unsigned& nx) {
    const unsigned G = gridDim.x * gridDim.y * gridDim.z;
    unsigned sum, cnt, mine, sp = 0u;
    for (;;) {
        sum = 0u; cnt = 0u; mine = 0u;
#pragma unroll
        for (unsigned j = 0; j < 16; ++j) { const unsigned c = xb_ld(&bar[XB_XCNT(j)]); sum += c; cnt += (c > 0u) ? 1u : 0u; mine = (j == x) ? c : mine; }
        if (sum == G) break;
        __builtin_amdgcn_s_sleep(1);
        if ((++sp & 255u) == 0u) { if (xb_ld(&bar[XB_TMO])) break; if (sp > XB_SPIN_CAP) { atomicAdd(&bar[XB_TMO], 1u); break; } }
    }
    nloc = mine > 0u ? mine : 1u; nx = cnt > 0u ? cnt : 1u;
}

__device__ __forceinline__ void xcd_barrier(const XcdBarrier& b) {
    asm volatile("s_waitcnt vmcnt(0)" ::: "memory");
    __syncthreads();
    if (b.w0 == 0 && __builtin_amdgcn_mbcnt_hi(~0u, __builtin_amdgcn_mbcnt_lo(~0u, 0u)) == 0u) {
        unsigned* bar = b.bar;
        __builtin_amdgcn_s_waitcnt(0);
        unsigned nloc = b.st[0], nx = b.st[1];
        if (nloc == 0u) { xcd_barrier_complete(bar, b.x, nloc, nx); b.st[0] = nloc; b.st[1] = nx; }
        const unsigned old = xb_add(&bar[XB_XSUB(b.x)], 1u);
        const unsigned gen = old / nloc;
        if (old + 1u == (gen + 1u) * nloc) {
            __builtin_amdgcn_fence(__ATOMIC_RELEASE, "agent");
            asm volatile("s_waitcnt vmcnt(0)" ::: "memory");
            const unsigned og = xb_add(&bar[XB_TOP], 1u);
            const unsigned tg = og / nx;
            if (og + 1u == (tg + 1u) * nx) xb_add(&bar[XB_TOPGEN], 1u);
            else XB_SPIN(xb_ld(&bar[XB_TOPGEN]) == tg, bar);
            __builtin_amdgcn_fence(__ATOMIC_ACQUIRE, "agent");
            xb_add(&bar[XB_XGEN(b.x)], 1u);
            asm volatile("s_waitcnt vmcnt(0)" ::: "memory");
        } else {
            XB_SPIN(xb_ld(&bar[XB_XGEN(b.x)]) == gen, bar);
            __builtin_amdgcn_fence(__ATOMIC_ACQUIRE, "agent");
            asm volatile("s_waitcnt vmcnt(0)" ::: "memory");
        }
    }
    __syncthreads();
}


namespace att {
typedef float f32x16 __attribute__((ext_vector_type(16)));
typedef short s16x4 __attribute__((ext_vector_type(4)));
typedef short v4i16_t __attribute__((ext_vector_type(4)));
typedef short bf16x8 __attribute__((ext_vector_type(8)));
typedef unsigned u32x4 __attribute__((ext_vector_type(4)));
#define ATT_LAS __attribute__((address_space(3)))
__device__ __forceinline__ int crow(int r, int hi) { return (r & 3) + 8 * (r >> 2) + 4 * hi; }
__device__ __forceinline__ unsigned cvtpk(float lo, float hi) { typedef float f2 __attribute__((ext_vector_type(2))); typedef __bf16 b2 __attribute__((ext_vector_type(2))); f2 v = {lo, hi}; b2 b = __builtin_convertvector(v, b2); return __builtin_bit_cast(unsigned, b); }
__device__ __forceinline__ float swapmax(float m) { auto rr = __builtin_amdgcn_permlane32_swap(__float_as_uint(m), __float_as_uint(m), false, false); return fmaxf(__uint_as_float(rr[0]), __uint_as_float(rr[1])); }
__device__ __forceinline__ float swapsum(float m) { auto rr = __builtin_amdgcn_permlane32_swap(__float_as_uint(m), __float_as_uint(m), false, false); return __uint_as_float(rr[0]) + __uint_as_float(rr[1]); }
__device__ __forceinline__ float sx(float v, int mask, int lane) { return __int_as_float(__builtin_amdgcn_ds_bpermute((lane ^ mask) << 2, __float_as_int(v))); }
constexpr float THR = 8.0f;
constexpr int NOMASK = -1000000;

struct TileSeq {
    int b, nt, mode  , q0, jlo;
    __device__ __forceinline__ int row(int t, int& kabs0) const {
        if (t < 4) { kabs0 = NOMASK; return 16384 + b * 256 + 64 * t; }
        if (mode == 0) { kabs0 = NOMASK; return b * 4096 + 64 * (t - 4); }
        const int j = jlo + t - 4; kabs0 = q0 - 128 + 64 * j; return b * 4096 + kabs0;
    }
};

__device__ __forceinline__ void dma16(const void* g, ATT_LAS unsigned char* l) {
    asm volatile("s_mov_b32 m0, %1\n\ts_nop 0\n\tglobal_load_lds_dwordx4 %0, off" :: "v"(g), "s"((unsigned)(unsigned long)l) : "memory", "m0");
}
template <int NS, int ND> __device__ __forceinline__ void issue_tile(ATT_LAS unsigned char* stage, const unsigned short* PROJ, int krow0, int kcol, int vcol, int wave, int lane) {
#pragma unroll
    for (int i = 0; i < NS; ++i) { const int p = wave + 8 * i, s = p >> 3, c = p & 7;
        const unsigned short* src = PROJ + (size_t)(krow0 + lane) * 2560 + kcol + 64 * s + 8 * c;
        dma16(src, stage + s * 8192 + c * 1024); }
#pragma unroll
    for (int i = 0; i < ND / 2; ++i) { const int p = wave + 8 * i, dblk = p >> 2, rg = p & 3;
        const unsigned short* src = PROJ + (size_t)(krow0 + 16 * rg + (lane >> 2)) * 2560 + vcol + 32 * dblk + 8 * (lane & 3);
        dma16(src, stage + NS * 8192 + (dblk * 4 + rg) * 1024); }
}
__device__ __forceinline__ s16x4 vtr(const ATT_LAS unsigned char* p) { return __builtin_bit_cast(s16x4, __builtin_amdgcn_ds_read_tr16_b64_v4i16((ATT_LAS v4i16_t*)p)); }

#define AT_ROWS_OUT(Ts_, ND_, Y_, qrow_, ycol_, lane_) do { asm volatile("s_waitcnt lgkmcnt(0)" ::: "memory"); \
        _Pragma("unroll") for (int j_ = 0; j_ < 2 * (ND_); ++j_) { const int idx_ = (lane_) + 64 * j_, row_ = idx_ / (4 * (ND_)), ch_ = idx_ % (4 * (ND_)); \
            const u32x4 v_ = *(const ATT_LAS u32x4*)((Ts_) + row_ * (64 * (ND_)) + ch_ * 16); \
            *(u32x4*)((Y_) + (size_t)((qrow_) + row_) * 1024 + (ycol_) + 8 * ch_) = v_; } } while (0)
#define AT_MX3(a, b, c) __builtin_fmaxf(__builtin_fmaxf((a), (b)), (c))
template <int NS, int ND> __device__ __forceinline__ void pv_step(f32x16 (&o)[NS][ND], const u32x4 (&pf)[NS][4], const ATT_LAS unsigned char* Vs);
template <int NS, int ND, int NSTG, bool QLDS>
__device__ __forceinline__ void attn_unit(ATT_LAS unsigned char* lds, const unsigned short* PROJ, unsigned short* Y, const TileSeq ts, int qrow, int qcol, int kcol, int vcol, int ycol,
                                          int qabs, float sinkl2, float lam, const float* subg, float oml, int tid) {
    constexpr int STAGE = NS * 8192 + ND * 4096, NDMA = NS + ND / 2;
    const int lane = tid & 63, r32 = lane & 31, hi = lane >> 5; const int wave = __builtin_amdgcn_readfirstlane(tid >> 6);
    constexpr int QBYTES = QLDS ? 8 * NS * 4096 : 0;
    ATT_LAS unsigned char* Qs = lds + NSTG * STAGE + wave * (NS * 4096);
    ATT_LAS float* wsf = (ATT_LAS float*)(lds + NSTG * STAGE + QBYTES) + wave * 64;
    int ka;
    { const int kr = ts.row(0, ka); issue_tile<NS, ND>(lds, PROJ, kr, kcol, vcol, wave, lane); }
    if (NSTG == 3 && ts.nt > 1) { const int kr = ts.row(1, ka); issue_tile<NS, ND>(lds + STAGE, PROJ, kr, kcol, vcol, wave, lane); }
    bf16x8 qf[NS][4];
#pragma unroll
    for (int s = 0; s < NS; ++s)
#pragma unroll
        for (int d0 = 0; d0 < 4; ++d0) { qf[s][d0] = *(const bf16x8*)(PROJ + (size_t)(qrow + r32) * 2560 + qcol + 64 * s + 16 * d0 + 8 * hi);
            if (QLDS) *(ATT_LAS bf16x8*)(Qs + (s * 8 + 2 * d0 + hi) * 512 + r32 * 16) = qf[s][d0]; }
    f32x16 o[NS][ND];
#pragma unroll
    for (int s = 0; s < NS; ++s)
#pragma unroll
        for (int d = 0; d < ND; ++d)
#pragma unroll
            for (int r = 0; r < 16; ++r) o[s][d][r] = 0.f;
    float mref[NS], lsum[NS];
#pragma unroll
    for (int s = 0; s < NS; ++s) { mref[s] = (NS == 1) ? sinkl2 : -1e30f; lsum[s] = (NS == 1 && hi == 0) ? 1.0f : 0.f; }
    const int koff = hi * 1024 + r32 * 16;
    const int voff = ((lane >> 4) & 1) * 32 + (lane & 3) * 8 + (4 * hi + ((lane & 15) >> 2)) * 64;
    __builtin_amdgcn_s_waitcnt(0x0F70);
    int st = 0;
    for (int t = 0; t < ts.nt; ++t) {
        if (NSTG == 3 && t + 1 < ts.nt) asm volatile("s_waitcnt vmcnt(%0)" ::"n"(NDMA) : "memory"); else asm volatile("s_waitcnt vmcnt(0)" ::: "memory");
        asm volatile("s_waitcnt lgkmcnt(0)" ::: "memory");
        __builtin_amdgcn_s_barrier();
        asm volatile("" ::: "memory");
        if (NSTG == 3) { if (t + 2 < ts.nt) { int k2; const int kr = ts.row(t + 2, k2); const int s2 = (st >= 1) ? st - 1 : 2; issue_tile<NS, ND>(lds + s2 * STAGE, PROJ, kr, kcol, vcol, wave, lane); } }
        else { if (t + 1 < ts.nt) { int k2; const int kr = ts.row(t + 1, k2); issue_tile<NS, ND>(lds + (st ^ 1) * STAGE, PROJ, kr, kcol, vcol, wave, lane); } }
        int kabs0; (void)ts.row(t, kabs0);
        const ATT_LAS unsigned char* Ks = lds + st * STAGE; const ATT_LAS unsigned char* Vs = Ks + NS * 8192;
        u32x4 pf[NS][4];
#pragma unroll
        for (int s = 0; s < NS; ++s) {
            f32x16 p0, p1;
#pragma unroll
            for (int r = 0; r < 16; ++r) { p0[r] = 0.f; p1[r] = 0.f; }
            bf16x8 kA[4], kB[4];
#pragma unroll
            for (int d0 = 0; d0 < 4; ++d0) { kA[d0] = *(const ATT_LAS bf16x8*)(Ks + s * 8192 + koff + d0 * 2048); kB[d0] = *(const ATT_LAS bf16x8*)(Ks + s * 8192 + koff + d0 * 2048 + 512); }
            __builtin_amdgcn_sched_group_barrier(0x100, 8, 0);
#pragma unroll
            for (int d0 = 0; d0 < 4; ++d0) {
                const bf16x8 qv = QLDS ? *(const ATT_LAS bf16x8*)(Qs + (s * 8 + 2 * d0 + hi) * 512 + r32 * 16) : qf[s][d0];
                p0 = __builtin_amdgcn_mfma_f32_32x32x16_bf16(kA[d0], qv, p0, 0, 0, 0);
                p1 = __builtin_amdgcn_mfma_f32_32x32x16_bf16(kB[d0], qv, p1, 0, 0, 0);
            }
            __builtin_amdgcn_sched_group_barrier(0x008, 8, 0);
            if (NS == 1 && kabs0 != NOMASK) {
                const int dq = qabs + r32 - kabs0 - 4 * hi;
#pragma unroll
                for (int r = 0; r < 16; ++r) { const int dk = dq - ((r & 3) + 8 * (r >> 2)); if (dk > 128 || dk < -128) p0[r] = -1e30f; if (dk - 32 > 128 || dk - 32 < -128) p1[r] = -1e30f; }
            }
            float rm; { float a_ = AT_MX3(p0[0], p0[1], p1[0]), b_ = AT_MX3(p0[2], p0[3], p1[1]); a_ = AT_MX3(a_, p1[2], p1[3]);
#pragma unroll
                for (int r = 4; r < 16; r += 4) { a_ = AT_MX3(a_, p0[r], p0[r + 1]); b_ = AT_MX3(b_, p0[r + 2], p0[r + 3]); a_ = AT_MX3(a_, p1[r], p1[r + 1]); b_ = AT_MX3(b_, p1[r + 2], p1[r + 3]); }
                rm = __builtin_fmaxf(a_, b_); }
            rm = swapmax(rm);
            if (__any(rm > mref[s] + THR)) {
                const float mn = fmaxf(mref[s], rm), f = __builtin_amdgcn_exp2f(mref[s] - mn);
                lsum[s] *= f; mref[s] = mn;
                if (hi == 0) wsf[r32] = f;
                float fr[16];
#pragma unroll
                for (int r = 0; r < 16; ++r) fr[r] = wsf[crow(r, hi)];
#pragma unroll
                for (int d = 0; d < ND; ++d)
#pragma unroll
                    for (int r = 0; r < 16; ++r) o[s][d][r] *= fr[r];
            }
            float sacc = lsum[s];
#pragma unroll
            for (int r = 0; r < 16; ++r) { p0[r] = __builtin_amdgcn_exp2f(p0[r] - mref[s]); p1[r] = __builtin_amdgcn_exp2f(p1[r] - mref[s]); sacc = sacc + p0[r]; sacc = sacc + p1[r]; }
            lsum[s] = sacc;
            pf[s][0] = (u32x4){cvtpk(p0[0], p0[1]), cvtpk(p0[2], p0[3]), cvtpk(p0[4], p0[5]), cvtpk(p0[6], p0[7])};
            pf[s][1] = (u32x4){cvtpk(p0[8], p0[9]), cvtpk(p0[10], p0[11]), cvtpk(p0[12], p0[13]), cvtpk(p0[14], p0[15])};
            pf[s][2] = (u32x4){cvtpk(p1[0], p1[1]), cvtpk(p1[2], p1[3]), cvtpk(p1[4], p1[5]), cvtpk(p1[6], p1[7])};
            pf[s][3] = (u32x4){cvtpk(p1[8], p1[9]), cvtpk(p1[10], p1[11]), cvtpk(p1[12], p1[13]), cvtpk(p1[14], p1[15])};
        }
        __builtin_amdgcn_sched_barrier(0);
        pv_step<NS, ND>(o, pf, Vs + voff);
        __builtin_amdgcn_sched_barrier(0);
        st = (NSTG == 3) ? ((st == 2) ? 0 : st + 1) : (st ^ 1);
    }
    unsigned lz_ = 0u; asm volatile("" : "+v"(lz_)); const int lane_e = (int)__builtin_amdgcn_mbcnt_hi(~0u, __builtin_amdgcn_mbcnt_lo(~0u, lz_));
    const int r32e = lane_e & 31, hie = lane_e >> 5;
    float inv[NS][16];
#pragma unroll
    for (int s = 0; s < NS; ++s) {
        const float lt = swapsum(lsum[s]);
        if (hie == 0) wsf[s * 32 + r32e] = 1.0f / lt;
    }
#pragma unroll
    for (int s = 0; s < NS; ++s)
#pragma unroll
        for (int r = 0; r < 16; ++r) inv[s][r] = wsf[s * 32 + crow(r, hie)];
    if (NS == 1) {
        ATT_LAS unsigned char* Ts = lds + NSTG * STAGE + QBYTES + 2048 + wave * (32 * 64 * ND);
#pragma unroll
        for (int r = 0; r < 16; ++r)
#pragma unroll
            for (int d = 0; d < ND; ++d) *(ATT_LAS unsigned short*)(Ts + crow(r, hie) * (64 * ND) + (32 * d + r32e) * 2) = f2bf(o[0][d][r] * inv[0][r]);
        AT_ROWS_OUT(Ts, ND, Y, qrow, ycol, lane_e);
    } else {
        float gsub[ND];
#pragma unroll
        for (int d = 0; d < ND; ++d) gsub[d] = subg[32 * d + r32e] * oml;
#pragma unroll
        for (int r = 0; r < 16; ++r) {
            float ss = 0.f; float ov[ND];
#pragma unroll
            for (int d = 0; d < ND; ++d) { ov[d] = o[0][d][r] * inv[0][r] - lam * (o[NS - 1][d][r] * inv[NS - 1][r]); ss += ov[d] * ov[d]; }
            ss += sx(ss, 1, lane_e); ss += sx(ss, 2, lane_e); ss += sx(ss, 4, lane_e); ss += sx(ss, 8, lane_e); ss += sx(ss, 16, lane_e);
            const float rstd = 1.0f / sqrtf(ss * (1.0f / (32 * ND)) + 1e-6f);
            unsigned short* yp = Y + (size_t)(qrow + crow(r, hie)) * 1024 + ycol + r32e;
#pragma unroll
            for (int d = 0; d < ND; ++d) yp[32 * d] = f2bf(ov[d] * rstd * gsub[d]);
        }
    }
    asm volatile("s_waitcnt lgkmcnt(0)" ::: "memory");
    __builtin_amdgcn_s_barrier();
    asm volatile("" ::: "memory");
}

#define ATT_MX3(a, b, c) __builtin_fmaxf(__builtin_fmaxf((a), (b)), (c))
template <int NS, int ND> __device__ __forceinline__ void pv_step(f32x16 (&o)[NS][ND], const u32x4 (&pf)[NS][4], const ATT_LAS unsigned char* Vs) {
    constexpr int NF = 4 * ND, PVDEP = 3;
    __builtin_amdgcn_s_setprio(1);
    bf16x8 vf[NF];
#define PV_LD(i_) do { const int ks_ = (i_) / ND, d_ = (i_) % ND; const s16x4 lo_ = vtr(Vs + d_ * 4096 + ks_ * 1024), hh_ = vtr(Vs + d_ * 4096 + ks_ * 1024 + 512); \
        vf[i_] = (bf16x8){lo_[0], lo_[1], lo_[2], lo_[3], hh_[0], hh_[1], hh_[2], hh_[3]}; } while (0)
#pragma unroll
    for (int i = 0; i < PVDEP; ++i) PV_LD(i);
    __builtin_amdgcn_sched_group_barrier(0x100, 2 * PVDEP, 0);
#pragma unroll
    for (int i = 0; i < NF; ++i) {
        if (i + PVDEP < NF) PV_LD(i + PVDEP);
#pragma unroll
        for (int s = 0; s < NS; ++s) o[s][i % ND] = __builtin_amdgcn_mfma_f32_32x32x16_bf16(__builtin_bit_cast(bf16x8, pf[s][i / ND]), vf[i], o[s][i % ND], 0, 0, 0);
        if (i + PVDEP < NF) __builtin_amdgcn_sched_group_barrier(0x100, 2, 0);
        __builtin_amdgcn_sched_group_barrier(0x008, NS, 0);
    }
#undef PV_LD
    __builtin_amdgcn_s_setprio(0);
}
template <int NS, int ND>
__device__ __forceinline__ void attn_unit_pp(ATT_LAS unsigned char* lds, const unsigned short* PROJ, unsigned short* Y, const TileSeq ts, int qrow, int qcol, int kcol, int vcol, int ycol,
                                             float lam, const float* subg, float oml, int tid) {
    constexpr int KB = NS * 8192, VB = ND * 4096, OFF_V = 2 * KB, OFF_Q = 2 * KB + 3 * VB, OFF_W = OFF_Q + 8 * NS * 4096;
    const int lane = tid & 63, r32 = lane & 31, hi = lane >> 5; const int wave = __builtin_amdgcn_readfirstlane(tid >> 6); const bool grpB = wave >= 4;
    ATT_LAS unsigned char* Qs = lds + OFF_Q + wave * (NS * 4096);
    ATT_LAS float* wsf = (ATT_LAS float*)(lds + OFF_W) + wave * 64;
#define PP_ISSUE(t_, kslot_, vslot_) do { int ka_; const int kr_ = ts.row((t_), ka_); \
        _Pragma("unroll") for (int i_ = 0; i_ < NS; ++i_) { const int p_ = wave + 8 * i_, s_ = p_ >> 3, c_ = p_ & 7; \
            dma16(PROJ + (size_t)(kr_ + lane) * 2560 + kcol + 64 * s_ + 8 * c_, lds + (kslot_) * KB + s_ * 8192 + c_ * 1024); } \
        _Pragma("unroll") for (int i_ = 0; i_ < ND / 2; ++i_) { const int p_ = wave + 8 * i_, db_ = p_ >> 2, rg_ = p_ & 3; \
            dma16(PROJ + (size_t)(kr_ + 16 * rg_ + (lane >> 2)) * 2560 + vcol + 32 * db_ + 8 * (lane & 3), lds + OFF_V + (vslot_) * VB + (db_ * 4 + rg_) * 1024); } } while (0)
    PP_ISSUE(0, 0, 0);
#pragma unroll
    for (int s = 0; s < NS; ++s)
#pragma unroll
        for (int d0 = 0; d0 < 4; ++d0) *(ATT_LAS bf16x8*)(Qs + (s * 8 + 2 * d0 + hi) * 512 + r32 * 16) = *(const bf16x8*)(PROJ + (size_t)(qrow + r32) * 2560 + qcol + 64 * s + 16 * d0 + 8 * hi);
    f32x16 o[NS][ND];
#pragma unroll
    for (int s = 0; s < NS; ++s)
#pragma unroll
        for (int d = 0; d < ND; ++d)
#pragma unroll
            for (int r = 0; r < 16; ++r) o[s][d][r] = 0.f;
    float mref[NS], lsum[NS];
#pragma unroll
    for (int s = 0; s < NS; ++s) { mref[s] = 0.f; lsum[s] = 0.f; }
    u32x4 pf[NS][4];
#pragma unroll
    for (int s = 0; s < NS; ++s)
#pragma unroll
        for (int k = 0; k < 4; ++k) pf[s][k] = (u32x4){0u, 0u, 0u, 0u};
    const int koff = hi * 1024 + r32 * 16;
    const int voff = ((lane >> 4) & 1) * 32 + (lane & 3) * 8 + (4 * hi + ((lane & 15) >> 2)) * 64;
#define PP_QKSM(Ks_, MID_) do { \
        _Pragma("unroll") for (int s = 0; s < NS; ++s) { \
            f32x16 p0, p1; \
            _Pragma("unroll") for (int r = 0; r < 16; ++r) { p0[r] = -mref[s]; p1[r] = -mref[s]; } \
            bf16x8 kA_[4], kB_[4], qq_[4];        \
            _Pragma("unroll") for (int d0 = 0; d0 < 2; ++d0) { \
                kA_[d0] = *(const ATT_LAS bf16x8*)((Ks_) + s * 8192 + koff + d0 * 2048); kB_[d0] = *(const ATT_LAS bf16x8*)((Ks_) + s * 8192 + koff + d0 * 2048 + 512); \
                qq_[d0] = *(const ATT_LAS bf16x8*)(Qs + (s * 8 + 2 * d0 + hi) * 512 + r32 * 16); } \
            __builtin_amdgcn_sched_group_barrier(0x100, 6, 0); \
            _Pragma("unroll") for (int d0 = 0; d0 < 4; ++d0) { \
                if (d0 + 2 < 4) { kA_[d0 + 2] = *(const ATT_LAS bf16x8*)((Ks_) + s * 8192 + koff + (d0 + 2) * 2048); kB_[d0 + 2] = *(const ATT_LAS bf16x8*)((Ks_) + s * 8192 + koff + (d0 + 2) * 2048 + 512); \
                    qq_[d0 + 2] = *(const ATT_LAS bf16x8*)(Qs + (s * 8 + 2 * (d0 + 2) + hi) * 512 + r32 * 16); } \
                p0 = __builtin_amdgcn_mfma_f32_32x32x16_bf16(kA_[d0], qq_[d0], p0, 0, 0, 0); \
                p1 = __builtin_amdgcn_mfma_f32_32x32x16_bf16(kB_[d0], qq_[d0], p1, 0, 0, 0); \
                __builtin_amdgcn_sched_group_barrier(0x008, 2, 0); \
                if (d0 + 2 < 4) __builtin_amdgcn_sched_group_barrier(0x100, 3, 0); } \
            float rm; { float a_ = ATT_MX3(p0[0], p0[1], p1[0]), b_ = ATT_MX3(p0[2], p0[3], p1[1]); a_ = ATT_MX3(a_, p1[2], p1[3]); \
                _Pragma("unroll") for (int r = 4; r < 16; r += 4) { a_ = ATT_MX3(a_, p0[r], p0[r + 1]); b_ = ATT_MX3(b_, p0[r + 2], p0[r + 3]); a_ = ATT_MX3(a_, p1[r], p1[r + 1]); b_ = ATT_MX3(b_, p1[r + 2], p1[r + 3]); } \
                rm = __builtin_fmaxf(a_, b_); } \
            rm = swapmax(rm); \
            if (__any(rm > THR || firstf != 0.f)) { const float dl = fmaxf(rm, (firstf != 0.f) ? -100.f : 0.f), f = __builtin_amdgcn_exp2f(-dl); mref[s] += dl; lsum[s] *= f; \
                _Pragma("unroll") for (int r = 0; r < 16; ++r) { p0[r] -= dl; p1[r] -= dl; } \
                if (hi == 0) wsf[r32] = f; \
                _Pragma("unroll") for (int r = 0; r < 16; ++r) { const float fr = wsf[crow(r, hi)]; _Pragma("unroll") for (int d = 0; d < ND; ++d) o[s][d][r] *= fr; } } \
            float sacc = lsum[s];        \
            _Pragma("unroll") for (int r = 0; r < 16; ++r) { p0[r] = __builtin_amdgcn_exp2f(p0[r]); p1[r] = __builtin_amdgcn_exp2f(p1[r]); sacc = sacc + p0[r]; sacc = sacc + p1[r]; } \
            lsum[s] = sacc; \
            pf[s][0] = (u32x4){cvtpk(p0[0], p0[1]), cvtpk(p0[2], p0[3]), cvtpk(p0[4], p0[5]), cvtpk(p0[6], p0[7])}; \
            pf[s][1] = (u32x4){cvtpk(p0[8], p0[9]), cvtpk(p0[10], p0[11]), cvtpk(p0[12], p0[13]), cvtpk(p0[14], p0[15])}; \
            pf[s][2] = (u32x4){cvtpk(p1[0], p1[1]), cvtpk(p1[2], p1[3]), cvtpk(p1[4], p1[5]), cvtpk(p1[6], p1[7])}; \
            pf[s][3] = (u32x4){cvtpk(p1[8], p1[9]), cvtpk(p1[10], p1[11]), cvtpk(p1[12], p1[13]), cvtpk(p1[14], p1[15])}; \
            if (s == 0) { MID_; }        \
        } \
        firstf = 0.f; asm volatile("" : "+v"(firstf)); } while (0)
#define PP_TOP() do { asm volatile("s_waitcnt vmcnt(0)" ::: "memory"); asm volatile("s_waitcnt lgkmcnt(0)" ::: "memory"); __builtin_amdgcn_s_barrier(); asm volatile("" ::: "memory"); } while (0)
    int kst = 0, vst = 0, vprev = 2;
    float firstf = 1.f; asm volatile("" : "+v"(firstf));
    if (!grpB) {
        for (int t = 0; t < ts.nt; ++t) {
            PP_TOP();
            const int vnext = (vst == 2) ? 0 : vst + 1;
            PP_QKSM(lds + kst * KB, if (t + 1 < ts.nt) PP_ISSUE(t + 1, kst ^ 1, vnext));
            __builtin_amdgcn_sched_barrier(0);
            pv_step<NS, ND>(o, pf, lds + OFF_V + vst * VB + voff);
            vst = vnext; kst ^= 1;
        }
    } else {
        for (int t = 0; t < ts.nt; ++t) {
            PP_TOP();
            const int vnext = (vst == 2) ? 0 : vst + 1;
            if (t > 0) pv_step<NS, ND>(o, pf, lds + OFF_V + vprev * VB + voff);
            __builtin_amdgcn_sched_barrier(0);
            PP_QKSM(lds + kst * KB, if (t + 1 < ts.nt) PP_ISSUE(t + 1, kst ^ 1, vnext));
            vprev = vst; vst = vnext; kst ^= 1;
        }
        pv_step<NS, ND>(o, pf, lds + OFF_V + vprev * VB + voff);
    }
#undef PP_QKSM
#undef PP_TOP
#undef PP_ISSUE
    unsigned lz_ = 0u; asm volatile("" : "+v"(lz_)); const int lane_e = (int)__builtin_amdgcn_mbcnt_hi(~0u, __builtin_amdgcn_mbcnt_lo(~0u, lz_));
    const int r32e = lane_e & 31, hie = lane_e >> 5;
    float inv[NS][16];
#pragma unroll
    for (int s = 0; s < NS; ++s) {
        const float lt = swapsum(lsum[s]);
        if (hie == 0) wsf[s * 32 + r32e] = 1.0f / lt;
    }
#pragma unroll
    for (int s = 0; s < NS; ++s)
#pragma unroll
        for (int r = 0; r < 16; ++r) inv[s][r] = wsf[s * 32 + crow(r, hie)];
    if (NS == 1) {
#pragma unroll
        for (int r = 0; r < 16; ++r) { unsigned short* yp = Y + (size_t)(qrow + crow(r, hie)) * 1024 + ycol + r32e;
#pragma unroll
            for (int d = 0; d < ND; ++d) yp[32 * d] = f2bf(o[0][d][r] * inv[0][r]); }
    } else {
        float gsub[ND];
#pragma unroll
        for (int d = 0; d < ND; ++d) gsub[d] = subg[32 * d + r32e] * oml;
#pragma unroll
        for (int r = 0; r < 16; ++r) {
            float ss = 0.f; float ov[ND];
#pragma unroll
            for (int d = 0; d < ND; ++d) { ov[d] = o[0][d][r] * inv[0][r] - lam * (o[NS - 1][d][r] * inv[NS - 1][r]); ss += ov[d] * ov[d]; }
            ss += sx(ss, 1, lane_e); ss += sx(ss, 2, lane_e); ss += sx(ss, 4, lane_e); ss += sx(ss, 8, lane_e); ss += sx(ss, 16, lane_e);
            const float rstd = 1.0f / sqrtf(ss * (1.0f / (32 * ND)) + 1e-6f);
#pragma unroll
            for (int d = 0; d < ND; ++d) *(ATT_LAS unsigned short*)(Qs + crow(r, hie) * (64 * ND) + (32 * d + r32e) * 2) = f2bf(ov[d] * rstd * gsub[d]);
        }
        AT_ROWS_OUT(Qs, ND, Y, qrow, ycol, lane_e);
    }
    asm volatile("s_waitcnt lgkmcnt(0)" ::: "memory");
    __builtin_amdgcn_s_barrier();
    asm volatile("" ::: "memory");
}
}

namespace lru {
typedef short bf16x8 __attribute__((ext_vector_type(8)));
typedef float f32x4 __attribute__((ext_vector_type(4)));
typedef unsigned u32x4 __attribute__((ext_vector_type(4)));
#define LRU_LAS __attribute__((address_space(3)))
constexpr int LXS = 528, UBS = 528, HSS = 1040;
constexpr int OFF_HS = 0, OFF_LX = 0, OFF_UB = 66560, OFF_HIN = 66560 + 33792;
__device__ __forceinline__ float sxl(float v, int srclane) { return __int_as_float(__builtin_amdgcn_ds_bpermute(srclane << 2, __float_as_int(v))); }
__device__ __forceinline__ float fsig(float x) { return __builtin_amdgcn_rcpf(1.0f + __builtin_amdgcn_exp2f(-1.4426950408889634f * x)); }


template <bool FINAL, int DIR>
__device__ __forceinline__ void lru_scan_part(LRU_LAS unsigned char* lds, const unsigned short* WL, const float* br, const float* bi, const float* lruc, float* SUMM, unsigned* PH, int rowbase, int b, int ck, int blk, int lane, int nt0, int nt1) {
    constexpr int dir = DIR;
    const int c16 = lane & 15, g = lane >> 4;
    const unsigned short* wbase = WL + (size_t)((dir * 4 + blk) * 2) * 4096;
    bf16x8 bwn[2][2]; float brn, bin_, cdn;
#define LRU_LOADW(nt_) do { const int chn_ = blk * 64 + 16 * (nt_) + c16; \
        _Pragma("unroll") for (int gt = 0; gt < 2; ++gt) _Pragma("unroll") for (int ks = 0; ks < 2; ++ks) bwn[gt][ks] = *(const bf16x8*)(wbase + (size_t)gt * 4096 + (16 * (nt_) + c16) * 64 + 32 * ks + 8 * g); \
        brn = br[dir * 256 + chn_]; bin_ = bi[dir * 256 + chn_]; cdn = lruc[dir * 256 + chn_]; } while (0)
    LRU_LOADW(nt0);
#pragma unroll 2
    for (int nt = nt0; nt < nt1; ++nt) {
        const int ch = blk * 64 + 16 * nt + c16;
        bf16x8 bw[2][2];
#pragma unroll
        for (int gt = 0; gt < 2; ++gt)
#pragma unroll
            for (int ks = 0; ks < 2; ++ks) bw[gt][ks] = bwn[gt][ks];
        const float brv = brn, biv = bin_, cdec = cdn;
        if (nt + 1 < nt1) LRU_LOADW(nt + 1);
        f32x4 ar[4], ai[4];
#pragma unroll
        for (int m = 0; m < 4; ++m) {
            ar[m] = (f32x4){0.f, 0.f, 0.f, 0.f}; ai[m] = ar[m];
#pragma unroll
            for (int ks = 0; ks < 2; ++ks) { const bf16x8 af = *(const LRU_LAS bf16x8*)(lds + OFF_UB + (16 * m + c16) * UBS + (blk * 64 + 32 * ks + 8 * g) * 2);
                ar[m] = __builtin_amdgcn_mfma_f32_16x16x32_bf16(af, bw[0][ks], ar[m], 0, 0, 0); ai[m] = __builtin_amdgcn_mfma_f32_16x16x32_bf16(af, bw[1][ks], ai[m], 0, 0, 0); }
        }
        float Pi[4][4], Hi[4][4], Ps[4], Hs[4];
#pragma unroll
        for (int m = 0; m < 4; ++m) {
            float P = 1.f, Hh = 0.f;
#pragma unroll
            for (int ee = 0; ee < 4; ++ee) { constexpr int dummy = 0; const int e = dir ? 3 - ee : ee;
                const int tok = 16 * m + 4 * g + e;
                const float r = fsig(ar[m][e] + brv), iv = fsig(ai[m][e] + biv), la = r * cdec, a = __builtin_amdgcn_exp2f(1.4426950408889634f * la);
                const float uval = __uint_as_float((unsigned)(*(const LRU_LAS unsigned short*)(lds + OFF_UB + tok * UBS + ch * 2)) << 16);
                const float bb = __builtin_amdgcn_sqrtf((1.f - a) * (1.f + a)) * iv * uval;
                Hh = a * Hh + bb; P = P * a; Pi[m][e] = P; Hi[m][e] = Hh; }
            Ps[m] = P; Hs[m] = Hh;
        }
        float Pc = 1.f, Hc = 0.f;
#pragma unroll
        for (int mm = 0; mm < 4; ++mm) { const int m = dir ? 3 - mm : mm;
            float P = Ps[m], Hh = Hs[m];
            {
                const int src = dir ? lane + 16 : lane - 16; const bool ok = dir ? (g <= 2) : (g >= 1);
                const float Pp = sxl(P, src & 63), Hp = sxl(Hh, src & 63); if (ok) { Hh = P * Hp + Hh; P = P * Pp; } }
            {
                const int src = dir ? lane + 32 : lane - 32; const bool ok = dir ? (g <= 1) : (g >= 2);
                const float Pp = sxl(P, src & 63), Hp = sxl(Hh, src & 63); if (ok) { Hh = P * Hp + Hh; P = P * Pp; } }
            float Pe, He;
            { const int src = dir ? lane + 16 : lane - 16; const bool ok = dir ? (g <= 2) : (g >= 1); const float Pp = sxl(P, src & 63), Hp = sxl(Hh, src & 63); Pe = ok ? Pp : 1.f; He = ok ? Hp : 0.f; }
            const int lastl = (dir ? 0 : 48) + c16; const float Pt = sxl(P, lastl), Ht = sxl(Hh, lastl);
            { const float Pb = Pe * Pc, Hb = Pe * Hc + He;
#pragma unroll
              for (int e = 0; e < 4; ++e) { const int tok = 16 * m + 4 * g + e; const float pt = Pi[m][e] * Pb, ht = Pi[m][e] * Hb + Hi[m][e];
                  PH[((size_t)dir * 17408 + rowbase + tok) * 256 + ch] = cvtpk2(pt, ht); } }
            Hc = Pt * Hc + Ht; Pc = Pt * Pc;
        }
        if (!FINAL) { if (g == 0) { float2 o; o.x = Pc; o.y = Hc; *(float2*)(SUMM + ((size_t)(b * 2 + dir) * 68 + ck) * 512 + 2 * ch) = o; } }
    }
#undef LRU_LOADW
}
template <bool FINAL>
__device__ __forceinline__ void lru_unit(LRU_LAS unsigned char* lds, const unsigned short* PROJ, unsigned short* Y, const unsigned short* WL, const float* cw, const float* cb,
                                         const float* br, const float* bi, const float* lruc, float* SUMM, unsigned* PH, int b, int ck, int mode, int tid) {
    const int lane = tid & 63; const int wave = __builtin_amdgcn_readfirstlane(tid >> 6);
    const int seqbase = (ck < 4) ? 16384 + b * 256 : b * 4096, pos0 = (ck < 4) ? 64 * ck : 64 * (ck - 4), len = (ck < 4) ? 256 : 4096;
    {
        u32x4 v[5];
#pragma unroll
        for (int k = 0; k < 5; ++k) { int it = tid + 512 * k; it = (it < 67 * 32) ? it : 67 * 32 - 1; const int i = it >> 5, c = it & 31, p = pos0 - 2 + i; const int pc = p < 0 ? 0 : (p >= len ? len - 1 : p);
            v[k] = *(const u32x4*)(PROJ + (size_t)(seqbase + pc) * 2560 + 8 * c); }
#pragma unroll
        for (int k = 0; k < 5; ++k) { const int it = tid + 512 * k; const int i = it >> 5, c = it & 31, p = pos0 - 2 + i; const bool ok = (p >= 0 && p < len);
            const u32x4 z = {0u, 0u, 0u, 0u}; if (it < 67 * 32) *(LRU_LAS u32x4*)(lds + OFF_LX + i * LXS + c * 16) = ok ? v[k] : z; }
    }
    __syncthreads();
    {
        const int ch2 = tid & 127, tg = tid >> 7; float w0[4], w1[4];
#pragma unroll
        for (int k = 0; k < 4; ++k) { w0[k] = cw[k * 256 + 2 * ch2]; w1[k] = cw[k * 256 + 2 * ch2 + 1]; }
        const float b0 = cb[2 * ch2], b1 = cb[2 * ch2 + 1];
        float x0[4], x1[4];
#pragma unroll
        for (int k = 0; k < 3; ++k) { const unsigned v = *(const LRU_LAS unsigned*)(lds + OFF_LX + (tg * 16 + k) * LXS + ch2 * 4); x0[k + 1] = __uint_as_float(v << 16); x1[k + 1] = __uint_as_float(v & 0xffff0000u); }
#pragma unroll
        for (int t = 0; t < 16; ++t) {
            x0[0] = x0[1]; x0[1] = x0[2]; x0[2] = x0[3]; x1[0] = x1[1]; x1[1] = x1[2]; x1[2] = x1[3];
            const unsigned v = *(const LRU_LAS unsigned*)(lds + OFF_LX + (tg * 16 + t + 3) * LXS + ch2 * 4); x0[3] = __uint_as_float(v << 16); x1[3] = __uint_as_float(v & 0xffff0000u);
            const float u0 = b0 + w0[0] * x0[0] + w0[1] * x0[1] + w0[2] * x0[2] + w0[3] * x0[3], u1 = b1 + w1[0] * x1[0] + w1[1] * x1[1] + w1[2] * x1[2] + w1[3] * x1[3];
            *(LRU_LAS unsigned*)(lds + OFF_UB + (tg * 16 + t) * UBS + ch2 * 4) = cvtpk2(u0, u1);
        }
    }
    __syncthreads();
    { const int dsel = (mode == 0) ? (wave & 1) : (mode - 1), nt0 = (mode == 0) ? 0 : 2 * (wave & 1), nt1 = (mode == 0) ? 4 : nt0 + 2;
      if (dsel) lru_scan_part<FINAL, 1>(lds, WL, br, bi, lruc, SUMM, PH, seqbase + pos0, b, ck, wave >> 1, lane, nt0, nt1);
      else      lru_scan_part<FINAL, 0>(lds, WL, br, bi, lruc, SUMM, PH, seqbase + pos0, b, ck, wave >> 1, lane, nt0, nt1); }
    __syncthreads();
}

__device__ __forceinline__ void lru_final_unit(LRU_LAS unsigned char* lds, const unsigned short* PROJ, unsigned short* Y, const float* SUMM, const unsigned* PH, int b, int ck, int tid) {
    const int seqbase = (ck < 4) ? 16384 + b * 256 : b * 4096, pos0 = (ck < 4) ? 64 * ck : 64 * (ck - 4);
    { const int ch = tid & 255, dir = tid >> 8; const float* sp = SUMM + ((size_t)(b * 2 + dir) * 68) * 512 + 2 * ch;
      const int np = dir ? ((ck < 4) ? 3 - ck : 4 + (67 - ck)) : ck; float hin = 0.f;
      for (int p0 = 0; p0 < np; p0 += 16) { float2 v[16];
#pragma unroll
          for (int j = 0; j < 16; ++j) { int p = p0 + j; p = (p < np) ? p : np - 1; const int c = dir ? ((p < 4) ? 3 - p : 67 - (p - 4)) : p; v[j] = *(const float2*)(sp + (size_t)c * 512); }
#pragma unroll
          for (int j = 0; j < 16; ++j) { const bool ok = (p0 + j) < np; const float px = ok ? v[j].x : 1.f, hy = ok ? v[j].y : 0.f; hin = px * hin + hy; } }
      *(LRU_LAS float*)(lds + tid * 4) = hin; }
    __syncthreads();
    const int tok = tid >> 3, cg = tid & 7; const size_t row = (size_t)seqbase + pos0 + tok;
#pragma unroll
    for (int j = 0; j < 4; ++j) { const int c0 = 32 * cg + 8 * j;
        const u32x4 f0 = *(const u32x4*)(PH + row * 256 + c0), f1 = *(const u32x4*)(PH + row * 256 + c0 + 4), r0 = *(const u32x4*)(PH + ((size_t)17408 + row) * 256 + c0), r1 = *(const u32x4*)(PH + ((size_t)17408 + row) * 256 + c0 + 4);
        const u32x4 lg = *(const u32x4*)(PROJ + row * 2560 + 256 + c0);
        const unsigned ff[8] = {f0.x, f0.y, f0.z, f0.w, f1.x, f1.y, f1.z, f1.w}, rr[8] = {r0.x, r0.y, r0.z, r0.w, r1.x, r1.y, r1.z, r1.w}; const unsigned lgw[4] = {lg.x, lg.y, lg.z, lg.w};
        float y[8];
#pragma unroll
        for (int k = 0; k < 8; ++k) { const float hf = *(const LRU_LAS float*)(lds + (c0 + k) * 4), hr = *(const LRU_LAS float*)(lds + (256 + c0 + k) * 4);
            const float h = (__uint_as_float(ff[k] & 0xffff0000u) + __uint_as_float(ff[k] << 16) * hf) + (__uint_as_float(rr[k] & 0xffff0000u) + __uint_as_float(rr[k] << 16) * hr);
            const float g = (k & 1) ? __uint_as_float(lgw[k >> 1] & 0xffff0000u) : __uint_as_float(lgw[k >> 1] << 16); y[k] = h * g; }
        u32x4 o; o.x = cvtpk2(y[0], y[1]); o.y = cvtpk2(y[2], y[3]); o.z = cvtpk2(y[4], y[5]); o.w = cvtpk2(y[6], y[7]);
        *(u32x4*)(Y + row * 1024 + c0) = o; }
    __syncthreads();
}
}

#include <utility>
constexpr int NWAVES = 8;
constexpr int RING_OFF = 0, RING_BYTES = 150528;
constexpr int LDSCTL_OFF = RING_BYTES, MISC_OFF = LDSCTL_OFF + 320;
constexpr int LDS_BYTES = 155648;
constexpr int CW_BAR = 4096;
constexpr int MAX_LAUNCHES = 16;
static_assert((CW_BAR + MAX_LAUNCHES * XCD_BAR_WORDS) * 4 <= (int)(1u << 20), "CTL words inside the memset region");

constexpr int PH_PRO = 0, PH_PRO2 = 1, PH_L0 = 2, PH_PER_LAYER = 11, PH_FINAL = PH_L0 + 2 * PH_PER_LAYER, NPH = PH_FINAL + 1;
constexpr int EPI_OFF = LDSCTL_OFF + 1024;

#ifndef MK_REPEAT_PH
#define MK_REPEAT_PH (-1)
#endif
struct Args { const float* in[24]; float* out; unsigned char* ws; int ph_lo, ph_hi, li, rep; };

__device__ __forceinline__ float shfl_xor_l(float v, int mask, int lane) { return __int_as_float(__builtin_amdgcn_ds_bpermute((lane ^ mask) << 2, __float_as_int(v))); }
__device__ __forceinline__ float wave_sum(float v, int lane) {
#pragma unroll
    for (int o = 1; o < 64; o <<= 1) v += shfl_xor_l(v, o, lane);
    return v;
}
__device__ __forceinline__ unsigned pk2(float lo, float hi) { return cvtpk2(lo, hi); }

__device__ __forceinline__ void p0_transpose_item(const float* W, int K, int N, bf16_t* WT, int kind, LAS float* scr, int item, int lane) {
    const int nblk = N / 64, kb = item / nblk, nb = item % nblk, k0 = 64 * kb, n0 = 64 * nb;
    const int rr = lane >> 4, cq = lane & 15;
    f32x4 v[16];
#pragma unroll
    for (int i = 0; i < 16; ++i) v[i] = *(const f32x4*)(W + (size_t)(k0 + 4 * i + rr) * N + n0 + 4 * cq);
#pragma unroll
    for (int i = 0; i < 16; ++i) { LAS float* p = scr + (4 * i + rr) * 65 + 4 * cq; p[0] = v[i].x; p[1] = v[i].y; p[2] = v[i].z; p[3] = v[i].w; }
    LDS_WAIT(); asm volatile("" ::: "memory");
    const int c = lane & 7;
#pragma unroll
    for (int j = 0; j < 8; ++j) { const int n = (lane >> 3) + 8 * j; const LAS float* s = scr + (8 * c) * 65 + n;
        v4u o; o.x = pk2(s[0 * 65], s[1 * 65]); o.y = pk2(s[2 * 65], s[3 * 65]); o.z = pk2(s[4 * 65], s[5 * 65]); o.w = pk2(s[6 * 65], s[7 * 65]);
        *(GAS v4u*)(WT + (size_t)dest_row(kind, n0 + n) * K + k0 + 8 * c) = o; }
    LDS_WAIT(); asm volatile("" ::: "memory");
}

struct ConvDesc { const float* W; bf16_t* WT; int K, N, kind, item; };
__device__ __forceinline__ void p0_load(const ConvDesc& d, f32x4 (&v)[16], int lane) {
    const int nblk = d.N / 64, kb = d.item / nblk, nb = d.item % nblk, k0 = 64 * kb, n0 = 64 * nb; const int rr = lane >> 4, cq = lane & 15;
#pragma unroll
    for (int i = 0; i < 16; ++i) v[i] = *(const f32x4*)(d.W + (size_t)(k0 + 4 * i + rr) * d.N + n0 + 4 * cq);
}
__device__ __forceinline__ void p0_finish(const ConvDesc& d, const f32x4 (&v)[16], LAS float* scr, int lane) {
    const int nblk = d.N / 64, kb = d.item / nblk, nb = d.item % nblk, k0 = 64 * kb, n0 = 64 * nb; const int rr = lane >> 4, cq = lane & 15;
#pragma unroll
    for (int i = 0; i < 16; ++i) { LAS float* p = scr + (4 * i + rr) * 65 + 4 * cq; p[0] = v[i].x; p[1] = v[i].y; p[2] = v[i].z; p[3] = v[i].w; }
    LDS_WAIT(); asm volatile("" ::: "memory");
    const int c = lane & 7;
#pragma unroll
    for (int j = 0; j < 8; ++j) { const int n = (lane >> 3) + 8 * j; const LAS float* s = scr + (8 * c) * 65 + n;
        v4u o; o.x = pk2(s[0 * 65], s[1 * 65]); o.y = pk2(s[2 * 65], s[3 * 65]); o.z = pk2(s[4 * 65], s[5 * 65]); o.w = pk2(s[6 * 65], s[7 * 65]);
        *(GAS v4u*)(d.WT + (size_t)dest_row(d.kind, n0 + n) * d.K + k0 + 8 * c) = o; }
    LDS_WAIT(); asm volatile("" ::: "memory");
}

__device__ __forceinline__ void norm_row(const float* src, const float* g, const float* shift, const float* scale, bf16_t* orow, int lane) {
    const f32x4* xr = (const f32x4*)src + lane; f32x4 v[4]; float s = 0.f;
#pragma unroll
    for (int j = 0; j < 4; ++j) { v[j] = xr[64 * j]; s += (v[j].x * v[j].x + v[j].y * v[j].y) + (v[j].z * v[j].z + v[j].w * v[j].w); }
    const float rstd = 1.0f / sqrtf(wave_sum(s, lane) * (1.0f / D) + 1e-6f);
    unsigned long long* o8 = (unsigned long long*)orow + lane;
#pragma unroll
    for (int j = 0; j < 4; ++j) { const int c0 = (lane + 64 * j) * 4; const f32x4 gg = *(const f32x4*)(g + c0), sc = *(const f32x4*)(scale + c0), sh = *(const f32x4*)(shift + c0);
        const f32x4 y = v[j] * rstd * gg * (sc + 1.0f) + sh;
        o8[64 * j] = (unsigned long long)pk2(y.x, y.y) | ((unsigned long long)pk2(y.z, y.w) << 32); }
}

__device__ __forceinline__ void norm_regs(const f32x4 (&v)[4], const float* g, const float* shift, const float* scale, bf16_t* orow, int lane) {
    float s = 0.f;
#pragma unroll
    for (int j = 0; j < 4; ++j) s += (v[j].x * v[j].x + v[j].y * v[j].y) + (v[j].z * v[j].z + v[j].w * v[j].w);
    const float rstd = 1.0f / sqrtf(wave_sum(s, lane) * (1.0f / D) + 1e-6f);
    unsigned long long* o8 = (unsigned long long*)orow + lane;
#pragma unroll
    for (int j = 0; j < 4; ++j) { const int c0 = (lane + 64 * j) * 4; const f32x4 gg = *(const f32x4*)(g + c0), sc = *(const f32x4*)(scale + c0), sh = *(const f32x4*)(shift + c0);
        const f32x4 y = v[j] * rstd * gg * (sc + 1.0f) + sh;
        o8[64 * j] = (unsigned long long)pk2(y.x, y.y) | ((unsigned long long)pk2(y.z, y.w) << 32); }
}

constexpr int I_GU = (D / 64) * (2 * DFF / 64), I_DN = (DFF / 64) * (D / 64), I_IN = (D / 64) * (NIN / 64), I_OUT = (D / 64) * (D / 64);
constexpr int R_GU1 = 0, R_GU2 = I_GU, R_DN1 = 2 * I_GU, R_DN2 = R_DN1 + I_DN, R_IN = R_DN2 + I_DN, R_OUT = R_IN + I_IN, I_LAYER = R_OUT + I_OUT;

struct KCtx { LAS unsigned char* lds; unsigned char* ws; float* out; const __attribute__((address_space(4))) unsigned long long* kin; int wave0, vcu, G, bx, ph_lo, ph_end; XcdBarrier bar; };
#define tidq() ({ int tq_ = tid; asm volatile("" : "+v"(tq_)); tq_; })
#define KIN(i) ((const float*)(const GAS float*)(kin[(i) + kz]))
template <int PHI> __device__ __forceinline__ void run_phase(const KCtx& kc) {
    if (PHI < kc.ph_lo || PHI >= kc.ph_end) return;
    constexpr int ph = (MK_REPEAT_PH >= 0 && PHI > MK_REPEAT_PH) ? PHI - 1 : PHI;
    LAS unsigned char* lds = kc.lds; unsigned char* ws = kc.ws; const __attribute__((address_space(4))) unsigned long long* kin = kc.kin;
    const int wave0 = kc.wave0, vcu = kc.vcu, G = kc.G, bx = kc.bx, NGW = kc.G * NWAVES;
    struct { float* out; } args; args.out = kc.out;
        unsigned lz = 0u; asm volatile("" : "+v"(lz)); const int lane_o = (int)__builtin_amdgcn_mbcnt_hi(~0u, __builtin_amdgcn_mbcnt_lo(~0u, lz));
        const int lane = lane_o, wave = wave0, tid = wave0 * 64 + lane_o, gw = vcu * NWAVES + wave;
        int kz = 0; asm volatile("" : "+s"(kz));
        unsigned long long wsi = (unsigned long long)ws; asm volatile("" : "+s"(wsi)); unsigned char* wsp = (unsigned char*)(GAS unsigned char*)wsi;
        float* MOD = (float*)(wsp + WS_MOD); Tab* T = (Tab*)(wsp + WS_TAB); bf16_t* W = (bf16_t*)(wsp + WS_W); float* H = (float*)(wsp + WS_H);
        bf16_t* HB = (bf16_t*)(wsp + WS_R); bf16_t* PROJ = (bf16_t*)(wsp + WS_R + R_PROJ); bf16_t* Y = (bf16_t*)(wsp + WS_R + R_Y);
        unsigned long long outi = (unsigned long long)args.out; asm volatile("" : "+s"(outi)); float* outp = (float*)(GAS float*)outi; bf16_t* XN = (bf16_t*)outp;
        auto conv_desc = [&](int l, int r) -> ConvDesc {
            const float* src; int K_, N_, kind; size_t off;
            if (r < R_GU2)      {             src = KIN(7)  + (size_t)l * D * 2 * DFF; K_ = D;   N_ = 2 * DFF; kind = 1; off = OFF_GU1; }
            else if (r < R_DN1) { r -= R_GU2; src = KIN(9)  + (size_t)l * D * 2 * DFF; K_ = D;   N_ = 2 * DFF; kind = 1; off = OFF_GU2; }
            else if (r < R_DN2) { r -= R_DN1; src = KIN(8)  + (size_t)l * DFF * D;     K_ = DFF; N_ = D;       kind = 0; off = OFF_DN1; }
            else if (r < R_IN)  { r -= R_DN2; src = KIN(10) + (size_t)l * DFF * D;     K_ = DFF; N_ = D;       kind = 0; off = OFF_DN2; }
            else if (r < R_OUT) { r -= R_IN;  src = KIN(11) + (size_t)l * D * NIN;     K_ = D;   N_ = NIN;     kind = 2; off = OFF_IN; }
            else                { r -= R_OUT; src = KIN(12) + (size_t)l * D * D;       K_ = D;   N_ = D;       kind = 0; off = OFF_OUT; }
            return ConvDesc{src, W + (size_t)l * W_LAYER + off, K_, N_, kind, r};
        };
        auto conv_range = [&](int l, int r0, int r1, int nb, int bi) {
            const int step = nb * NWAVES; int r = r0 + bi * NWAVES + wave; if (r >= r1) return;
            LAS float* scr = (LAS float*)(lds + wave * 16896);
            ConvDesc dc = conv_desc(l, r); f32x4 vc[16]; p0_load(dc, vc, lane);
            for (;;) {
                const int rn = r + step; const bool hn = rn < r1; ConvDesc dn = conv_desc(l, hn ? rn : r); f32x4 vn[16];
                if (hn) p0_load(dn, vn, lane);
                p0_finish(dc, vc, scr, lane);
                if (!hn) break;
#pragma unroll
                for (int i = 0; i < 16; ++i) vc[i] = vn[i];
                dc = dn; r = rn;
            }
        };
        auto sw_rows = [&](int l, int k, int nb, int bi) {
            const int N = (k == 1) ? NIN : 2 * DFF; const bf16_t* Wt = W + (size_t)l * W_LAYER + (k == 0 ? OFF_GU1 : k == 1 ? OFF_IN : OFF_GU2); float* SWp = (float*)(wsp + WS_SW) + (size_t)(l * 3 + k) * 4 * 5632;
            f32x4 sh[4][4];
#pragma unroll
            for (int b = 0; b < 4; ++b)
#pragma unroll
                for (int j = 0; j < 4; ++j) sh[b][j] = *(const f32x4*)(MOD + (size_t)l * 5 * NMODW + (size_t)b * NMODW + (3 * k) * D + lane * 16 + 4 * j);
            const int stride = nb * NWAVES;
            for (int p0 = bi * NWAVES + wave; p0 < N; p0 += 4 * stride) {
                int pr[4]; bool hv[4]; v4u w0[4], w1[4];
#pragma unroll
                for (int q = 0; q < 4; ++q) { pr[q] = p0 + q * stride; hv[q] = pr[q] < N; const int pc = hv[q] ? pr[q] : p0; w0[q] = *(const v4u*)(Wt + (size_t)pc * D + lane * 16); w1[q] = *(const v4u*)(Wt + (size_t)pc * D + lane * 16 + 8); }
                float a[4][4];
#pragma unroll
                for (int q = 0; q < 4; ++q) { const unsigned ww[8] = {w0[q].x, w0[q].y, w0[q].z, w0[q].w, w1[q].x, w1[q].y, w1[q].z, w1[q].w};
#pragma unroll
                    for (int b = 0; b < 4; ++b) a[q][b] = 0.f;
#pragma unroll
                    for (int j = 0; j < 8; ++j) { const float lo = __uint_as_float(ww[j] << 16), hi = __uint_as_float(ww[j] & 0xffff0000u);
#pragma unroll
                        for (int b = 0; b < 4; ++b) a[q][b] += lo * sh[b][j >> 1][(2 * j) & 3] + hi * sh[b][j >> 1][(2 * j + 1) & 3]; } }
#pragma unroll
                for (int q = 0; q < 4; ++q)
#pragma unroll
                    for (int b = 0; b < 4; ++b) { const float sa = wave_sum(a[q][b], lane); if (lane == 0 && hv[q]) SWp[(size_t)b * 5632 + pr[q]] = sa; }
            }
        };
        if (ph == PH_PRO) {
            const float* cc = KIN(1); const float* c_ctx = KIN(3); const float* w_ada = KIN(4); const float* b_ada = KIN(5);
            LAS float* sc = (LAS float*)lds; LAS float* red = (LAS float*)(lds + 20480);
            for (int i = tid; i < 5 * 1024; i += NWAVES * 64) { const int b = i >> 10, k = i & 1023; const float v = b < 4 ? cc[b * 1024 + k] : c_ctx[k]; sc[i] = v / (1.f + __expf(-v)); }
            __syncthreads();
            for (int item = bx; item < 288; item += G) {
                const int l = item / 144, col0 = (item % 144) * 64, cq = tid & 15, kg = tid >> 4;
                const float* wp = w_ada + (size_t)l * D * NMODW + (size_t)(kg * 32) * NMODW + col0 + 4 * cq;
                f32x4 a0 = {0, 0, 0, 0}, a1 = a0, a2 = a0, a3 = a0, a4 = a0;
#pragma unroll 8
                for (int k = 0; k < 32; ++k) { const f32x4 wv = *(const f32x4*)(wp + (size_t)k * NMODW); const int kk = kg * 32 + k;
                    a0 += wv * sc[kk]; a1 += wv * sc[1024 + kk]; a2 += wv * sc[2048 + kk]; a3 += wv * sc[3072 + kk]; a4 += wv * sc[4096 + kk]; }
                LAS f32x4* rp = (LAS f32x4*)(red + (size_t)kg * 320 + 4 * cq);
                rp[0] = a0; rp[16] = a1; rp[32] = a2; rp[48] = a3; rp[64] = a4;
                __syncthreads();
                if (tid < 320) { float s = 0.f;
#pragma unroll 8
                    for (int k = 0; k < 32; ++k) s += red[k * 320 + tid];
                    const int b = tid >> 6, cidx = tid & 63; MOD[(size_t)l * 5 * NMODW + (size_t)b * NMODW + col0 + cidx] = s + b_ada[l * NMODW + col0 + cidx]; }
                __syncthreads();
            }
            for (int i = (bx * NWAVES * 64 + tid); i < 2 * 65536; i += G * NWAVES * 64) {
                const int l = i >> 16, r = i & 65535; const int c = r & 63, d = (r >> 6) & 63, ri = (r >> 12) & 1, blk = (r >> 13) & 3, dir = r >> 15;
                const float* src = (ri ? KIN(17) : KIN(15)) + (size_t)l * 32768;
                W[(size_t)l * W_LAYER + OFF_LRU + r] = f2bf(src[((size_t)(dir * 4 + blk) * 64 + c) * 64 + d]);
            }
            conv_range(0, R_GU1, R_GU2, G, bx);
        } else if (ph == PH_FINAL) {
            const float* fg = KIN(23); const bf16_t* Hb = (const bf16_t*)(wsp + WS_H);
            for (int row = gw; row < ML; row += NGW) {
                const v4u w0 = *(const v4u*)(Hb + (size_t)row * D + lane * 16), w1 = *(const v4u*)(Hb + (size_t)row * D + lane * 16 + 8);
                const unsigned ww[8] = {w0.x, w0.y, w0.z, w0.w, w1.x, w1.y, w1.z, w1.w}; float v[16]; float sq = 0.f;
#pragma unroll
                for (int j = 0; j < 8; ++j) { v[2 * j] = __uint_as_float(ww[j] << 16); v[2 * j + 1] = __uint_as_float(ww[j] & 0xffff0000u); sq += v[2 * j] * v[2 * j] + v[2 * j + 1] * v[2 * j + 1]; }
                const float rstd = 1.0f / sqrtf(wave_sum(sq, lane) * (1.0f / D) + 1e-6f);
#pragma unroll
                for (int j = 0; j < 4; ++j) { const f32x4 g4 = *(const f32x4*)(fg + lane * 16 + 4 * j); f32x4 o; o.x = v[4 * j] * rstd * g4.x; o.y = v[4 * j + 1] * rstd * g4.y; o.z = v[4 * j + 2] * rstd * g4.z; o.w = v[4 * j + 3] * rstd * g4.w;
                    *(f32x4*)(outp + (size_t)row * D + lane * 16 + 4 * j) = o; }
            }
        } else if (ph == PH_PRO2) {
            float* GS = (float*)(wsp + WS_GS); float* SW = (float*)(wsp + WS_SW); float* SSQ = (float*)(wsp + WS_SSQ);
            for (int i = bx * NWAVES * 64 + tid; i < 2 * 3 * 5 * D; i += G * NWAVES * 64) { const int c = i & 1023, b = (i >> 10) % 5, k = ((i >> 10) / 5) % 3, l = (i >> 10) / 15;
                GS[i] = KIN(6)[(size_t)(l * 3 + k) * D + c] * (1.0f + MOD[(size_t)l * 5 * NMODW + (size_t)b * NMODW + (3 * k + 1) * D + c]); }
            sw_rows(0, 0, G, bx);
            { const float* x = KIN(0); const float* ctxp = KIN(2); const float* g0 = KIN(6);
              for (int row = gw; row < M; row += NGW) {
                if (row < ML) { const int b = row >> 12; const float* sc = MOD + (size_t)b * NMODW + D; const f32x4* xr = (const f32x4*)(x + (size_t)row * D) + lane; float s = 0.f;
                    unsigned long long* o8 = (unsigned long long*)(XN + (size_t)row * D) + lane; unsigned long long* h8 = (unsigned long long*)((bf16_t*)H + (size_t)row * D) + lane;
#pragma unroll
                    for (int j = 0; j < 4; ++j) { const f32x4 v = xr[64 * j]; const int c0 = (lane + 64 * j) * 4; s += (v.x * v.x + v.y * v.y) + (v.z * v.z + v.w * v.w);
                        h8[64 * j] = (unsigned long long)pk2(v.x, v.y) | ((unsigned long long)pk2(v.z, v.w) << 32);
                        const f32x4 y = v * *(const f32x4*)(g0 + c0) * (*(const f32x4*)(sc + c0) + 1.0f); o8[64 * j] = (unsigned long long)pk2(y.x, y.y) | ((unsigned long long)pk2(y.z, y.w) << 32); }
                    s = wave_sum(s, lane); if (lane == 0) *(f32x4*)(SSQ + (size_t)row * 4) = (f32x4){s, 0.f, 0.f, 0.f};
                } else { const float* src = ctxp + (size_t)(row - ML) * D; const float* shift = MOD + (size_t)4 * NMODW;
                    norm_row(src, g0, shift, shift + D, XN + (size_t)row * D, lane);
#pragma unroll
                    for (int j = 0; j < 4; ++j) ((f32x4*)(H + (size_t)row * D))[lane + 64 * j] = ((const f32x4*)src)[lane + 64 * j]; }
              } }
        } else {
            const int l = (ph - PH_L0) / PH_PER_LAYER, ty = (ph - PH_L0) % PH_PER_LAYER; const bool last = (l == 1);
            if (last && (ty == T_NC2 || ty == T_NC3)) return;
            bf16_t* Wl = W + (size_t)l * W_LAYER; const float* MODl = MOD + (size_t)l * 5 * NMODW;
            float* SSQ = (float*)(wsp + WS_SSQ); const float* GS = (const float*)(wsp + WS_GS); const float* SW = (const float*)(wsp + WS_SW);
            const int mrows = (last && ty >= T_OUT) ? ML : M;
            if (ty == T_NC1 || ty == T_NC2 || ty == T_NC3) {
                const int kk = (ty == T_NC1) ? 1 : (ty == T_NC2) ? 2 : 0, ln = (ty == T_NC3) ? l + 1 : l;
                const float* shift = MOD + (size_t)ln * 5 * NMODW + (size_t)4 * NMODW + (3 * kk) * D; const float* ngn = KIN(6) + (size_t)(ln * 3 + kk) * D;
                const int ns = (ty == T_NC2) ? 4 : 11;
                for (int row = ML + gw; row < M; row += NGW) {
                    f32x4* hr = (f32x4*)(H + (size_t)row * D) + lane; f32x4 v[4];
#pragma unroll
                    for (int j = 0; j < 4; ++j) v[j] = hr[64 * j];
#define NC_ALL(cnt_) do { typedef unsigned u32x2n __attribute__((ext_vector_type(2))); u32x2n w_[cnt_][4]; \
                        _Pragma("unroll") for (int q_ = 0; q_ < (cnt_); ++q_) { const u32x2n* sp = (const u32x2n*)((const bf16_t*)pg8::slab_ptr(wsi, outi, q_) + (size_t)(row - ML) * D) + lane; \
                            _Pragma("unroll") for (int j = 0; j < 4; ++j) w_[q_][j] = sp[64 * j]; } \
                        _Pragma("unroll") for (int q_ = 0; q_ < (cnt_); ++q_) _Pragma("unroll") for (int j = 0; j < 4; ++j) { const u32x2n t_ = w_[q_][j]; \
                            v[j] += (f32x4){__uint_as_float(t_.x << 16), __uint_as_float(t_.x & 0xffff0000u), __uint_as_float(t_.y << 16), __uint_as_float(t_.y & 0xffff0000u)}; } } while (0)
                    if (ns == 11) { NC_ALL(11); } else { NC_ALL(4); }
#undef NC_ALL
                    norm_regs(v, ngn, shift, shift + D, XN + (size_t)row * D, lane);
#pragma unroll
                    for (int j = 0; j < 4; ++j) hr[64 * j] = v[j];
                }
            } else if (ty == T_GU1 || ty == T_GU2) {
                pg8::Gemm g{XN, Wl + (ty == T_GU1 ? OFF_GU1 : OFF_GU2), mrows, 2 * DFF, D, D}; pg8::StaticOrder So; So.init(mrows, 2 * DFF, G, bx);
                pg8::EpiGU E{pg8::EpiCtx{wsi, outi, kin, l, ty}};
                pg8::gemm_phase<pg8::EpiGU, pg8::StaticOrder, true, true>(lds + RING_OFF, g, So, E, tidq());
                if (bx >= 216) {
                    const int bi = bx - 216;
                    if (l == 0 && ty == T_GU1) { conv_range(0, R_DN1, R_DN2, 40, bi); conv_range(0, R_IN, R_OUT, 40, bi); }
                    if (l == 0 && ty == T_GU2) { conv_range(1, R_GU1, R_GU2, 40, bi); }
                    if (l == 1 && ty == T_GU1) { conv_range(1, R_DN1, R_DN2, 40, bi); conv_range(1, R_IN, R_OUT, 40, bi); }
                }
            } else if (ty == T_DN1 || ty == T_DN2 || ty == T_OUT) {
                const bf16_t* A = (ty == T_OUT) ? Y : HB; const int K = (ty == T_OUT) ? D : DFF;
                const bf16_t* Bt = Wl + (ty == T_DN1 ? OFF_DN1 : ty == T_DN2 ? OFF_DN2 : OFF_OUT);
                {
                    pg8::Gemm g{A, Bt, M, D, K, K}; pg8::DnOrder So; So.so.init(ML, D, G, bx); So.ns = (mrows == M) ? K / 256 : 0; So.KS = 256; So.ntl = K / 64;
                    pg8::EpiDn E{pg8::EpiRes{pg8::EpiCtx{wsi, outi, kin, l, ty}, (LAS float*)(lds + EPI_OFF)}, pg8::EpiResAt{pg8::EpiCtx{wsi, outi, kin, l, ty}}};
                    pg8::gemm_phase<pg8::EpiDn, pg8::DnOrder, true, true>(lds + RING_OFF, g, So, E, tidq());
                }
                if (ty == T_DN1 && bx < 80)  { sw_rows(l, 1, 80, bx); conv_range(l, R_OUT, I_LAYER, 80, bx); }
                if (l == 0 && ty == T_OUT && bx < 192) { sw_rows(0, 2, 192, bx); sw_rows(1, 2, 192, bx); }
                if (l == 0 && ty == T_DN2 && bx < 80)  { sw_rows(1, 0, 80, bx); }
            } else if (ty == T_IN) {
                pg8::Gemm g{XN, Wl + OFF_IN, M, NIN, D, D}; pg8::StaticOrder So; So.init(M, NIN, G, bx);
                { const int tq = tidq(); *(LAS f32x4*)(lds + RING_OFF + pg8::STAGE_BYTES + 10240 + tq * 16) = *((const f32x4*)T->cosv + tq); asm volatile("s_waitcnt vmcnt(0) lgkmcnt(0)" ::: "memory"); __syncthreads(); }
                pg8::EpiIN E{pg8::EpiCtx{wsi, outi, kin, l, ty}, (const LAS float*)(lds + RING_OFF + pg8::STAGE_BYTES + 10240)};
                pg8::gemm_phase<pg8::EpiIN, pg8::StaticOrder, true, true>(lds + RING_OFF, g, So, E, tidq());
                if (bx >= 168) {
                    const int bi = bx - 168; if (l == 0) conv_range(0, R_GU2, R_DN1, 88, bi); conv_range(l, R_DN2, R_IN, 88, bi);
                }
            } else if (ty == T_M2) {
                return;
            } else if (ty == T_M1) {
              const float* cw = KIN(13) + (size_t)l * 1024; const float* cb = KIN(14) + (size_t)l * 256; const float* lbr = KIN(16) + (size_t)l * 512; const float* lbi = KIN(18) + (size_t)l * 512;
              float* SUMM = (float*)(wsp + WS_SUMM); unsigned* PH = (unsigned*)outp;
              gu32* lcnt = (gu32*)(wsp + WS_CTL) + 2048 + 64 * l;
              { unsigned nloc = 0;
                for (int u = vcu; u < 288; u += G) { int b, ck, mode; if (u < 256) { b = u >> 6; ck = 4 + (u & 63); mode = 0; } else { const int i2 = u - 256; b = i2 >> 3; ck = (i2 >> 1) & 3; mode = 1 + (i2 & 1); }
                    int tq = tid; asm volatile("" : "+v"(tq));
                    lru::lru_unit<false>(lds, PROJ, Y, Wl + OFF_LRU, cw, cb, lbr, lbi, T->lruc + l * 512, SUMM, PH, b, ck, mode, tq); ++nloc; }
                asm volatile("s_waitcnt vmcnt(0)" ::: "memory"); __syncthreads();
                if (wave == 0 && lane == 0) { __builtin_amdgcn_fence(__ATOMIC_RELEASE, "agent"); asm volatile("s_waitcnt vmcnt(0)" ::: "memory"); __hip_atomic_fetch_add(lcnt, nloc, __ATOMIC_RELAXED, __HIP_MEMORY_SCOPE_AGENT); }
              }
              {
                const float* sink = KIN(20) + l * 4;
                {
                    const int idx = vcu, b = idx >> 6, kvh = (idx >> 5) & 1, q0 = 128 * (idx & 31), g = wave >> 2, head = 2 * kvh + g;
                    att::TileSeq ts; ts.b = b; ts.mode = 1; ts.q0 = q0; ts.jlo = (q0 == 0) ? 2 : 0; { const int jh = (S - q0 + 128) / 64; ts.nt = 4 + ((jh < 6) ? jh : 6) - ts.jlo; }
                    { int tq = tid; asm volatile("" : "+v"(tq)); att::attn_unit<1, 2, 3, false>(lds, PROJ, Y, ts, b * S + q0 + 32 * (wave & 3), 512 + 64 * head, 768 + 64 * kvh, 896 + 64 * kvh, 256 + 64 * head, q0 + 32 * (wave & 3), sink[head] * LOG2E, 0.f, nullptr, 0.f, tq); }
                }
                if (!last && vcu >= 32 && vcu < 48) {
                    const int idx = vcu - 32, b = idx >> 2, kvh = (idx >> 1) & 1, qb = idx & 1, g = wave >> 2, head = 2 * kvh + g;
                    att::TileSeq ts; ts.b = b; ts.mode = 2; ts.q0 = 0; ts.jlo = 0; ts.nt = 4;
                    { int tq = tid; asm volatile("" : "+v"(tq)); att::attn_unit<1, 2, 3, false>(lds, PROJ, Y, ts, ML + b * LC + 128 * qb + 32 * (wave & 3), 512 + 64 * head, 768 + 64 * kvh, 896 + 64 * kvh, 256 + 64 * head, 0, sink[head] * LOG2E, 0.f, nullptr, 0.f, tq); }
                }
              }
              {
                const float lam = T->lam[l]; const float* subg = KIN(22) + l * 128; const float oml = 1.0f - (0.8f - 0.6f * __expf(-0.3f * (float)l));
                {
                    const int idx = vcu, b = idx >> 6, h = (idx >> 4) & 3, q0 = 256 * (idx & 15);
                    att::TileSeq ts; ts.b = b; ts.mode = 0; ts.q0 = 0; ts.jlo = 0; ts.nt = 68;
                    { int tq = tid; asm volatile("" : "+v"(tq)); att::attn_unit_pp<2, 4>(lds, PROJ, Y, ts, b * S + q0 + 32 * wave, 1024 + 128 * h, 1536 + 128 * h, 2048 + 128 * h, 512 + 128 * h, lam, subg, oml, tq); }
                }
                if (!last && vcu >= 48 && vcu < 64) {
                    const int idx = vcu - 48, b = idx >> 2, h = idx & 3;
                    att::TileSeq ts; ts.b = b; ts.mode = 2; ts.q0 = 0; ts.jlo = 0; ts.nt = 4;
                    { int tq = tid; asm volatile("" : "+v"(tq)); att::attn_unit_pp<2, 4>(lds, PROJ, Y, ts, ML + b * LC + 32 * wave, 1024 + 128 * h, 1536 + 128 * h, 2048 + 128 * h, 512 + 128 * h, lam, subg, oml, tq); }
                }
              }
              if (wave == 0) {
                  if (lane == 0) { unsigned spins = 0; while (__hip_atomic_load(lcnt, __ATOMIC_RELAXED, __HIP_MEMORY_SCOPE_AGENT) < 288u) { __builtin_amdgcn_s_sleep(8); if (++spins > (1u << 20)) break; } }
                  __builtin_amdgcn_fence(__ATOMIC_ACQUIRE, "agent"); asm volatile("s_waitcnt vmcnt(0)" ::: "memory");
              }
              __syncthreads();
              for (int u = vcu; u < 272; u += G) { const int b = u / 68, ck = u % 68; int tq = tid; asm volatile("" : "+v"(tq));
                  if (!(last && ck < 4)) lru::lru_final_unit(lds, PROJ, Y, SUMM, PH, b, ck, tq); }
              if (l == 0 && vcu >= 64) { __syncthreads(); conv_range(1, R_GU2, R_DN1, 192, vcu - 64); }
            }
        }
    if (PHI + 1 < kc.ph_end) xcd_barrier(kc.bar);
}
template <int... I> __device__ __forceinline__ void run_all(const KCtx& kc, std::integer_sequence<int, I...>) { (run_phase<I>(kc), ...); }

__global__ void __launch_bounds__(NWAVES * 64, 2) mk_fwd(Args args) {
    extern __shared__ __attribute__((aligned(16))) unsigned char lds_raw[];
    LAS unsigned char* lds = (LAS unsigned char*)lds_raw;
    volatile LAS unsigned* MISC = (volatile LAS unsigned*)(lds + MISC_OFF);
    const int tid0 = threadIdx.x; const int wave0 = __builtin_amdgcn_readfirstlane(tid0 >> 6);
    const int G = gridDim.x; const int bx = blockIdx.x; const int vcu = (G % 8 == 0) ? (bx % 8) * (G / 8) + bx / 8 : bx;
    unsigned char* ws = args.ws;
    gu32* ctl = (gu32*)(ws + WS_CTL);
    for (int u = tid0; u < (LDS_BYTES - LDSCTL_OFF) / 4; u += NWAVES * 64) ((LAS unsigned*)(lds + LDSCTL_OFF))[u] = 0u;
    __syncthreads();
    XcdBarrier bar = xcd_barrier_post((unsigned*)(ctl + CW_BAR) + args.li * XCD_BAR_WORDS, MISC + 8);

    const __attribute__((address_space(4))) unsigned long long* kin = (const __attribute__((address_space(4))) unsigned long long*)__builtin_amdgcn_kernarg_segment_ptr();
    const int NGW = G * NWAVES;

    if (args.ph_lo == PH_PRO && bx == 0) {
                const int tid = tid0; Tab* T = (Tab*)(ws + WS_TAB); const int kz = 0;
                const float* lru_lambda = KIN(19); const float* diff_lambda = KIN(21);
                for (int i = tid; i < 1024; i += NWAVES * 64) {
                    const int pos = i >> 4, f = i & 15;
                    const double q[4] = {1.0, 0.5623413251903491, 0.31622776601683794, 0.1778279410038923};
                    double inv = (f & 3) == 0 ? q[0] : (f & 3) == 1 ? q[1] : (f & 3) == 2 ? q[2] : q[3]; for (int j = 0; j < (f >> 2); ++j) inv *= 0.1;
                    const float ang = (float)pos * (float)inv;
                    double xx = (double)ang; const double TWO_PI = 6.283185307179586476925287, PI = 3.141592653589793238462643;
                    const double k = rint(xx * 0.15915494309189533577); double r = xx - k * TWO_PI;
                    double sgn = 1.0; if (r > PI * 0.5) { r = PI - r; sgn = -1.0; } else if (r < -PI * 0.5) { r = -PI - r; sgn = -1.0; }
                    const double r2 = r * r;
                    double ss = -1.9572941063391263e-20; ss = ss * r2 + 8.2206352466243295e-18; ss = ss * r2 - 2.8114572543455206e-15; ss = ss * r2 + 7.6471637318198164e-13; ss = ss * r2 - 1.6059043836821613e-10;
                    ss = ss * r2 + 2.5052108385441720e-08; ss = ss * r2 - 2.7557319223985893e-06; ss = ss * r2 + 1.9841269841269841e-04; ss = ss * r2 - 8.3333333333333332e-03; ss = ss * r2 + 1.6666666666666666e-01; ss = r - r * r2 * ss;
                    double cs = 4.1103176233121648e-19; cs = cs * r2 - 1.5619206968586226e-16; cs = cs * r2 + 4.7794773323873853e-14; cs = cs * r2 - 1.1470745597729725e-11; cs = cs * r2 + 2.0876756987868100e-09;
                    cs = cs * r2 - 2.7557319223985888e-07; cs = cs * r2 + 2.4801587301587302e-05; cs = cs * r2 - 1.3888888888888889e-03; cs = cs * r2 + 4.1666666666666664e-02; cs = cs * r2 - 0.5; cs = cs * r2 + 1.0;
                    T->cosv[i] = (float)(sgn * cs); T->sinv[i] = (float)ss;
                    T->lruc[i] = -8.0f * log1pf(expf(-lru_lambda[i]));
                }
                if (tid < 2) { const float* dl = diff_lambda + tid * 256; float s0 = 0.f, s1 = 0.f;
                    for (int j = 0; j < 64; ++j) { s0 += dl[j] * dl[64 + j]; s1 += dl[128 + j] * dl[192 + j]; }
                    T->lam[tid] = expf(s0) - expf(s1) + (0.8f - 0.6f * expf(-0.3f * (float)tid)); }
            }
    KCtx kc; kc.lds = lds; kc.ws = ws; kc.out = args.out; kc.kin = kin; kc.wave0 = wave0; kc.vcu = vcu; kc.G = G; kc.bx = bx; kc.ph_lo = args.ph_lo; kc.ph_end = args.ph_hi + (MK_REPEAT_PH >= 0 ? 1 : 0); kc.bar = bar;
    run_all(kc, std::make_integer_sequence<int, NPH + (MK_REPEAT_PH >= 0 ? 1 : 0)>{});
}

static void launch_seg(const Args& base, int lo, int hi, int& li, int grid, hipStream_t stream) {
    Args a = base; a.ph_lo = lo; a.ph_hi = hi; a.li = li++; a.rep = 0;
    void* kargs[] = {&a};
    hipError_t e = hipLaunchCooperativeKernel((const void*)mk_fwd, dim3(grid), dim3(NWAVES * 64), kargs, LDS_BYTES, stream);
    if (e != hipSuccess) fprintf(stderr, "kernel_launch: cooperative launch failed: %s (grid %d)\n", hipGetErrorString(e), grid);
}
extern "C" void kernel_launch(void* const* d_in, const int* in_sizes, int n_in, void* d_out, int out_size, void* d_ws, size_t ws_size, hipStream_t stream) {
    static int grid = 0;
    if (grid == 0) {
        if (n_in != 24 || ws_size < WS_END || out_size != ML * D) { fprintf(stderr, "kernel_launch: unexpected shapes (n_in %d, ws %zu need %zu, out %d)\n", n_in, ws_size, (size_t)WS_END, out_size); grid = -1; return; }
        int dev = 0, cus = 0, per_cu = 0;
        hipGetDevice(&dev); hipDeviceGetAttribute(&cus, hipDeviceAttributeMultiprocessorCount, dev);
        if (hipFuncSetAttribute((const void*)mk_fwd, hipFuncAttributeMaxDynamicSharedMemorySize, LDS_BYTES) != hipSuccess) { fprintf(stderr, "kernel_launch: hipFuncSetAttribute failed\n"); grid = -1; return; }
        if (hipOccupancyMaxActiveBlocksPerMultiprocessor(&per_cu, (const void*)mk_fwd, NWAVES * 64, LDS_BYTES) != hipSuccess || per_cu < 1) { fprintf(stderr, "kernel_launch: occupancy query says %d blocks per CU\n", per_cu); grid = -1; return; }
        (void)hipGetLastError();
        if (cus != 256) { fprintf(stderr, "kernel_launch: built for a 256-CU device (one workgroup per CU; the unit maps of the mixer phases assume it); found %d CUs; nothing launched\n", cus); grid = -1; return; }
        grid = cus;
    }
    if (grid < 0) return;
    hipMemsetAsync((char*)d_ws + WS_CTL, 0, 1u << 20, stream);
    Args a{};
    for (int i = 0; i < 24; ++i) a.in[i] = (const float*)d_in[i];
    a.out = (float*)d_out; a.ws = (unsigned char*)d_ws;
    int li = 0, lo = 0;
    launch_seg(a, lo, NPH, li, grid, stream);
}
```

```cpp
#include <hip/hip_runtime.h>
#include <cstdio>
#include <cstdint>
#include <cmath>

typedef unsigned short bf16_t;
constexpr int D = 1024, NB = 4, S = 4096, LC = 256, DFF = 2816, NIN = 2560;
constexpr int ML = NB * S, MC = NB * LC, M = ML + MC;
constexpr int NMODW = 9 * D;
constexpr float C2 = 0.125f * 1.4426950408889634f;
constexpr float LOG2E = 1.4426950408889634f;

__device__ __forceinline__ float bf2f(bf16_t v) { return __uint_as_float((unsigned)v << 16); }
__device__ __forceinline__ bf16_t f2bf(float f) { unsigned u = __float_as_uint(f); return (bf16_t)((u + 0x7fffu + ((u >> 16) & 1u)) >> 16); }
__device__ __forceinline__ unsigned cvtpk2(float lo, float hi) { typedef float f2_t __attribute__((ext_vector_type(2))); typedef __bf16 b2_t __attribute__((ext_vector_type(2))); f2_t v = {lo, hi}; b2_t b = __builtin_convertvector(v, b2_t); return __builtin_bit_cast(unsigned, b); }
__device__ __forceinline__ int bidx(int row) { return row < ML ? (row >> 12) : 4; }
__device__ __forceinline__ float silu_f(float x) { return x / (1.f + __expf(-x)); }
__device__ __forceinline__ float gelu_tanh_f(float x) { const float u = 0.7978845608028654f * (x + 0.044715f * x * x * x); return 0.5f * x * (1.f + tanhf(u)); }
__device__ __forceinline__ float sigmoid_f(float x) { return 1.f / (1.f + __expf(-x)); }

constexpr size_t MiB = 1u << 20;
constexpr size_t WS_CTL = 0;
constexpr size_t WS_MOD = 1 * MiB;
constexpr size_t WS_TAB = WS_MOD + 512 * 1024;
constexpr size_t WS_SUMM = 2 * MiB;
constexpr size_t WS_SSQ = 3 * MiB + 256 * 1024;
constexpr size_t WS_GS = 3 * MiB + 512 * 1024;
constexpr size_t WS_SW = 3 * MiB + 768 * 1024;
constexpr size_t WS_W = 5 * MiB;
constexpr size_t W_GU = (size_t)2 * DFF * D, W_DN = (size_t)D * DFF, W_IN = (size_t)NIN * D, W_OUT = (size_t)D * D, W_LRU = 2 * 4 * 2 * 64 * 64;
constexpr size_t W_LAYER = 2 * W_GU + 2 * W_DN + W_IN + W_OUT + W_LRU;
constexpr size_t OFF_GU1 = 0, OFF_DN1 = OFF_GU1 + W_GU, OFF_IN = OFF_DN1 + W_DN, OFF_OUT = OFF_IN + W_IN, OFF_GU2 = OFF_OUT + W_OUT, OFF_DN2 = OFF_GU2 + W_GU, OFF_LRU = OFF_DN2 + W_DN;
constexpr size_t WS_H = WS_W + ((2 * W_LAYER * 2 + MiB - 1) / MiB) * MiB;
constexpr size_t WS_R = WS_H + (((size_t)M * D * 4 + MiB - 1) / MiB) * MiB;
constexpr size_t R_PROJ = 0, R_Y = (size_t)M * NIN * 2, R_BYTES = (size_t)M * NIN * 2 + (size_t)M * D * 2;
constexpr size_t WS_NAIVE = WS_R + ((R_BYTES + MiB - 1) / MiB) * MiB;
constexpr size_t WS_END = WS_NAIVE + (size_t)M * 256 * 4;

enum { T_GU1 = 0, T_DN1, T_NC1, T_IN, T_M1, T_M2, T_OUT, T_NC2, T_GU2, T_DN2, T_NC3 };
struct Tab { float cosv[1024]; float sinv[1024]; float lam[2]; float pad[2]; float lruc[2 * 2 * 256]; };

__device__ __forceinline__ int dest_row(int kind, int n) {
    if (kind == 1) { const int s = n >= DFF ? 1 : 0, j = n - s * DFF; return 256 * (j >> 7) + 128 * s + (j & 127); }
    if (kind == 2) {
        const int pn = n >> 8, w = n & 255;
        if (pn == 2 || (pn >= 4 && pn <= 7)) { const int hh = w >> 6, x = (w >> 5) & 1, i = w & 31; return 256 * pn + 128 * x + 32 * hh + i; }
        if (pn == 3) { if (w < 128) { const int hh = w >> 6, x = (w >> 5) & 1, i = w & 31; return 768 + 128 * x + 32 * hh + i; } const int v = w - 128; return 768 + 128 * (v >> 6) + 64 + (v & 63); }
        return n;
    }
    return n;
}
namespace pg8 {
#define PG8_LAS __attribute__((address_space(3)))
typedef unsigned short bf16_t;
typedef short bf16x8 __attribute__((ext_vector_type(8)));
typedef float f32x4 __attribute__((ext_vector_type(4)));
typedef unsigned u32x4 __attribute__((ext_vector_type(4)));
constexpr int BM = 256, BK = 64, HALF = 128, HTB = HALF * BK * 2  , STAGE_BYTES = 8 * HTB, NXCD = 8, WGM = 4;

__host__ __device__ __forceinline__ int lds_byte(int r, int c) { const int st = (r >> 4) * 2 + (c >> 5), rr = r & 15, cc = c & 31, ob = rr * 64 + cc * 2; return st * 1024 + (ob ^ (((ob >> 9) & 1) << 5)); }
__host__ __device__ __forceinline__ void stage_rc(int b, int& R, int& C) { const int st = b / 1024, sb = b % 1024, swz = sb ^ (((sb >> 9) & 1) << 5); R = (st >> 1) * 16 + swz / 64; C = (st & 1) * 32 + (swz % 64) / 2; }
__host__ __device__ __forceinline__ int perm32(int rho) { const int n = rho >> 4, i = rho & 15; return 8 * (i >> 2) + 4 * n + (i & 3); }

struct Unit { int pm, pn, ko, nt; };
struct Gemm { const bf16_t* A; const bf16_t* Bt; int M, N, K, ld; };

struct StaticOrder {
    static constexpr bool VAR_NT = false;
    int nM, nN, nwg, G, c;
    __host__ __device__ void init(int M, int N, int G_, int c_) { nM = M / BM; nN = N / BM; nwg = nM * nN; G = G_; c = c_; }
    __host__ __device__ bool next(int i, Unit& u) const {
        const long L = (long)i * G + c; if (L >= nwg) return false;
        int wgid = (int)L; { const int q = nwg / NXCD, r = nwg % NXCD, xcd = wgid % NXCD, off = wgid / NXCD; wgid = (xcd < r ? xcd * (q + 1) : r * (q + 1) + (xcd - r) * q) + off; }
        const int nig = WGM * nN, gid = wgid / nig, fm = gid * WGM, gsz = (nM - fm) < WGM ? (nM - fm) : WGM;
        u.pm = fm + ((wgid % nig) % gsz); u.pn = (wgid % nig) / gsz; u.ko = 0; return true;
    }
    __device__ __forceinline__ void a_ready(const Unit&) const {}
    __device__ __forceinline__ void done(const Unit&) const {}
};
struct SliceOrder {
    static constexpr bool VAR_NT = false;
    int ns, KS, G, c;
    __host__ __device__ bool next(int i, Unit& u) const { const int L = i * G + (G - 1 - c); if (L >= 16 * ns) return false; const int tile = L / ns, sl = L % ns; u.pm = 64 + (tile >> 2); u.pn = tile & 3; u.ko = sl * KS; return true; }
    __device__ __forceinline__ void a_ready(const Unit&) const {}
    __device__ __forceinline__ void done(const Unit&) const {}
};

struct DnOrder {
    static constexpr bool VAR_NT = true;
    StaticOrder so; int ns, KS, ntl;
    __host__ __device__ bool next(int i, Unit& u) const {
        const int Ls = so.G - 1 - so.c; const bool hs = Ls < 16 * ns;
        if (hs && i == 0) { const int tile = Ls / ns, sl = Ls % ns; u.pm = 64 + (tile >> 2); u.pn = tile & 3; u.ko = sl * KS; u.nt = KS / BK; return true; }
        if (!so.next(hs ? i - 1 : i, u)) return false;
        u.nt = ntl; return true;
    }
    __device__ __forceinline__ void a_ready(const Unit&) const {}
    __device__ __forceinline__ void done(const Unit&) const {}
};

__device__ __forceinline__ unsigned cvt_pk_bf16(float lo, float hi) { unsigned r; asm volatile("v_cvt_pk_bf16_f32 %0, %1, %2" : "=v"(r) : "v"(lo), "v"(hi)); return r; }
__device__ __forceinline__ float fast_silu(float x) { return x * __builtin_amdgcn_rcpf(1.0f + __builtin_amdgcn_exp2f(-1.4426950408889634f * x)); }
__device__ __forceinline__ float fast_gelu_tanh(float x) {
    const float u = 0.7978845608028654f * (x + 0.044715f * x * x * x);
    return x * __builtin_amdgcn_rcpf(1.0f + __builtin_amdgcn_exp2f(-2.0f * 1.4426950408889634f * u));
}
struct EpiCtx { unsigned long long wsi, outi; const __attribute__((address_space(4))) unsigned long long* kin; int l, ty; };
#define PG8_GAS __attribute__((address_space(1)))
__device__ __forceinline__ unsigned char* ectx_ws(const EpiCtx& c) { return (unsigned char*)(PG8_GAS unsigned char*)c.wsi; }
__device__ __forceinline__ const float* ectx_in(const EpiCtx& c, int i) { return (const float*)(const PG8_GAS float*)(c.kin[i]); }
__device__ __forceinline__ int hw_lane() { unsigned z = 0u; asm volatile("" : "+v"(z)); return (int)__builtin_amdgcn_mbcnt_hi(~0u, __builtin_amdgcn_mbcnt_lo(~0u, z)); }
__device__ __forceinline__ void epi_stage_params(PG8_LAS unsigned char* par, const float* ssq_tile, const float* sw_tile, int wid, int) {
    const int lane = hw_lane();
    if (wid < 4) __builtin_amdgcn_global_load_lds((const unsigned*)(ssq_tile + (size_t)(wid * 64 + lane) * 4), (PG8_LAS unsigned*)(par + wid * 1024), 16, 0, 0);
    else if (wid == 4) __builtin_amdgcn_global_load_lds((const unsigned*)(sw_tile + lane * 4), (PG8_LAS unsigned*)(par + 4096), 16, 0, 0);
}
struct EpiGU {
    static constexpr bool PERM = true, AFTER_DRAIN = false, PARAMS = true, LOOSE = true; static constexpr int NST = 8;
    EpiCtx cx;
    __device__ __forceinline__ void stage(PG8_LAS unsigned char* par, const Unit& u, int wid, int lane) const {
        if (u.pm >= 64) return;
        unsigned char* wsb = ectx_ws(cx);
        epi_stage_params(par, (const float*)(wsb + WS_SSQ) + (size_t)u.pm * BM * 4, (const float*)(wsb + WS_SW) + (size_t)(cx.l * 3 + (cx.ty == T_GU1 ? 0 : 2)) * 4 * 5632 + (size_t)(u.pm >> 4) * 5632 + u.pn * 256, wid, lane);
    }
    __device__ __forceinline__ void operator()(const f32x4 (&acc)[2][2][4][2], const Unit& u, int wr, int wc, int fr_in, int fq_in, const PG8_LAS unsigned char* par) const {
        const int ln_ = hw_lane(); const int fr = ln_ & 15, fq = ln_ >> 4;
        unsigned char* wsb = ectx_ws(cx); bf16_t* HB = (bf16_t*)(wsb + WS_R);
        const int row0 = u.pm * BM + wr * 64 + fr, col0 = u.pn * 128 + wc * 32 + 8 * fq; const bool lat = u.pm < 64;
        float rs[2][4];
        { f32x4 sq[2][4];
#pragma unroll
          for (int ai = 0; ai < 2; ++ai)
#pragma unroll
            for (int m = 0; m < 4; ++m) sq[ai][m] = *(const PG8_LAS f32x4*)(par + (wr * 64 + fr + ai * HALF + m * 16) * 16);
#pragma unroll
          for (int ai = 0; ai < 2; ++ai)
#pragma unroll
            for (int m = 0; m < 4; ++m) rs[ai][m] = lat ? __builtin_amdgcn_rsqf(((sq[ai][m][0] + sq[ai][m][1]) + (sq[ai][m][2] + sq[ai][m][3])) * (1.0f / 1024.0f) + 1e-6f) : 1.0f; }
        f32x4 sv[2][2];
#pragma unroll
        for (int bj = 0; bj < 2; ++bj)
#pragma unroll
            for (int n = 0; n < 2; ++n) { const f32x4 t = *(const PG8_LAS f32x4*)(par + 4096 + (bj * 128 + wc * 32 + 8 * fq + 4 * n) * 4); sv[bj][n] = lat ? t : (f32x4){0.f, 0.f, 0.f, 0.f}; }
        f32x4 svg[2], svu[2];
#pragma unroll
        for (int n = 0; n < 2; ++n) { svg[n] = sv[0][n] * -1.4426950408889634f; svu[n] = sv[1][n] * -0.6931471805599453f; }
#pragma unroll
        for (int ai = 0; ai < 2; ++ai)
#pragma unroll
            for (int m = 0; m < 4; ++m) {
                const int row = row0 + ai * HALF + m * 16; bf16_t* rowp = HB + (size_t)row * 2816 + col0; const float rstd = rs[ai][m];
                const float rg = rstd * -1.4426950408889634f, ru = rstd * -0.6931471805599453f;
                const f32x4 g0 = acc[ai][0][m][0] * rg + svg[0], g1 = acc[ai][0][m][1] * rg + svg[1], u0 = acc[ai][1][m][0] * ru + svu[0], u1 = acc[ai][1][m][1] * ru + svu[1];
#define GU_F(g_, u_) (((g_) * (u_)) * __builtin_amdgcn_rcpf(1.0f + __builtin_amdgcn_exp2f(g_)))
                u32x4 w;
                w.x = cvt_pk_bf16(GU_F(g0[0], u0[0]), GU_F(g0[1], u0[1])); w.y = cvt_pk_bf16(GU_F(g0[2], u0[2]), GU_F(g0[3], u0[3]));
                w.z = cvt_pk_bf16(GU_F(g1[0], u1[0]), GU_F(g1[1], u1[1])); w.w = cvt_pk_bf16(GU_F(g1[2], u1[2]), GU_F(g1[3], u1[3]));
#undef GU_F
                *(u32x4*)rowp = w;
            }
    }
};
struct EpiRes {
    static constexpr bool PERM = false, AFTER_DRAIN = false, PARAMS = false, LOOSE = false;
    EpiCtx cx; PG8_LAS float* part;
    __device__ __forceinline__ void operator()(const f32x4 (&acc)[2][2][4][2], const Unit& u, int wr, int wc, int fr_in, int fq_in, const PG8_LAS unsigned char* par) const {
        const int ln_ = hw_lane(); const int fr = ln_ & 15, fq = ln_ >> 4;
        unsigned char* wsb = ectx_ws(cx); const int l = cx.l, ty = cx.ty;
        const bool hasAN = !(l == 1 && ty == T_DN2);
        const float coef = (ty == T_OUT) ? 1.0f : 0.5f;
        float* ssq = (float*)(wsb + WS_SSQ);
        const int pc0 = wc * 32 + 4 * fq;
        const size_t tb = ((size_t)u.pm * BM) * 1024 + (size_t)u.pn * BM;
        char* hbt = (char*)((bf16_t*)(wsb + WS_H) + tb); char* ant = (char*)((bf16_t*)(PG8_GAS bf16_t*)cx.outi + tb);
        const int r0 = wr * 64 + fr;
        unsigned ro[2][4];
#pragma unroll
        for (int ai = 0; ai < 2; ++ai)
#pragma unroll
            for (int m = 0; m < 4; ++m) ro[ai][m] = (unsigned)((r0 + ai * HALF + m * 16) * 1024 + pc0) * 2u;
        typedef unsigned u32x2w __attribute__((ext_vector_type(2)));
        u32x2w hq[2][4][2][2];
#pragma unroll
        for (int ai = 0; ai < 2; ++ai)
#pragma unroll
            for (int m = 0; m < 4; ++m)
#pragma unroll
                for (int bj = 0; bj < 2; ++bj)
#pragma unroll
                    for (int n = 0; n < 2; ++n) hq[ai][m][bj][n] = *(const u32x2w*)(hbt + (size_t)ro[ai][m] + (bj * HALF + n * 16) * 2);
#pragma unroll
        for (int ai = 0; ai < 2; ++ai)
#pragma unroll
            for (int m = 0; m < 4; ++m) { float sqr = 0.f;
#pragma unroll
                for (int bj = 0; bj < 2; ++bj)
#pragma unroll
                    for (int n = 0; n < 2; ++n) { const int co = bj * HALF + n * 16;
                        const f32x4 gv = *(const PG8_LAS f32x4*)(par + (pc0 + co) * 4) * coef;
                        const u32x2w hw0 = hq[ai][m][bj][n]; const f32x4 hin = (f32x4){__uint_as_float(hw0.x << 16), __uint_as_float(hw0.x & 0xffff0000u), __uint_as_float(hw0.y << 16), __uint_as_float(hw0.y & 0xffff0000u)};
                        const f32x4 v = hin + gv * acc[ai][bj][m][n];
                        { u32x2w hw; hw.x = cvt_pk_bf16(v[0], v[1]); hw.y = cvt_pk_bf16(v[2], v[3]); *(u32x2w*)(hbt + (size_t)ro[ai][m] + co * 2) = hw; }
                        if (hasAN) { const f32x4 gs = *(const PG8_LAS f32x4*)(par + 1024 + (pc0 + co) * 4);
                            sqr += (v[0] * v[0] + v[1] * v[1]) + (v[2] * v[2] + v[3] * v[3]); const f32x4 a = v * gs;
                            u32x2w w; w.x = cvt_pk_bf16(a[0], a[1]); w.y = cvt_pk_bf16(a[2], a[3]);
                            *(u32x2w*)(ant + (size_t)ro[ai][m] + co * 2) = w; } }
                if (hasAN) { float s = sqr;
                    s += __int_as_float(__builtin_amdgcn_ds_bpermute((ln_ ^ 16) << 2, __float_as_int(s))); s += __int_as_float(__builtin_amdgcn_ds_bpermute((ln_ ^ 32) << 2, __float_as_int(s)));
                    if (fq == 0) part[(ai * HALF + wr * 64 + m * 16 + fr) * 4 + wc] = s; }
            }
        if (hasAN) { const int lane = ln_;
            asm volatile("s_waitcnt lgkmcnt(0)" ::: "memory"); __builtin_amdgcn_s_barrier(); asm volatile("" ::: "memory");
            const int tid = (wr * 4 + wc) * 64 + lane;
            if (tid < 256) { const f32x4 p = *(const PG8_LAS f32x4*)(part + tid * 4); ssq[(size_t)(u.pm * BM + tid) * 4 + u.pn] = (p[0] + p[1]) + (p[2] + p[3]); }
        }
    }
};
__device__ __forceinline__ float* slab_ptr(unsigned long long wsi, unsigned long long outi, int s) {
    return s < 7 ? (float*)(PG8_GAS float*)(outi + ((size_t)34 << 20) + ((size_t)s << 22)) : (float*)(PG8_GAS float*)(wsi + WS_R + ((size_t)94 << 20) + ((size_t)(s - 7) << 22)); }
struct EpiResAt {
    static constexpr bool PERM = false, AFTER_DRAIN = false, PARAMS = false, LOOSE = false;
    EpiCtx cx;
    __device__ __forceinline__ void operator()(const f32x4 (&acc)[2][2][4][2], const Unit& u, int wr, int wc, int fr_in, int fq_in, const PG8_LAS unsigned char* par) const {
        const int ln_ = hw_lane(); const int fr = ln_ & 15, fq = ln_ >> 4;
        const int ty = cx.ty;
        const float coef = (ty == T_OUT) ? 1.0f : 0.5f;
        float* dst = (float*)((bf16_t*)slab_ptr(cx.wsi, cx.outi, u.ko >> 8) + (size_t)(u.pm - 64) * BM * 1024); const int col0 = u.pn * BM + wc * 32 + 4 * fq, r0 = wr * 64 + fr;
        f32x4 gv[2][2];
#pragma unroll
        for (int bj = 0; bj < 2; ++bj)
#pragma unroll
            for (int n = 0; n < 2; ++n) gv[bj][n] = *(const PG8_LAS f32x4*)(par + (wc * 32 + 4 * fq + bj * HALF + n * 16) * 4) * coef;
#pragma unroll
        for (int ai = 0; ai < 2; ++ai)
#pragma unroll
            for (int m = 0; m < 4; ++m) { bf16_t* rp = (bf16_t*)dst + (size_t)(r0 + ai * HALF + m * 16) * 1024 + col0;
#pragma unroll
                for (int bj = 0; bj < 2; ++bj)
#pragma unroll
                    for (int n = 0; n < 2; ++n) { const f32x4 t = gv[bj][n] * acc[ai][bj][m][n]; typedef unsigned u32x2s __attribute__((ext_vector_type(2)));
                        u32x2s w; w.x = cvt_pk_bf16(t[0], t[1]); w.y = cvt_pk_bf16(t[2], t[3]); *(u32x2s*)(rp + bj * HALF + n * 16) = w; } }
    }
};
struct EpiDn {
    static constexpr bool PERM = false, AFTER_DRAIN = false, PARAMS = true, LOOSE = true; static constexpr int NST = 32;
    EpiRes r; EpiResAt a;
    __device__ __forceinline__ void stage(PG8_LAS unsigned char* par, const Unit& u, int wid, int) const {
        if (wid >= 2) return;
        const int l = r.cx.l, ty = r.cx.ty; unsigned char* wsb = ectx_ws(r.cx); const int lane = hw_lane(); const bool ctxu = u.pm >= 64; const int b = ctxu ? 4 : (u.pm >> 4);
        if (wid == 0) { const int gk = (ty == T_DN1) ? 2 : (ty == T_OUT) ? 5 : 8;
            __builtin_amdgcn_global_load_lds((const unsigned*)((const float*)(wsb + WS_MOD) + (size_t)l * 5 * 9216 + (size_t)b * 9216 + gk * 1024 + u.pn * BM + lane * 4), (PG8_LAS unsigned*)par, 16, 0, 0); }
        else if (!ctxu && !(l == 1 && ty == T_DN2)) {
            const float* gsn = (const float*)(wsb + WS_GS) + (size_t)((ty == T_DN2 ? l + 1 : l) * 3 + (ty == T_DN1 ? 1 : ty == T_OUT ? 2 : 0)) * 5 * 1024;
            __builtin_amdgcn_global_load_lds((const unsigned*)(gsn + (size_t)b * 1024 + u.pn * BM + lane * 4), (PG8_LAS unsigned*)(par + 1024), 16, 0, 0); }
    }
    __device__ __forceinline__ void operator()(const f32x4 (&acc)[2][2][4][2], const Unit& u, int wr, int wc, int fr_in, int fq_in, const PG8_LAS unsigned char* par) const { if (u.pm >= 64) a(acc, u, wr, wc, fr_in, fq_in, par); else r(acc, u, wr, wc, fr_in, fq_in, par); }
};
struct EpiIN {
    static constexpr bool PERM = true, AFTER_DRAIN = false, PARAMS = true, LOOSE = true; static constexpr int NST = 16;
    EpiCtx cx; const PG8_LAS float* ropet;
    __device__ __forceinline__ void stage(PG8_LAS unsigned char* par, const Unit& u, int wid, int lane) const {
        if (u.pm >= 64) return;
        unsigned char* wsb = ectx_ws(cx);
        epi_stage_params(par, (const float*)(wsb + WS_SSQ) + (size_t)u.pm * BM * 4, (const float*)(wsb + WS_SW) + (size_t)(cx.l * 3 + 1) * 4 * 5632 + (size_t)(u.pm >> 4) * 5632 + u.pn * 256, wid, lane);
    }
    __device__ __forceinline__ void operator()(const f32x4 (&acc)[2][2][4][2], const Unit& u, int wr, int wc, int fr_in, int fq_in, const PG8_LAS unsigned char* par) const {
        const int ln_ = hw_lane(); const int fr = ln_ & 15, fq = ln_ >> 4;
        unsigned char* wsb = ectx_ws(cx); bf16_t* PROJ = (bf16_t*)(wsb + WS_R + R_PROJ); const PG8_LAS float* cosv = ropet; const PG8_LAS float* sinv = ropet + 1024;
        const int pn = u.pn; const int row0 = u.pm * BM + wr * 64 + fr; const int j0 = wc * 32 + 8 * fq;
        const bool rope_tile = (pn == 2) || (pn >= 4 && pn <= 7) || (pn == 3 && wc < 2);
        const float C2q = 0.125f * 1.4426950408889634f;
        const bool lat = u.pm < 64;
        f32x4 sv[2][2];
#pragma unroll
        for (int bj = 0; bj < 2; ++bj)
#pragma unroll
            for (int n = 0; n < 2; ++n) { const f32x4 t = *(const PG8_LAS f32x4*)(par + 4096 + (bj * 128 + j0 + 4 * n) * 4); sv[bj][n] = lat ? t : (f32x4){0.f, 0.f, 0.f, 0.f}; }
        float rs[2][4];
        { f32x4 sq[2][4];
#pragma unroll
          for (int ai = 0; ai < 2; ++ai)
#pragma unroll
            for (int m = 0; m < 4; ++m) sq[ai][m] = *(const PG8_LAS f32x4*)(par + (wr * 64 + fr + ai * HALF + m * 16) * 16);
#pragma unroll
          for (int ai = 0; ai < 2; ++ai)
#pragma unroll
            for (int m = 0; m < 4; ++m) rs[ai][m] = lat ? __builtin_amdgcn_rsqf(((sq[ai][m][0] + sq[ai][m][1]) + (sq[ai][m][2] + sq[ai][m][3])) * (1.0f / 1024.0f) + 1e-6f) : 1.0f; }
#define EPIIN_SV
#define EPIIN_RSTD(row_) const float rstd = rs[ai][m];
        if (!rope_tile) {
            int cbase[2];
            if (pn == 3) { cbase[0] = 896 + (j0 - 64); cbase[1] = 896 + 64 + (j0 - 64); } else { cbase[0] = 256 * pn + j0; cbase[1] = 256 * pn + 128 + j0; }
#pragma unroll
            for (int ai = 0; ai < 2; ++ai)
#pragma unroll
                for (int m = 0; m < 4; ++m) { bf16_t* rowp = PROJ + (size_t)(row0 + ai * HALF + m * 16) * 2560; EPIIN_RSTD(row0 + ai * HALF + m * 16) EPIIN_SV
#pragma unroll
                    for (int bj = 0; bj < 2; ++bj) { f32x4 v0 = acc[ai][bj][m][0] * rstd + sv[bj][0], v1 = acc[ai][bj][m][1] * rstd + sv[bj][1];
                        if (pn == 1) {
#pragma unroll
                            for (int e = 0; e < 4; ++e) { v0[e] = fast_gelu_tanh(v0[e]); v1[e] = fast_gelu_tanh(v1[e]); } }
                        u32x4 w; w.x = cvt_pk_bf16(v0[0], v0[1]); w.y = cvt_pk_bf16(v0[2], v0[3]); w.z = cvt_pk_bf16(v1[0], v1[1]); w.w = cvt_pk_bf16(v1[2], v1[3]);
                        *(u32x4*)(rowp + cbase[bj]) = w; } }
        } else {
            const bool latent = lat; const float qs = (pn == 2 || pn == 4 || pn == 5) ? C2q : 1.0f;
            const int c1 = (pn == 3 ? 768 : 256 * pn) + 64 * wc + 8 * fq;
            const int fo = 8 * (fq & 1);
#pragma unroll
            for (int ai = 0; ai < 2; ++ai) {
                const int posr = (4 * u.pm + 2 * ai + wr) & 63;
#pragma unroll
                for (int m = 0; m < 4; ++m) { bf16_t* rowp = PROJ + (size_t)(row0 + ai * HALF + m * 16) * 2560 + c1;
                    const int pos = (fq < 2) ? posr : (16 * m + fr); EPIIN_RSTD(row0 + ai * HALF + m * 16) EPIIN_SV
                    f32x4 x1a = acc[ai][0][m][0] * rstd + sv[0][0], x1b = acc[ai][0][m][1] * rstd + sv[0][1], x2a = acc[ai][1][m][0] * rstd + sv[1][0], x2b = acc[ai][1][m][1] * rstd + sv[1][1];
                    if (latent) {
                        const f32x4 ca = *(const PG8_LAS f32x4*)(cosv + pos * 16 + fo), cb = *(const PG8_LAS f32x4*)(cosv + pos * 16 + fo + 4), sa = *(const PG8_LAS f32x4*)(sinv + pos * 16 + fo), sb = *(const PG8_LAS f32x4*)(sinv + pos * 16 + fo + 4);
                        const f32x4 o1a = x1a * ca - x2a * sa, o1b = x1b * cb - x2b * sb, o2a = x1a * sa + x2a * ca, o2b = x1b * sb + x2b * cb;
                        x1a = o1a; x1b = o1b; x2a = o2a; x2b = o2b;
                    }
                    x1a = x1a * qs; x1b = x1b * qs; x2a = x2a * qs; x2b = x2b * qs;
                    u32x4 w1, w2; w1.x = cvt_pk_bf16(x1a[0], x1a[1]); w1.y = cvt_pk_bf16(x1a[2], x1a[3]); w1.z = cvt_pk_bf16(x1b[0], x1b[1]); w1.w = cvt_pk_bf16(x1b[2], x1b[3]);
                    w2.x = cvt_pk_bf16(x2a[0], x2a[1]); w2.y = cvt_pk_bf16(x2a[2], x2a[3]); w2.z = cvt_pk_bf16(x2b[0], x2b[1]); w2.w = cvt_pk_bf16(x2b[2], x2b[3]);
                    *(u32x4*)rowp = w1; *(u32x4*)(rowp + 32) = w2; }
            }
        }
    }
};
#undef EPIIN_RSTD
#undef EPIIN_SV

template <class Epi, class Sched, bool ALIGN_EPI = false, bool SP2 = false>
__device__ __forceinline__ void gemm_phase(PG8_LAS unsigned char* lds, const Gemm g, const Sched& S, const Epi& E, const int tid_in) {
    const int tid = tid_in, wid = __builtin_amdgcn_readfirstlane(tid >> 6), lane = tid & 63, wr = wid >> 2, wc = wid & 3, fr = lane & 15, fq = lane >> 4;
    const int K = g.K, LD = g.ld; int nt = K / BK;
    unsigned voffA[2], voffB[2];
#pragma unroll
    for (int i = 0; i < 2; ++i) { int R, C; stage_rc(tid * 16 + i * 8192, R, C); const int Rb = Epi::PERM ? ((R & ~31) + perm32(R & 31)) : R;
        voffA[i] = (unsigned)(R * LD + C) * 2u; voffB[i] = (unsigned)(Rb * LD + C) * 2u; }
    const size_t kstep = (size_t)(BK * 2);
    const size_t hstep = (size_t)HALF * LD * 2;
    const size_t tstep = 2 * hstep;
    const unsigned ldsw = (unsigned)wid * 1024u;
    const int aoff = lds_byte(wr * 64 + fr, fq * 8), boff = lds_byte(wc * 32 + fr, fq * 8);
#define PG8_SA(b, h) (((b) * 2 + (h)) * HTB)
#define PG8_SB(b, h) ((4 + (b) * 2 + (h)) * HTB)
#define PG8_STAGE(bufoff, gbase, voff) do { _Pragma("unroll") for (int _i = 0; _i < 2; ++_i) { unsigned vo_ = (voff)[_i]; asm volatile("" : "+v"(vo_));   \
        __builtin_amdgcn_global_load_lds((const unsigned*)((const char*)(gbase) + vo_), (PG8_LAS unsigned*)(lds + (bufoff) + ldsw + _i * 8192), 16, 0, 0); } } while (0)
#define PG8_LDA(dst, b, h) do { _Pragma("unroll") for (int m = 0; m < 4; ++m) _Pragma("unroll") for (int k = 0; k < 2; ++k) dst[m][k] = *(const PG8_LAS bf16x8*)(lds + PG8_SA(b, h) + aoff + m * 2048 + k * 1024); } while (0)
#define PG8_LDB(dst, b, h) do { _Pragma("unroll") for (int n = 0; n < 2; ++n) _Pragma("unroll") for (int k = 0; k < 2; ++k) dst[n][k] = *(const PG8_LAS bf16x8*)(lds + PG8_SB(b, h) + boff + n * 2048 + k * 1024); } while (0)
#define PG8_MMA(ai, bj, At, Bt) do { __builtin_amdgcn_s_setprio(1); _Pragma("unroll") for (int m = 0; m < 4; ++m) _Pragma("unroll") for (int n = 0; n < 2; ++n) _Pragma("unroll") for (int k = 0; k < 2; ++k) \
        acc[ai][bj][m][n] = __builtin_amdgcn_mfma_f32_16x16x32_bf16(Bt[n][k], At[m][k], acc[ai][bj][m][n], 0, 0, 0); __builtin_amdgcn_s_setprio(0); } while (0)
#define PG8_WAIT_V(n) asm volatile("s_waitcnt vmcnt(" #n ")" ::: "memory")
#define PG8_WAIT_L(n) asm volatile("s_waitcnt lgkmcnt(" #n ")" ::: "memory")
#define PG8_WAIT_VN(n) asm volatile("s_waitcnt vmcnt(%0)" :: "n"(n) : "memory")
#define PG8_BAR __builtin_amdgcn_s_barrier()
#define PG8_SCHED __builtin_amdgcn_sched_barrier(0)
    Unit cur, nxt; int ui = 0;
    if (!S.next(0, cur)) return;
    f32x4 acc[2][2][4][2];
#pragma unroll
    for (int a = 0; a < 2; ++a)
#pragma unroll
        for (int b = 0; b < 2; ++b)
#pragma unroll
            for (int m = 0; m < 4; ++m)
#pragma unroll
                for (int n = 0; n < 2; ++n) acc[a][b][m][n] = (f32x4){0.f, 0.f, 0.f, 0.f};
    bf16x8 At[4][2], B0[2][2], B1[2][2];
    const char* cA = (const char*)g.A + (size_t)cur.pm * tstep + (size_t)cur.ko * 2; const char* cB = (const char*)g.Bt + (size_t)cur.pn * tstep + (size_t)cur.ko * 2;
    if constexpr (Sched::VAR_NT) nt = cur.nt;
    S.a_ready(cur);
    if constexpr (SP2) {
        PG8_STAGE(PG8_SB(0, 0), cB, voffB); PG8_STAGE(PG8_SB(0, 1), cB + hstep, voffB); PG8_STAGE(PG8_SA(0, 0), cA, voffA); PG8_STAGE(PG8_SA(0, 1), cA + hstep, voffA);
        if (wr == 1) PG8_BAR;
        PG8_WAIT_V(2); PG8_BAR;
        PG8_STAGE(PG8_SB(1, 0), cB + kstep, voffB); PG8_STAGE(PG8_SA(1, 0), cA + kstep, voffA); PG8_STAGE(PG8_SB(1, 1), cB + hstep + kstep, voffB);
        PG8_WAIT_V(6); PG8_BAR;
    } else {
        PG8_STAGE(PG8_SB(0, 0), cB, voffB); PG8_STAGE(PG8_SA(0, 0), cA, voffA); PG8_STAGE(PG8_SB(0, 1), cB + hstep, voffB); PG8_STAGE(PG8_SA(0, 1), cA + hstep, voffA);
        if (wr == 1) PG8_BAR;
        PG8_WAIT_V(4); PG8_BAR;
        PG8_STAGE(PG8_SB(1, 0), cB + kstep, voffB); PG8_STAGE(PG8_SA(1, 0), cA + kstep, voffA); PG8_STAGE(PG8_SB(1, 1), cB + hstep + kstep, voffB);
        PG8_WAIT_V(6); PG8_BAR;
    }
    if constexpr (Epi::PARAMS) E.stage(lds + STAGE_BYTES, cur, wid, lane);
    for (;;) {
        const bool has_next = S.next(ui + 1, nxt);
        const char* nA = has_next ? (const char*)g.A + (size_t)nxt.pm * tstep + (size_t)nxt.ko * 2 : cA; const char* nB = has_next ? (const char*)g.Bt + (size_t)nxt.pn * tstep + (size_t)nxt.ko * 2 : cB;
        int t0 = 0;
        if constexpr (Epi::LOOSE) { if (ui > 0) {
            const char* a2 = cA + 2 * kstep; const char* b2 = cB + 2 * kstep; asm volatile("" : "+s"(a2), "+s"(b2));
            const char* a3 = a2 + kstep; const char* b3 = b2 + kstep; asm volatile("" : "+s"(a3), "+s"(b3));
            PG8_LDB(B0, 0, 0); PG8_LDB(B1, 0, 1); PG8_SCHED; PG8_LDA(At, 0, 0);
            PG8_WAIT_VN(8 + Epi::NST); PG8_WAIT_L(0); PG8_BAR; PG8_MMA(0, 0, At, B0); PG8_MMA(0, 1, At, B1); PG8_BAR; PG8_SCHED;
            PG8_LDA(At, 0, 1); PG8_STAGE(PG8_SB(0, 0), b2, voffB); PG8_STAGE(PG8_SB(0, 1), b2 + hstep, voffB); PG8_STAGE(PG8_SA(0, 0), a2, voffA);
            PG8_WAIT_VN(8 + Epi::NST); PG8_WAIT_L(0); PG8_BAR; PG8_MMA(1, 0, At, B0); PG8_MMA(1, 1, At, B1); PG8_BAR; PG8_SCHED;
            PG8_LDB(B0, 1, 0); PG8_LDB(B1, 1, 1); PG8_SCHED; PG8_LDA(At, 1, 0); PG8_STAGE(PG8_SA(0, 1), a2 + hstep, voffA);
            PG8_WAIT_VN(8 + Epi::NST); PG8_WAIT_L(0); PG8_BAR; PG8_MMA(0, 0, At, B0); PG8_MMA(0, 1, At, B1); PG8_BAR; PG8_SCHED;
            PG8_LDA(At, 1, 1); PG8_STAGE(PG8_SB(1, 0), b3, voffB); PG8_STAGE(PG8_SB(1, 1), b3 + hstep, voffB); PG8_STAGE(PG8_SA(1, 0), a3, voffA);
            PG8_WAIT_V(8); PG8_WAIT_L(0); PG8_BAR; PG8_MMA(1, 0, At, B0); PG8_MMA(1, 1, At, B1); PG8_BAR; PG8_SCHED;
            t0 = 2; } }
        for (int t = t0; t < nt; t += 2) {
            const bool last = (t == nt - 2);
            const char* a1 = cA + (size_t)(t + 1) * kstep;
            const char* a2 = last ? nA : cA + (size_t)(t + 2) * kstep; const char* b2 = last ? nB : cB + (size_t)(t + 2) * kstep;
            const char* a3 = a2 + kstep; const char* b3 = b2 + kstep;
            if (last && has_next) S.a_ready(nxt);
            if constexpr (SP2) {
            PG8_LDB(B0, 0, 0); PG8_LDB(B1, 0, 1); PG8_SCHED; PG8_LDA(At, 0, 0); PG8_STAGE(PG8_SA(1, 1), a1 + hstep, voffA);
            PG8_WAIT_V(8); PG8_WAIT_L(0); PG8_BAR; PG8_MMA(0, 0, At, B0); PG8_MMA(0, 1, At, B1); PG8_BAR; PG8_SCHED;
            PG8_LDA(At, 0, 1); PG8_STAGE(PG8_SB(0, 0), b2, voffB); PG8_STAGE(PG8_SB(0, 1), b2 + hstep, voffB); PG8_STAGE(PG8_SA(0, 0), a2, voffA);
            PG8_WAIT_V(8); PG8_WAIT_L(0); PG8_BAR; PG8_MMA(1, 0, At, B0); PG8_MMA(1, 1, At, B1); PG8_BAR; PG8_SCHED;
            PG8_LDB(B0, 1, 0); PG8_LDB(B1, 1, 1); PG8_SCHED; PG8_LDA(At, 1, 0); PG8_STAGE(PG8_SA(0, 1), a2 + hstep, voffA);
            PG8_WAIT_V(8); PG8_WAIT_L(0); PG8_BAR; PG8_MMA(0, 0, At, B0); PG8_MMA(0, 1, At, B1); PG8_BAR; PG8_SCHED;
            PG8_LDA(At, 1, 1); PG8_STAGE(PG8_SB(1, 0), b3, voffB); PG8_STAGE(PG8_SB(1, 1), b3 + hstep, voffB); PG8_STAGE(PG8_SA(1, 0), a3, voffA);
            PG8_WAIT_V(8); PG8_WAIT_L(0); PG8_BAR; PG8_MMA(1, 0, At, B0); PG8_MMA(1, 1, At, B1); PG8_BAR; PG8_SCHED;
            } else {
            PG8_LDB(B0, 0, 0); PG8_SCHED; PG8_LDA(At, 0, 0); PG8_STAGE(PG8_SA(1, 1), a1 + hstep, voffA);
            PG8_WAIT_L(8); PG8_BAR; PG8_WAIT_L(0); PG8_MMA(0, 0, At, B0); PG8_BAR; PG8_SCHED;
            PG8_LDB(B1, 0, 1); PG8_STAGE(PG8_SB(0, 0), b2, voffB);
            PG8_BAR; PG8_WAIT_L(0); PG8_MMA(0, 1, At, B1); PG8_BAR;
            PG8_LDA(At, 0, 1); PG8_STAGE(PG8_SA(0, 0), a2, voffA);
            PG8_BAR; PG8_WAIT_L(0); PG8_MMA(1, 0, At, B0); PG8_BAR; PG8_SCHED;
            PG8_STAGE(PG8_SB(0, 1), b2 + hstep, voffB);
            PG8_WAIT_V(6); PG8_BAR; PG8_MMA(1, 1, At, B1); PG8_BAR;
            PG8_LDB(B0, 1, 0); PG8_SCHED; PG8_LDA(At, 1, 0); PG8_STAGE(PG8_SA(0, 1), a2 + hstep, voffA);
            PG8_WAIT_L(8); PG8_BAR; PG8_WAIT_L(0); PG8_MMA(0, 0, At, B0); PG8_BAR; PG8_SCHED;
            PG8_LDB(B1, 1, 1); PG8_STAGE(PG8_SB(1, 0), b3, voffB);
            PG8_BAR; PG8_WAIT_L(0); PG8_MMA(0, 1, At, B1); PG8_BAR;
            PG8_LDA(At, 1, 1); PG8_STAGE(PG8_SA(1, 0), a3, voffA);
            PG8_BAR; PG8_WAIT_L(0); PG8_MMA(1, 0, At, B0); PG8_BAR; PG8_SCHED;
            PG8_STAGE(PG8_SB(1, 1), b3 + hstep, voffB);
            PG8_WAIT_V(6); PG8_BAR; PG8_MMA(1, 1, At, B1); PG8_BAR;
            }
        }
        if constexpr (Epi::PARAMS || Epi::LOOSE) { if (has_next) { if constexpr (Epi::LOOSE) { const char* xa = nA + kstep + hstep; asm volatile("" : "+s"(xa)); PG8_STAGE(PG8_SA(1, 1), xa, voffA); } if constexpr (Epi::PARAMS) E.stage(lds + STAGE_BYTES + ((ui + 1) & 1) * 5120, nxt, wid, lane); } }
        if constexpr (ALIGN_EPI) { if (wr == 0) PG8_BAR; }
        if constexpr (!Epi::AFTER_DRAIN) { if constexpr (Epi::PARAMS) E(acc, cur, wr, wc, fr, fq, lds + STAGE_BYTES + (ui & 1) * 5120); else E(acc, cur, wr, wc, fr, fq); S.done(cur); }
        if (!has_next) break;
#pragma unroll
        for (int a = 0; a < 2; ++a)
#pragma unroll
            for (int b = 0; b < 2; ++b)
#pragma unroll
                for (int m = 0; m < 4; ++m)
#pragma unroll
                    for (int n = 0; n < 2; ++n) acc[a][b][m][n] = (f32x4){0.f, 0.f, 0.f, 0.f};
        cur = nxt; cA = nA; cB = nB; ++ui; if constexpr (Sched::VAR_NT) nt = cur.nt;
        if constexpr (ALIGN_EPI) { if (wr == 1) PG8_BAR; }
    }
    PG8_WAIT_V(0);
    if constexpr (!ALIGN_EPI) { if (wr == 0) PG8_BAR; }
    PG8_BAR;
    if constexpr (Epi::AFTER_DRAIN) { E.fused(acc, cur, wr, wc, fr, fq, lds, wid, lane); S.done(cur); }
#undef PG8_SA
#undef PG8_SB
#undef PG8_STAGE
#undef PG8_LDA
#undef PG8_LDB
#undef PG8_MMA
#undef PG8_WAIT_V
#undef PG8_WAIT_L
#undef PG8_WAIT_VN
#undef PG8_BAR
#undef PG8_SCHED
}
}

#define GAS __attribute__((address_space(1)))
#define LAS __attribute__((address_space(3)))
typedef unsigned short bf16;
typedef unsigned v4u __attribute__((ext_vector_type(4)));
typedef float f32x4 __attribute__((ext_vector_type(4)));
typedef short bf16x8 __attribute__((ext_vector_type(8)));
typedef GAS unsigned gu32;
typedef GAS unsigned long long gu64;
#define RLX_AGENT __ATOMIC_RELAXED, __HIP_MEMORY_SCOPE_AGENT
#define LDS_WAIT() asm volatile("s_waitcnt lgkmcnt(0)" ::: "memory")
#define VM_WAIT() asm volatile("s_waitcnt vmcnt(0)" ::: "memory")
__device__ __forceinline__ unsigned long long rt() { return __builtin_amdgcn_s_memrealtime(); }
#define XB_TMO      128
#define XB_XCNT(j)  (256  + 64 * (j))
#define XB_XSUB(j)  (1280 + 64 * (j))
#define XB_XGEN(j)  (2304 + 64 * (j))
#define XB_TOP      3328
#define XB_TOPGEN   3392
#define XCD_BAR_WORDS 3456
#define XB_SPIN_CAP (1u << 18)

__device__ __forceinline__ unsigned xb_ld(unsigned* p)              { return __hip_atomic_load(p, __ATOMIC_RELAXED, __HIP_MEMORY_SCOPE_AGENT); }
__device__ __forceinline__ unsigned xb_add(unsigned* p, unsigned v) { return __hip_atomic_fetch_add(p, v, __ATOMIC_RELAXED, __HIP_MEMORY_SCOPE_AGENT); }
__device__ __forceinline__ unsigned xb_xcc_id() { return (unsigned)__builtin_amdgcn_s_getreg((3 << 11) | 20) & 0xFu; }
#define XB_SPIN(cond, bar) do { unsigned _sp = 0; while (cond) { __builtin_amdgcn_s_sleep(1); \
    if ((++_sp & 255u) == 0u) { if (xb_ld(&(bar)[XB_TMO])) break; if (_sp > XB_SPIN_CAP) { atomicAdd(&(bar)[XB_TMO], 1u); break; } } } } while (0)

struct XcdBarrier {
    unsigned* bar; unsigned x; int w0;
    volatile LAS unsigned* st;
};

__device__ __forceinline__ XcdBarrier xcd_barrier_post(unsigned* bar, volatile LAS unsigned* st) {
    XcdBarrier b; b.bar = bar; b.x = xb_xcc_id(); b.st = st; b.w0 = __builtin_amdgcn_readfirstlane(threadIdx.x >> 6);
    if (threadIdx.x == 0) (void)xb_add(&bar[XB_XCNT(b.x)], 1u);
    return b;
}
__device__ __forceinline__ void xcd_barrier_complete(unsigned* bar, unsigned x, unsigned& nloc, unsigned& nx) {
    const unsigned G = gridDim.x * gridDim.y * gridDim.z;
    unsigned sum, cnt, mine, sp = 0u;
    for (;;) {
        sum = 0u; cnt = 0u; mine = 0u;
#pragma unroll
        for (unsigned j = 0; j < 16; ++j) { const unsigned c = xb_ld(&bar[XB_XCNT(j)]); sum += c; cnt += (c > 0u) ? 1u : 0u; mine = (j == x) ? c : mine; }
        if (sum == G) break;
        __builtin_amdgcn_s_sleep(1);
        if ((++sp & 255u) == 0u) { if (xb_ld(&bar[XB_TMO])) break; if (sp > XB_SPIN_CAP) { atomicAdd(&bar[XB_TMO], 1u); break; } }
    }
    nloc = mine > 0u ? mine : 1u; nx = cnt > 0u ? cnt : 1u;
}

__device__ __forceinline__ void xcd_barrier(const XcdBarrier& b) {
    asm volatile("s_waitcnt vmcnt(0)" ::: "memory");
    __syncthreads();
    if (b.w0 == 0 && __builtin_amdgcn_mbcnt_hi(~0u, __builtin_amdgcn_mbcnt_lo(~0u, 0u)) == 0u) {
        unsigned* bar = b.bar;
        __builtin_amdgcn_s_waitcnt(0);
        unsigned nloc = b.st[0], nx = b.st[1];
        if (nloc == 0u) { xcd_barrier_complete(bar, b.x, nloc, nx); b.st[0] = nloc; b.st[1] = nx; }
        const unsigned old = xb_add(&bar[XB_XSUB(b.x)], 1u);
        const unsigned gen = old / nloc;
        if (old + 1u == (gen + 1u) * nloc) {
            __builtin_amdgcn_fence(__ATOMIC_RELEASE, "agent");
            asm volatile("s_waitcnt vmcnt(0)" ::: "memory");
            const unsigned og = xb_add(&bar[XB_TOP], 1u);
            const unsigned tg = og / nx;
            if (og + 1u == (tg + 1u) * nx) xb_add(&bar[XB_TOPGEN], 1u);
            else XB_SPIN(xb_ld(&bar[XB_TOPGEN]) == tg, bar);
            __builtin_amdgcn_fence(__ATOMIC_ACQUIRE, "agent");
            xb_add(&bar[XB_XGEN(b.x)], 1u);
            asm volatile("s_waitcnt vmcnt(0)" ::: "memory");
        } else {
            XB_SPIN(xb_ld(&bar[XB_XGEN(b.x)]) == gen, bar);
            __builtin_amdgcn_fence(__ATOMIC_ACQUIRE, "agent");
            asm volatile("s_waitcnt vmcnt(0)" ::: "memory");
        }
    }
    __syncthreads();
}


namespace att {
typedef float f32x16 __attribute__((ext_vector_type(16)));
typedef short s16x4 __attribute__((ext_vector_type(4)));
typedef short v4i16_t __attribute__((ext_vector_type(4)));
typedef short bf16x8 __attribute__((ext_vector_type(8)));
typedef unsigned u32x4 __attribute__((ext_vector_type(4)));
#define ATT_LAS __attribute__((address_space(3)))
__device__ __forceinline__ int crow(int r, int hi) { return (r & 3) + 8 * (r >> 2) + 4 * hi; }
__device__ __forceinline__ unsigned cvtpk(float lo, float hi) { typedef float f2 __attribute__((ext_vector_type(2))); typedef __bf16 b2 __attribute__((ext_vector_type(2))); f2 v = {lo, hi}; b2 b = __builtin_convertvector(v, b2); return __builtin_bit_cast(unsigned, b); }
__device__ __forceinline__ float swapmax(float m) { auto rr = __builtin_amdgcn_permlane32_swap(__float_as_uint(m), __float_as_uint(m), false, false); return fmaxf(__uint_as_float(rr[0]), __uint_as_float(rr[1])); }
__device__ __forceinline__ float swapsum(float m) { auto rr = __builtin_amdgcn_permlane32_swap(__float_as_uint(m), __float_as_uint(m), false, false); return __uint_as_float(rr[0]) + __uint_as_float(rr[1]); }
__device__ __forceinline__ float sx(float v, int mask, int lane) { return __int_as_float(__builtin_amdgcn_ds_bpermute((lane ^ mask) << 2, __float_as_int(v))); }
constexpr float THR = 8.0f;
constexpr int NOMASK = -1000000;

struct TileSeq {
    int b, nt, mode  , q0, jlo;
    __device__ __forceinline__ int row(int t, int& kabs0) const {
        if (t < 4) { kabs0 = NOMASK; return 16384 + b * 256 + 64 * t; }
        if (mode == 0) { kabs0 = NOMASK; return b * 4096 + 64 * (t - 4); }
        const int j = jlo + t - 4; kabs0 = q0 - 128 + 64 * j; return b * 4096 + kabs0;
    }
};

__device__ __forceinline__ void dma16(const void* g, ATT_LAS unsigned char* l) {
    asm volatile("s_mov_b32 m0, %1\n\ts_nop 0\n\tglobal_load_lds_dwordx4 %0, off" :: "v"(g), "s"((unsigned)(unsigned long)l) : "memory", "m0");
}
template <int NS, int ND> __device__ __forceinline__ void issue_tile(ATT_LAS unsigned char* stage, const unsigned short* PROJ, int krow0, int kcol, int vcol, int wave, int lane) {
#pragma unroll
    for (int i = 0; i < NS; ++i) { const int p = wave + 8 * i, s = p >> 3, c = p & 7;
        const unsigned short* src = PROJ + (size_t)(krow0 + lane) * 2560 + kcol + 64 * s + 8 * c;
        dma16(src, stage + s * 8192 + c * 1024); }
#pragma unroll
    for (int i = 0; i < ND / 2; ++i) { const int p = wave + 8 * i, dblk = p >> 2, rg = p & 3;
        const unsigned short* src = PROJ + (size_t)(krow0 + 16 * rg + (lane >> 2)) * 2560 + vcol + 32 * dblk + 8 * (lane & 3);
        dma16(src, stage + NS * 8192 + (dblk * 4 + rg) * 1024); }
}
__device__ __forceinline__ s16x4 vtr(const ATT_LAS unsigned char* p) { return __builtin_bit_cast(s16x4, __builtin_amdgcn_ds_read_tr16_b64_v4i16((ATT_LAS v4i16_t*)p)); }

#define AT_ROWS_OUT(Ts_, ND_, Y_, qrow_, ycol_, lane_) do { asm volatile("s_waitcnt lgkmcnt(0)" ::: "memory"); \
        _Pragma("unroll") for (int j_ = 0; j_ < 2 * (ND_); ++j_) { const int idx_ = (lane_) + 64 * j_, row_ = idx_ / (4 * (ND_)), ch_ = idx_ % (4 * (ND_)); \
            const u32x4 v_ = *(const ATT_LAS u32x4*)((Ts_) + row_ * (64 * (ND_)) + ch_ * 16); \
            *(u32x4*)((Y_) + (size_t)((qrow_) + row_) * 1024 + (ycol_) + 8 * ch_) = v_; } } while (0)
#define AT_MX3(a, b, c) __builtin_fmaxf(__builtin_fmaxf((a), (b)), (c))
template <int NS, int ND> __device__ __forceinline__ void pv_step(f32x16 (&o)[NS][ND], const u32x4 (&pf)[NS][4], const ATT_LAS unsigned char* Vs);
template <int NS, int ND, int NSTG, bool QLDS>
__device__ __forceinline__ void attn_unit(ATT_LAS unsigned char* lds, const unsigned short* PROJ, unsigned short* Y, const TileSeq ts, int qrow, int qcol, int kcol, int vcol, int ycol,
                                          int qabs, float sinkl2, float lam, const float* subg, float oml, int tid) {
    constexpr int STAGE = NS * 8192 + ND * 4096, NDMA = NS + ND / 2;
    const int lane = tid & 63, r32 = lane & 31, hi = lane >> 5; const int wave = __builtin_amdgcn_readfirstlane(tid >> 6);
    constexpr int QBYTES = QLDS ? 8 * NS * 4096 : 0;
    ATT_LAS unsigned char* Qs = lds + NSTG * STAGE + wave * (NS * 4096);
    ATT_LAS float* wsf = (ATT_LAS float*)(lds + NSTG * STAGE + QBYTES) + wave * 64;
    int ka;
    { const int kr = ts.row(0, ka); issue_tile<NS, ND>(lds, PROJ, kr, kcol, vcol, wave, lane); }
    if (NSTG == 3 && ts.nt > 1) { const int kr = ts.row(1, ka); issue_tile<NS, ND>(lds + STAGE, PROJ, kr, kcol, vcol, wave, lane); }
    bf16x8 qf[NS][4];
#pragma unroll
    for (int s = 0; s < NS; ++s)
#pragma unroll
        for (int d0 = 0; d0 < 4; ++d0) { qf[s][d0] = *(const bf16x8*)(PROJ + (size_t)(qrow + r32) * 2560 + qcol + 64 * s + 16 * d0 + 8 * hi);
            if (QLDS) *(ATT_LAS bf16x8*)(Qs + (s * 8 + 2 * d0 + hi) * 512 + r32 * 16) = qf[s][d0]; }
    f32x16 o[NS][ND];
#pragma unroll
    for (int s = 0; s < NS; ++s)
#pragma unroll
        for (int d = 0; d < ND; ++d)
#pragma unroll
            for (int r = 0; r < 16; ++r) o[s][d][r] = 0.f;
    float mref[NS], lsum[NS];
#pragma unroll
    for (int s = 0; s < NS; ++s) { mref[s] = (NS == 1) ? sinkl2 : -1e30f; lsum[s] = (NS == 1 && hi == 0) ? 1.0f : 0.f; }
    const int koff = hi * 1024 + r32 * 16;
    const int voff = ((lane >> 4) & 1) * 32 + (lane & 3) * 8 + (4 * hi + ((lane & 15) >> 2)) * 64;
    __builtin_amdgcn_s_waitcnt(0x0F70);
    int st = 0;
    for (int t = 0; t < ts.nt; ++t) {
        if (NSTG == 3 && t + 1 < ts.nt) asm volatile("s_waitcnt vmcnt(%0)" ::"n"(NDMA) : "memory"); else asm volatile("s_waitcnt vmcnt(0)" ::: "memory");
        asm volatile("s_waitcnt lgkmcnt(0)" ::: "memory");
        __builtin_amdgcn_s_barrier();
        asm volatile("" ::: "memory");
        if (NSTG == 3) { if (t + 2 < ts.nt) { int k2; const int kr = ts.row(t + 2, k2); const int s2 = (st >= 1) ? st - 1 : 2; issue_tile<NS, ND>(lds + s2 * STAGE, PROJ, kr, kcol, vcol, wave, lane); } }
        else { if (t + 1 < ts.nt) { int k2; const int kr = ts.row(t + 1, k2); issue_tile<NS, ND>(lds + (st ^ 1) * STAGE, PROJ, kr, kcol, vcol, wave, lane); } }
        int kabs0; (void)ts.row(t, kabs0);
        const ATT_LAS unsigned char* Ks = lds + st * STAGE; const ATT_LAS unsigned char* Vs = Ks + NS * 8192;
        u32x4 pf[NS][4];
#pragma unroll
        for (int s = 0; s < NS; ++s) {
            f32x16 p0, p1;
#pragma unroll
            for (int r = 0; r < 16; ++r) { p0[r] = 0.f; p1[r] = 0.f; }
            bf16x8 kA[4], kB[4];
#pragma unroll
            for (int d0 = 0; d0 < 4; ++d0) { kA[d0] = *(const ATT_LAS bf16x8*)(Ks + s * 8192 + koff + d0 * 2048); kB[d0] = *(const ATT_LAS bf16x8*)(Ks + s * 8192 + koff + d0 * 2048 + 512); }
            __builtin_amdgcn_sched_group_barrier(0x100, 8, 0);
#pragma unroll
            for (int d0 = 0; d0 < 4; ++d0) {
                const bf16x8 qv = QLDS ? *(const ATT_LAS bf16x8*)(Qs + (s * 8 + 2 * d0 + hi) * 512 + r32 * 16) : qf[s][d0];
                p0 = __builtin_amdgcn_mfma_f32_32x32x16_bf16(kA[d0], qv, p0, 0, 0, 0);
                p1 = __builtin_amdgcn_mfma_f32_32x32x16_bf16(kB[d0], qv, p1, 0, 0, 0);
            }
            __builtin_amdgcn_sched_group_barrier(0x008, 8, 0);
            if (NS == 1 && kabs0 != NOMASK) {
                const int dq = qabs + r32 - kabs0 - 4 * hi;
#pragma unroll
                for (int r = 0; r < 16; ++r) { const int dk = dq - ((r & 3) + 8 * (r >> 2)); if (dk > 128 || dk < -128) p0[r] = -1e30f; if (dk - 32 > 128 || dk - 32 < -128) p1[r] = -1e30f; }
            }
            float rm; { float a_ = AT_MX3(p0[0], p0[1], p1[0]), b_ = AT_MX3(p0[2], p0[3], p1[1]); a_ = AT_MX3(a_, p1[2], p1[3]);
#pragma unroll
                for (int r = 4; r < 16; r += 4) { a_ = AT_MX3(a_, p0[r], p0[r + 1]); b_ = AT_MX3(b_, p0[r + 2], p0[r + 3]); a_ = AT_MX3(a_, p1[r], p1[r + 1]); b_ = AT_MX3(b_, p1[r + 2], p1[r + 3]); }
                rm = __builtin_fmaxf(a_, b_); }
            rm = swapmax(rm);
            if (__any(rm > mref[s] + THR)) {
                const float mn = fmaxf(mref[s], rm), f = __builtin_amdgcn_exp2f(mref[s] - mn);
                lsum[s] *= f; mref[s] = mn;
                if (hi == 0) wsf[r32] = f;
                float fr[16];
#pragma unroll
                for (int r = 0; r < 16; ++r) fr[r] = wsf[crow(r, hi)];
#pragma unroll
                for (int d = 0; d < ND; ++d)
#pragma unroll
                    for (int r = 0; r < 16; ++r) o[s][d][r] *= fr[r];
            }
            float sacc = lsum[s];
#pragma unroll
            for (int r = 0; r < 16; ++r) { p0[r] = __builtin_amdgcn_exp2f(p0[r] - mref[s]); p1[r] = __builtin_amdgcn_exp2f(p1[r] - mref[s]); sacc = sacc + p0[r]; sacc = sacc + p1[r]; }
            lsum[s] = sacc;
            pf[s][0] = (u32x4){cvtpk(p0[0], p0[1]), cvtpk(p0[2], p0[3]), cvtpk(p0[4], p0[5]), cvtpk(p0[6], p0[7])};
            pf[s][1] = (u32x4){cvtpk(p0[8], p0[9]), cvtpk(p0[10], p0[11]), cvtpk(p0[12], p0[13]), cvtpk(p0[14], p0[15])};
            pf[s][2] = (u32x4){cvtpk(p1[0], p1[1]), cvtpk(p1[2], p1[3]), cvtpk(p1[4], p1[5]), cvtpk(p1[6], p1[7])};
            pf[s][3] = (u32x4){cvtpk(p1[8], p1[9]), cvtpk(p1[10], p1[11]), cvtpk(p1[12], p1[13]), cvtpk(p1[14], p1[15])};
        }
        __builtin_amdgcn_sched_barrier(0);
        pv_step<NS, ND>(o, pf, Vs + voff);
        __builtin_amdgcn_sched_barrier(0);
        st = (NSTG == 3) ? ((st == 2) ? 0 : st + 1) : (st ^ 1);
    }
    unsigned lz_ = 0u; asm volatile("" : "+v"(lz_)); const int lane_e = (int)__builtin_amdgcn_mbcnt_hi(~0u, __builtin_amdgcn_mbcnt_lo(~0u, lz_));
    const int r32e = lane_e & 31, hie = lane_e >> 5;
    float inv[NS][16];
#pragma unroll
    for (int s = 0; s < NS; ++s) {
        const float lt = swapsum(lsum[s]);
        if (hie == 0) wsf[s * 32 + r32e] = 1.0f / lt;
    }
#pragma unroll
    for (int s = 0; s < NS; ++s)
#pragma unroll
        for (int r = 0; r < 16; ++r) inv[s][r] = wsf[s * 32 + crow(r, hie)];
    if (NS == 1) {
        ATT_LAS unsigned char* Ts = lds + NSTG * STAGE + QBYTES + 2048 + wave * (32 * 64 * ND);
#pragma unroll
        for (int r = 0; r < 16; ++r)
#pragma unroll
            for (int d = 0; d < ND; ++d) *(ATT_LAS unsigned short*)(Ts + crow(r, hie) * (64 * ND) + (32 * d + r32e) * 2) = f2bf(o[0][d][r] * inv[0][r]);
        AT_ROWS_OUT(Ts, ND, Y, qrow, ycol, lane_e);
    } else {
        float gsub[ND];
#pragma unroll
        for (int d = 0; d < ND; ++d) gsub[d] = subg[32 * d + r32e] * oml;
#pragma unroll
        for (int r = 0; r < 16; ++r) {
            float ss = 0.f; float ov[ND];
#pragma unroll
            for (int d = 0; d < ND; ++d) { ov[d] = o[0][d][r] * inv[0][r] - lam * (o[NS - 1][d][r] * inv[NS - 1][r]); ss += ov[d] * ov[d]; }
            ss += sx(ss, 1, lane_e); ss += sx(ss, 2, lane_e); ss += sx(ss, 4, lane_e); ss += sx(ss, 8, lane_e); ss += sx(ss, 16, lane_e);
            const float rstd = 1.0f / sqrtf(ss * (1.0f / (32 * ND)) + 1e-6f);
            unsigned short* yp = Y + (size_t)(qrow + crow(r, hie)) * 1024 + ycol + r32e;
#pragma unroll
            for (int d = 0; d < ND; ++d) yp[32 * d] = f2bf(ov[d] * rstd * gsub[d]);
        }
    }
    asm volatile("s_waitcnt lgkmcnt(0)" ::: "memory");
    __builtin_amdgcn_s_barrier();
    asm volatile("" ::: "memory");
}

#define ATT_MX3(a, b, c) __builtin_fmaxf(__builtin_fmaxf((a), (b)), (c))
template <int NS, int ND> __device__ __forceinline__ void pv_step(f32x16 (&o)[NS][ND], const u32x4 (&pf)[NS][4], const ATT_LAS unsigned char* Vs) {
    constexpr int NF = 4 * ND, PVDEP = 3;
    __builtin_amdgcn_s_setprio(1);
    bf16x8 vf[NF];
#define PV_LD(i_) do { const int ks_ = (i_) / ND, d_ = (i_) % ND; const s16x4 lo_ = vtr(Vs + d_ * 4096 + ks_ * 1024), hh_ = vtr(Vs + d_ * 4096 + ks_ * 1024 + 512); \
        vf[i_] = (bf16x8){lo_[0], lo_[1], lo_[2], lo_[3], hh_[0], hh_[1], hh_[2], hh_[3]}; } while (0)
#pragma unroll
    for (int i = 0; i < PVDEP; ++i) PV_LD(i);
    __builtin_amdgcn_sched_group_barrier(0x100, 2 * PVDEP, 0);
#pragma unroll
    for (int i = 0; i < NF; ++i) {
        if (i + PVDEP < NF) PV_LD(i + PVDEP);
#pragma unroll
        for (int s = 0; s < NS; ++s) o[s][i % ND] = __builtin_amdgcn_mfma_f32_32x32x16_bf16(__builtin_bit_cast(bf16x8, pf[s][i / ND]), vf[i], o[s][i % ND], 0, 0, 0);
        if (i + PVDEP < NF) __builtin_amdgcn_sched_group_barrier(0x100, 2, 0);
        __builtin_amdgcn_sched_group_barrier(0x008, NS, 0);
    }
#undef PV_LD
    __builtin_amdgcn_s_setprio(0);
}
template <int NS, int ND>
__device__ __forceinline__ void attn_unit_pp(ATT_LAS unsigned char* lds, const unsigned short* PROJ, unsigned short* Y, const TileSeq ts, int qrow, int qcol, int kcol, int vcol, int ycol,
                                             float lam, const float* subg, float oml, int tid) {
    constexpr int KB = NS * 8192, VB = ND * 4096, OFF_V = 2 * KB, OFF_Q = 2 * KB + 3 * VB, OFF_W = OFF_Q + 8 * NS * 4096;
    const int lane = tid & 63, r32 = lane & 31, hi = lane >> 5; const int wave = __builtin_amdgcn_readfirstlane(tid >> 6); const bool grpB = wave >= 4;
    ATT_LAS unsigned char* Qs = lds + OFF_Q + wave * (NS * 4096);
    ATT_LAS float* wsf = (ATT_LAS float*)(lds + OFF_W) + wave * 64;
#define PP_ISSUE(t_, kslot_, vslot_) do { int ka_; const int kr_ = ts.row((t_), ka_); \
        _Pragma("unroll") for (int i_ = 0; i_ < NS; ++i_) { const int p_ = wave + 8 * i_, s_ = p_ >> 3, c_ = p_ & 7; \
            dma16(PROJ + (size_t)(kr_ + lane) * 2560 + kcol + 64 * s_ + 8 * c_, lds + (kslot_) * KB + s_ * 8192 + c_ * 1024); } \
        _Pragma("unroll") for (int i_ = 0; i_ < ND / 2; ++i_) { const int p_ = wave + 8 * i_, db_ = p_ >> 2, rg_ = p_ & 3; \
            dma16(PROJ + (size_t)(kr_ + 16 * rg_ + (lane >> 2)) * 2560 + vcol + 32 * db_ + 8 * (lane & 3), lds + OFF_V + (vslot_) * VB + (db_ * 4 + rg_) * 1024); } } while (0)
    PP_ISSUE(0, 0, 0);
#pragma unroll
    for (int s = 0; s < NS; ++s)
#pragma unroll
        for (int d0 = 0; d0 < 4; ++d0) *(ATT_LAS bf16x8*)(Qs + (s * 8 + 2 * d0 + hi) * 512 + r32 * 16) = *(const bf16x8*)(PROJ + (size_t)(qrow + r32) * 2560 + qcol + 64 * s + 16 * d0 + 8 * hi);
    f32x16 o[NS][ND];
#pragma unroll
    for (int s = 0; s < NS; ++s)
#pragma unroll
        for (int d = 0; d < ND; ++d)
#pragma unroll
            for (int r = 0; r < 16; ++r) o[s][d][r] = 0.f;
    float mref[NS], lsum[NS];
#pragma unroll
    for (int s = 0; s < NS; ++s) { mref[s] = 0.f; lsum[s] = 0.f; }
    u32x4 pf[NS][4];
#pragma unroll
    for (int s = 0; s < NS; ++s)
#pragma unroll
        for (int k = 0; k < 4; ++k) pf[s][k] = (u32x4){0u, 0u, 0u, 0u};
    const int koff = hi * 1024 + r32 * 16;
    const int voff = ((lane >> 4) & 1) * 32 + (lane & 3) * 8 + (4 * hi + ((lane & 15) >> 2)) * 64;
#define PP_QKSM(Ks_, MID_) do { \
        _Pragma("unroll") for (int s = 0; s < NS; ++s) { \
            f32x16 p0, p1; \
            _Pragma("unroll") for (int r = 0; r < 16; ++r) { p0[r] = -mref[s]; p1[r] = -mref[s]; } \
            bf16x8 kA_[4], kB_[4], qq_[4];        \
            _Pragma("unroll") for (int d0 = 0; d0 < 2; ++d0) { \
                kA_[d0] = *(const ATT_LAS bf16x8*)((Ks_) + s * 8192 + koff + d0 * 2048); kB_[d0] = *(const ATT_LAS bf16x8*)((Ks_) + s * 8192 + koff + d0 * 2048 + 512); \
                qq_[d0] = *(const ATT_LAS bf16x8*)(Qs + (s * 8 + 2 * d0 + hi) * 512 + r32 * 16); } \
            __builtin_amdgcn_sched_group_barrier(0x100, 6, 0); \
            _Pragma("unroll") for (int d0 = 0; d0 < 4; ++d0) { \
                if (d0 + 2 < 4) { kA_[d0 + 2] = *(const ATT_LAS bf16x8*)((Ks_) + s * 8192 + koff + (d0 + 2) * 2048); kB_[d0 + 2] = *(const ATT_LAS bf16x8*)((Ks_) + s * 8192 + koff + (d0 + 2) * 2048 + 512); \
                    qq_[d0 + 2] = *(const ATT_LAS bf16x8*)(Qs + (s * 8 + 2 * (d0 + 2) + hi) * 512 + r32 * 16); } \
                p0 = __builtin_amdgcn_mfma_f32_32x32x16_bf16(kA_[d0], qq_[d0], p0, 0, 0, 0); \
                p1 = __builtin_amdgcn_mfma_f32_32x32x16_bf16(kB_[d0], qq_[d0], p1, 0, 0, 0); \
                __builtin_amdgcn_sched_group_barrier(0x008, 2, 0); \
                if (d0 + 2 < 4) __builtin_amdgcn_sched_group_barrier(0x100, 3, 0); } \
            float rm; { float a_ = ATT_MX3(p0[0], p0[1], p1[0]), b_ = ATT_MX3(p0[2], p0[3], p1[1]); a_ = ATT_MX3(a_, p1[2], p1[3]); \
                _Pragma("unroll") for (int r = 4; r < 16; r += 4) { a_ = ATT_MX3(a_, p0[r], p0[r + 1]); b_ = ATT_MX3(b_, p0[r + 2], p0[r + 3]); a_ = ATT_MX3(a_, p1[r], p1[r + 1]); b_ = ATT_MX3(b_, p1[r + 2], p1[r + 3]); } \
                rm = __builtin_fmaxf(a_, b_); } \
            rm = swapmax(rm); \
            if (__any(rm > THR || firstf != 0.f)) { const float dl = fmaxf(rm, (firstf != 0.f) ? -100.f : 0.f), f = __builtin_amdgcn_exp2f(-dl); mref[s] += dl; lsum[s] *= f; \
                _Pragma("unroll") for (int r = 0; r < 16; ++r) { p0[r] -= dl; p1[r] -= dl; } \
                if (hi == 0) wsf[r32] = f; \
                _Pragma("unroll") for (int r = 0; r < 16; ++r) { const float fr = wsf[crow(r, hi)]; _Pragma("unroll") for (int d = 0; d < ND; ++d) o[s][d][r] *= fr; } } \
            float sacc = lsum[s];        \
            _Pragma("unroll") for (int r = 0; r < 16; ++r) { p0[r] = __builtin_amdgcn_exp2f(p0[r]); p1[r] = __builtin_amdgcn_exp2f(p1[r]); sacc = sacc + p0[r]; sacc = sacc + p1[r]; } \
            lsum[s] = sacc; \
            pf[s][0] = (u32x4){cvtpk(p0[0], p0[1]), cvtpk(p0[2], p0[3]), cvtpk(p0[4], p0[5]), cvtpk(p0[6], p0[7])}; \
            pf[s][1] = (u32x4){cvtpk(p0[8], p0[9]), cvtpk(p0[10], p0[11]), cvtpk(p0[12], p0[13]), cvtpk(p0[14], p0[15])}; \
            pf[s][2] = (u32x4){cvtpk(p1[0], p1[1]), cvtpk(p1[2], p1[3]), cvtpk(p1[4], p1[5]), cvtpk(p1[6], p1[7])}; \
            pf[s][3] = (u32x4){cvtpk(p1[8], p1[9]), cvtpk(p1[10], p1[11]), cvtpk(p1[12], p1[13]), cvtpk(p1[14], p1[15])}; \
            if (s == 0) { MID_; }        \
        } \
        firstf = 0.f; asm volatile("" : "+v"(firstf)); } while (0)
#define PP_TOP() do { asm volatile("s_waitcnt vmcnt(0)" ::: "memory"); asm volatile("s_waitcnt lgkmcnt(0)" ::: "memory"); __builtin_amdgcn_s_barrier(); asm volatile("" ::: "memory"); } while (0)
    int kst = 0, vst = 0, vprev = 2;
    float firstf = 1.f; asm volatile("" : "+v"(firstf));
    if (!grpB) {
        for (int t = 0; t < ts.nt; ++t) {
            PP_TOP();
            const int vnext = (vst == 2) ? 0 : vst + 1;
            PP_QKSM(lds + kst * KB, if (t + 1 < ts.nt) PP_ISSUE(t + 1, kst ^ 1, vnext));
            __builtin_amdgcn_sched_barrier(0);
            pv_step<NS, ND>(o, pf, lds + OFF_V + vst * VB + voff);
            vst = vnext; kst ^= 1;
        }
    } else {
        for (int t = 0; t < ts.nt; ++t) {
            PP_TOP();
            const int vnext = (vst == 2) ? 0 : vst + 1;
            if (t > 0) pv_step<NS, ND>(o, pf, lds + OFF_V + vprev * VB + voff);
            __builtin_amdgcn_sched_barrier(0);
            PP_QKSM(lds + kst * KB, if (t + 1 < ts.nt) PP_ISSUE(t + 1, kst ^ 1, vnext));
            vprev = vst; vst = vnext; kst ^= 1;
        }
        pv_step<NS, ND>(o, pf, lds + OFF_V + vprev * VB + voff);
    }
#undef PP_QKSM
#undef PP_TOP
#undef PP_ISSUE
    unsigned lz_ = 0u; asm volatile("" : "+v"(lz_)); const int lane_e = (int)__builtin_amdgcn_mbcnt_hi(~0u, __builtin_amdgcn_mbcnt_lo(~0u, lz_));
    const int r32e = lane_e & 31, hie = lane_e >> 5;
    float inv[NS][16];
#pragma unroll
    for (int s = 0; s < NS; ++s) {
        const float lt = swapsum(lsum[s]);
        if (hie == 0) wsf[s * 32 + r32e] = 1.0f / lt;
    }
#pragma unroll
    for (int s = 0; s < NS; ++s)
#pragma unroll
        for (int r = 0; r < 16; ++r) inv[s][r] = wsf[s * 32 + crow(r, hie)];
    if (NS == 1) {
#pragma unroll
        for (int r = 0; r < 16; ++r) { unsigned short* yp = Y + (size_t)(qrow + crow(r, hie)) * 1024 + ycol + r32e;
#pragma unroll
            for (int d = 0; d < ND; ++d) yp[32 * d] = f2bf(o[0][d][r] * inv[0][r]); }
    } else {
        float gsub[ND];
#pragma unroll
        for (int d = 0; d < ND; ++d) gsub[d] = subg[32 * d + r32e] * oml;
#pragma unroll
        for (int r = 0; r < 16; ++r) {
            float ss = 0.f; float ov[ND];
#pragma unroll
            for (int d = 0; d < ND; ++d) { ov[d] = o[0][d][r] * inv[0][r] - lam * (o[NS - 1][d][r] * inv[NS - 1][r]); ss += ov[d] * ov[d]; }
            ss += sx(ss, 1, lane_e); ss += sx(ss, 2, lane_e); ss += sx(ss, 4, lane_e); ss += sx(ss, 8, lane_e); ss += sx(ss, 16, lane_e);
            const float rstd = 1.0f / sqrtf(ss * (1.0f / (32 * ND)) + 1e-6f);
#pragma unroll
            for (int d = 0; d < ND; ++d) *(ATT_LAS unsigned short*)(Qs + crow(r, hie) * (64 * ND) + (32 * d + r32e) * 2) = f2bf(ov[d] * rstd * gsub[d]);
        }
        AT_ROWS_OUT(Qs, ND, Y, qrow, ycol, lane_e);
    }
    asm volatile("s_waitcnt lgkmcnt(0)" ::: "memory");
    __builtin_amdgcn_s_barrier();
    asm volatile("" ::: "memory");
}
}

namespace lru {
typedef short bf16x8 __attribute__((ext_vector_type(8)));
typedef float f32x4 __attribute__((ext_vector_type(4)));
typedef unsigned u32x4 __attribute__((ext_vector_type(4)));
#define LRU_LAS __attribute__((address_space(3)))
constexpr int LXS = 528, UBS = 528, HSS = 1040;
constexpr int OFF_HS = 0, OFF_LX = 0, OFF_UB = 66560, OFF_HIN = 66560 + 33792;
__device__ __forceinline__ float sxl(float v, int srclane) { return __int_as_float(__builtin_amdgcn_ds_bpermute(srclane << 2, __float_as_int(v))); }
__device__ __forceinline__ float fsig(float x) { return __builtin_amdgcn_rcpf(1.0f + __builtin_amdgcn_exp2f(-1.4426950408889634f * x)); }


template <bool FINAL, int DIR>
__device__ __forceinline__ void lru_scan_part(LRU_LAS unsigned char* lds, const unsigned short* WL, const float* br, const float* bi, const float* lruc, float* SUMM, unsigned* PH, int rowbase, int b, int ck, int blk, int lane, int nt0, int nt1) {
    constexpr int dir = DIR;
    const int c16 = lane & 15, g = lane >> 4;
    const unsigned short* wbase = WL + (size_t)((dir * 4 + blk) * 2) * 4096;
    bf16x8 bwn[2][2]; float brn, bin_, cdn;
#define LRU_LOADW(nt_) do { const int chn_ = blk * 64 + 16 * (nt_) + c16; \
        _Pragma("unroll") for (int gt = 0; gt < 2; ++gt) _Pragma("unroll") for (int ks = 0; ks < 2; ++ks) bwn[gt][ks] = *(const bf16x8*)(wbase + (size_t)gt * 4096 + (16 * (nt_) + c16) * 64 + 32 * ks + 8 * g); \
        brn = br[dir * 256 + chn_]; bin_ = bi[dir * 256 + chn_]; cdn = lruc[dir * 256 + chn_]; } while (0)
    LRU_LOADW(nt0);
#pragma unroll 2
    for (int nt = nt0; nt < nt1; ++nt) {
        const int ch = blk * 64 + 16 * nt + c16;
        bf16x8 bw[2][2];
#pragma unroll
        for (int gt = 0; gt < 2; ++gt)
#pragma unroll
            for (int ks = 0; ks < 2; ++ks) bw[gt][ks] = bwn[gt][ks];
        const float brv = brn, biv = bin_, cdec = cdn;
        if (nt + 1 < nt1) LRU_LOADW(nt + 1);
        f32x4 ar[4], ai[4];
#pragma unroll
        for (int m = 0; m < 4; ++m) {
            ar[m] = (f32x4){0.f, 0.f, 0.f, 0.f}; ai[m] = ar[m];
#pragma unroll
            for (int ks = 0; ks < 2; ++ks) { const bf16x8 af = *(const LRU_LAS bf16x8*)(lds + OFF_UB + (16 * m + c16) * UBS + (blk * 64 + 32 * ks + 8 * g) * 2);
                ar[m] = __builtin_amdgcn_mfma_f32_16x16x32_bf16(af, bw[0][ks], ar[m], 0, 0, 0); ai[m] = __builtin_amdgcn_mfma_f32_16x16x32_bf16(af, bw[1][ks], ai[m], 0, 0, 0); }
        }
        float Pi[4][4], Hi[4][4], Ps[4], Hs[4];
#pragma unroll
        for (int m = 0; m < 4; ++m) {
            float P = 1.f, Hh = 0.f;
#pragma unroll
            for (int ee = 0; ee < 4; ++ee) { constexpr int dummy = 0; const int e = dir ? 3 - ee : ee;
                const int tok = 16 * m + 4 * g + e;
                const float r = fsig(ar[m][e] + brv), iv = fsig(ai[m][e] + biv), la = r * cdec, a = __builtin_amdgcn_exp2f(1.4426950408889634f * la);
                const float uval = __uint_as_float((unsigned)(*(const LRU_LAS unsigned short*)(lds + OFF_UB + tok * UBS + ch * 2)) << 16);
                const float bb = __builtin_amdgcn_sqrtf((1.f - a) * (1.f + a)) * iv * uval;
                Hh = a * Hh + bb; P = P * a; Pi[m][e] = P; Hi[m][e] = Hh; }
            Ps[m] = P; Hs[m] = Hh;
        }
        float Pc = 1.f, Hc = 0.f;
#pragma unroll
        for (int mm = 0; mm < 4; ++mm) { const int m = dir ? 3 - mm : mm;
            float P = Ps[m], Hh = Hs[m];
            {
                const int src = dir ? lane + 16 : lane - 16; const bool ok = dir ? (g <= 2) : (g >= 1);
                const float Pp = sxl(P, src & 63), Hp = sxl(Hh, src & 63); if (ok) { Hh = P * Hp + Hh; P = P * Pp; } }
            {
                const int src = dir ? lane + 32 : lane - 32; const bool ok = dir ? (g <= 1) : (g >= 2);
                const float Pp = sxl(P, src & 63), Hp = sxl(Hh, src & 63); if (ok) { Hh = P * Hp + Hh; P = P * Pp; } }
            float Pe, He;
            { const int src = dir ? lane + 16 : lane - 16; const bool ok = dir ? (g <= 2) : (g >= 1); const float Pp = sxl(P, src & 63), Hp = sxl(Hh, src & 63); Pe = ok ? Pp : 1.f; He = ok ? Hp : 0.f; }
            const int lastl = (dir ? 0 : 48) + c16; const float Pt = sxl(P, lastl), Ht = sxl(Hh, lastl);
            { const float Pb = Pe * Pc, Hb = Pe * Hc + He;
#pragma unroll
              for (int e = 0; e < 4; ++e) { const int tok = 16 * m + 4 * g + e; const float pt = Pi[m][e] * Pb, ht = Pi[m][e] * Hb + Hi[m][e];
                  PH[((size_t)dir * 17408 + rowbase + tok) * 256 + ch] = cvtpk2(pt, ht); } }
            Hc = Pt * Hc + Ht; Pc = Pt * Pc;
        }
        if (!FINAL) { if (g == 0) { float2 o; o.x = Pc; o.y = Hc; *(float2*)(SUMM + ((size_t)(b * 2 + dir) * 68 + ck) * 512 + 2 * ch) = o; } }
    }
#undef LRU_LOADW
}
template <bool FINAL>
__device__ __forceinline__ void lru_unit(LRU_LAS unsigned char* lds, const unsigned short* PROJ, unsigned short* Y, const unsigned short* WL, const float* cw, const float* cb,
                                         const float* br, const float* bi, const float* lruc, float* SUMM, unsigned* PH, int b, int ck, int mode, int tid) {
    const int lane = tid & 63; const int wave = __builtin_amdgcn_readfirstlane(tid >> 6);
    const int seqbase = (ck < 4) ? 16384 + b * 256 : b * 4096, pos0 = (ck < 4) ? 64 * ck : 64 * (ck - 4), len = (ck < 4) ? 256 : 4096;
    {
        u32x4 v[5];
#pragma unroll
        for (int k = 0; k < 5; ++k) { int it = tid + 512 * k; it = (it < 67 * 32) ? it : 67 * 32 - 1; const int i = it >> 5, c = it & 31, p = pos0 - 2 + i; const int pc = p < 0 ? 0 : (p >= len ? len - 1 : p);
            v[k] = *(const u32x4*)(PROJ + (size_t)(seqbase + pc) * 2560 + 8 * c); }
#pragma unroll
        for (int k = 0; k < 5; ++k) { const int it = tid + 512 * k; const int i = it >> 5, c = it & 31, p = pos0 - 2 + i; const bool ok = (p >= 0 && p < len);
            const u32x4 z = {0u, 0u, 0u, 0u}; if (it < 67 * 32) *(LRU_LAS u32x4*)(lds + OFF_LX + i * LXS + c * 16) = ok ? v[k] : z; }
    }
    __syncthreads();
    {
        const int ch2 = tid & 127, tg = tid >> 7; float w0[4], w1[4];
#pragma unroll
        for (int k = 0; k < 4; ++k) { w0[k] = cw[k * 256 + 2 * ch2]; w1[k] = cw[k * 256 + 2 * ch2 + 1]; }
        const float b0 = cb[2 * ch2], b1 = cb[2 * ch2 + 1];
        float x0[4], x1[4];
#pragma unroll
        for (int k = 0; k < 3; ++k) { const unsigned v = *(const LRU_LAS unsigned*)(lds + OFF_LX + (tg * 16 + k) * LXS + ch2 * 4); x0[k + 1] = __uint_as_float(v << 16); x1[k + 1] = __uint_as_float(v & 0xffff0000u); }
#pragma unroll
        for (int t = 0; t < 16; ++t) {
            x0[0] = x0[1]; x0[1] = x0[2]; x0[2] = x0[3]; x1[0] = x1[1]; x1[1] = x1[2]; x1[2] = x1[3];
            const unsigned v = *(const LRU_LAS unsigned*)(lds + OFF_LX + (tg * 16 + t + 3) * LXS + ch2 * 4); x0[3] = __uint_as_float(v << 16); x1[3] = __uint_as_float(v & 0xffff0000u);
            const float u0 = b0 + w0[0] * x0[0] + w0[1] * x0[1] + w0[2] * x0[2] + w0[3] * x0[3], u1 = b1 + w1[0] * x1[0] + w1[1] * x1[1] + w1[2] * x1[2] + w1[3] * x1[3];
            *(LRU_LAS unsigned*)(lds + OFF_UB + (tg * 16 + t) * UBS + ch2 * 4) = cvtpk2(u0, u1);
        }
    }
    __syncthreads();
    { const int dsel = (mode == 0) ? (wave & 1) : (mode - 1), nt0 = (mode == 0) ? 0 : 2 * (wave & 1), nt1 = (mode == 0) ? 4 : nt0 + 2;
      if (dsel) lru_scan_part<FINAL, 1>(lds, WL, br, bi, lruc, SUMM, PH, seqbase + pos0, b, ck, wave >> 1, lane, nt0, nt1);
      else      lru_scan_part<FINAL, 0>(lds, WL, br, bi, lruc, SUMM, PH, seqbase + pos0, b, ck, wave >> 1, lane, nt0, nt1); }
    __syncthreads();
}

__device__ __forceinline__ void lru_final_unit(LRU_LAS unsigned char* lds, const unsigned short* PROJ, unsigned short* Y, const float* SUMM, const unsigned* PH, int b, int ck, int tid) {
    const int seqbase = (ck < 4) ? 16384 + b * 256 : b * 4096, pos0 = (ck < 4) ? 64 * ck : 64 * (ck - 4);
    { const int ch = tid & 255, dir = tid >> 8; const float* sp = SUMM + ((size_t)(b * 2 + dir) * 68) * 512 + 2 * ch;
      const int np = dir ? ((ck < 4) ? 3 - ck : 4 + (67 - ck)) : ck; float hin = 0.f;
      for (int p0 = 0; p0 < np; p0 += 16) { float2 v[16];
#pragma unroll
          for (int j = 0; j < 16; ++j) { int p = p0 + j; p = (p < np) ? p : np - 1; const int c = dir ? ((p < 4) ? 3 - p : 67 - (p - 4)) : p; v[j] = *(const float2*)(sp + (size_t)c * 512); }
#pragma unroll
          for (int j = 0; j < 16; ++j) { const bool ok = (p0 + j) < np; const float px = ok ? v[j].x : 1.f, hy = ok ? v[j].y : 0.f; hin = px * hin + hy; } }
      *(LRU_LAS float*)(lds + tid * 4) = hin; }
    __syncthreads();
    const int tok = tid >> 3, cg = tid & 7; const size_t row = (size_t)seqbase + pos0 + tok;
#pragma unroll
    for (int j = 0; j < 4; ++j) { const int c0 = 32 * cg + 8 * j;
        const u32x4 f0 = *(const u32x4*)(PH + row * 256 + c0), f1 = *(const u32x4*)(PH + row * 256 + c0 + 4), r0 = *(const u32x4*)(PH + ((size_t)17408 + row) * 256 + c0), r1 = *(const u32x4*)(PH + ((size_t)17408 + row) * 256 + c0 + 4);
        const u32x4 lg = *(const u32x4*)(PROJ + row * 2560 + 256 + c0);
        const unsigned ff[8] = {f0.x, f0.y, f0.z, f0.w, f1.x, f1.y, f1.z, f1.w}, rr[8] = {r0.x, r0.y, r0.z, r0.w, r1.x, r1.y, r1.z, r1.w}; const unsigned lgw[4] = {lg.x, lg.y, lg.z, lg.w};
        float y[8];
#pragma unroll
        for (int k = 0; k < 8; ++k) { const float hf = *(const LRU_LAS float*)(lds + (c0 + k) * 4), hr = *(const LRU_LAS float*)(lds + (256 + c0 + k) * 4);
            const float h = (__uint_as_float(ff[k] & 0xffff0000u) + __uint_as_float(ff[k] << 16) * hf) + (__uint_as_float(rr[k] & 0xffff0000u) + __uint_as_float(rr[k] << 16) * hr);
            const float g = (k & 1) ? __uint_as_float(lgw[k >> 1] & 0xffff0000u) : __uint_as_float(lgw[k >> 1] << 16); y[k] = h * g; }
        u32x4 o; o.x = cvtpk2(y[0], y[1]); o.y = cvtpk2(y[2], y[3]); o.z = cvtpk2(y[4], y[5]); o.w = cvtpk2(y[6], y[7]);
        *(u32x4*)(Y + row * 1024 + c0) = o; }
    __syncthreads();
}
}

#include <utility>
constexpr int NWAVES = 8;
constexpr int RING_OFF = 0, RING_BYTES = 150528;
constexpr int LDSCTL_OFF = RING_BYTES, MISC_OFF = LDSCTL_OFF + 320;
constexpr int LDS_BYTES = 155648;
constexpr int CW_BAR = 4096;
constexpr int MAX_LAUNCHES = 16;
static_assert((CW_BAR + MAX_LAUNCHES * XCD_BAR_WORDS) * 4 <= (int)(1u << 20), "CTL words inside the memset region");

constexpr int PH_PRO = 0, PH_PRO2 = 1, PH_L0 = 2, PH_PER_LAYER = 11, PH_FINAL = PH_L0 + 2 * PH_PER_LAYER, NPH = PH_FINAL + 1;
constexpr int EPI_OFF = LDSCTL_OFF + 1024;

#ifndef MK_REPEAT_PH
#define MK_REPEAT_PH (-1)
#endif
struct Args { const float* in[24]; float* out; unsigned char* ws; int ph_lo, ph_hi, li, rep; };

__device__ __forceinline__ float shfl_xor_l(float v, int mask, int lane) { return __int_as_float(__builtin_amdgcn_ds_bpermute((lane ^ mask) << 2, __float_as_int(v))); }
__device__ __forceinline__ float wave_sum(float v, int lane) {
#pragma unroll
    for (int o = 1; o < 64; o <<= 1) v += shfl_xor_l(v, o, lane);
    return v;
}
__device__ __forceinline__ unsigned pk2(float lo, float hi) { return cvtpk2(lo, hi); }

__device__ __forceinline__ void p0_transpose_item(const float* W, int K, int N, bf16_t* WT, int kind, LAS float* scr, int item, int lane) {
    const int nblk = N / 64, kb = item / nblk, nb = item % nblk, k0 = 64 * kb, n0 = 64 * nb;
    const int rr = lane >> 4, cq = lane & 15;
    f32x4 v[16];
#pragma unroll
    for (int i = 0; i < 16; ++i) v[i] = *(const f32x4*)(W + (size_t)(k0 + 4 * i + rr) * N + n0 + 4 * cq);
#pragma unroll
    for (int i = 0; i < 16; ++i) { LAS float* p = scr + (4 * i + rr) * 65 + 4 * cq; p[0] = v[i].x; p[1] = v[i].y; p[2] = v[i].z; p[3] = v[i].w; }
    LDS_WAIT(); asm volatile("" ::: "memory");
    const int c = lane & 7;
#pragma unroll
    for (int j = 0; j < 8; ++j) { const int n = (lane >> 3) + 8 * j; const LAS float* s = scr + (8 * c) * 65 + n;
        v4u o; o.x = pk2(s[0 * 65], s[1 * 65]); o.y = pk2(s[2 * 65], s[3 * 65]); o.z = pk2(s[4 * 65], s[5 * 65]); o.w = pk2(s[6 * 65], s[7 * 65]);
        *(GAS v4u*)(WT + (size_t)dest_row(kind, n0 + n) * K + k0 + 8 * c) = o; }
    LDS_WAIT(); asm volatile("" ::: "memory");
}

struct ConvDesc { const float* W; bf16_t* WT; int K, N, kind, item; };
__device__ __forceinline__ void p0_load(const ConvDesc& d, f32x4 (&v)[16], int lane) {
    const int nblk = d.N / 64, kb = d.item / nblk, nb = d.item % nblk, k0 = 64 * kb, n0 = 64 * nb; const int rr = lane >> 4, cq = lane & 15;
#pragma unroll
    for (int i = 0; i < 16; ++i) v[i] = *(const f32x4*)(d.W + (size_t)(k0 + 4 * i + rr) * d.N + n0 + 4 * cq);
}
__device__ __forceinline__ void p0_finish(const ConvDesc& d, const f32x4 (&v)[16], LAS float* scr, int lane) {
    const int nblk = d.N / 64, kb = d.item / nblk, nb = d.item % nblk, k0 = 64 * kb, n0 = 64 * nb; const int rr = lane >> 4, cq = lane & 15;
#pragma unroll
    for (int i = 0; i < 16; ++i) { LAS float* p = scr + (4 * i + rr) * 65 + 4 * cq; p[0] = v[i].x; p[1] = v[i].y; p[2] = v[i].z; p[3] = v[i].w; }
    LDS_WAIT(); asm volatile("" ::: "memory");
    const int c = lane & 7;
#pragma unroll
    for (int j = 0; j < 8; ++j) { const int n = (lane >> 3) + 8 * j; const LAS float* s = scr + (8 * c) * 65 + n;
        v4u o; o.x = pk2(s[0 * 65], s[1 * 65]); o.y = pk2(s[2 * 65], s[3 * 65]); o.z = pk2(s[4 * 65], s[5 * 65]); o.w = pk2(s[6 * 65], s[7 * 65]);
        *(GAS v4u*)(d.WT + (size_t)dest_row(d.kind, n0 + n) * d.K + k0 + 8 * c) = o; }
    LDS_WAIT(); asm volatile("" ::: "memory");
}

__device__ __forceinline__ void norm_row(const float* src, const float* g, const float* shift, const float* scale, bf16_t* orow, int lane) {
    const f32x4* xr = (const f32x4*)src + lane; f32x4 v[4]; float s = 0.f;
#pragma unroll
    for (int j = 0; j < 4; ++j) { v[j] = xr[64 * j]; s += (v[j].x * v[j].x + v[j].y * v[j].y) + (v[j].z * v[j].z + v[j].w * v[j].w); }
    const float rstd = 1.0f / sqrtf(wave_sum(s, lane) * (1.0f / D) + 1e-6f);
    unsigned long long* o8 = (unsigned long long*)orow + lane;
#pragma unroll
    for (int j = 0; j < 4; ++j) { const int c0 = (lane + 64 * j) * 4; const f32x4 gg = *(const f32x4*)(g + c0), sc = *(const f32x4*)(scale + c0), sh = *(const f32x4*)(shift + c0);
        const f32x4 y = v[j] * rstd * gg * (sc + 1.0f) + sh;
        o8[64 * j] = (unsigned long long)pk2(y.x, y.y) | ((unsigned long long)pk2(y.z, y.w) << 32); }
}

__device__ __forceinline__ void norm_regs(const f32x4 (&v)[4], const float* g, const float* shift, const float* scale, bf16_t* orow, int lane) {
    float s = 0.f;
#pragma unroll
    for (int j = 0; j < 4; ++j) s += (v[j].x * v[j].x + v[j].y * v[j].y) + (v[j].z * v[j].z + v[j].w * v[j].w);
    const float rstd = 1.0f / sqrtf(wave_sum(s, lane) * (1.0f / D) + 1e-6f);
    unsigned long long* o8 = (unsigned long long*)orow + lane;
#pragma unroll
    for (int j = 0; j < 4; ++j) { const int c0 = (lane + 64 * j) * 4; const f32x4 gg = *(const f32x4*)(g + c0), sc = *(const f32x4*)(scale + c0), sh = *(const f32x4*)(shift + c0);
        const f32x4 y = v[j] * rstd * gg * (sc + 1.0f) + sh;
        o8[64 * j] = (unsigned long long)pk2(y.x, y.y) | ((unsigned long long)pk2(y.z, y.w) << 32); }
}

constexpr int I_GU = (D / 64) * (2 * DFF / 64), I_DN = (DFF / 64) * (D / 64), I_IN = (D / 64) * (NIN / 64), I_OUT = (D / 64) * (D / 64);
constexpr int R_GU1 = 0, R_GU2 = I_GU, R_DN1 = 2 * I_GU, R_DN2 = R_DN1 + I_DN, R_IN = R_DN2 + I_DN, R_OUT = R_IN + I_IN, I_LAYER = R_OUT + I_OUT;

struct KCtx { LAS unsigned char* lds; unsigned char* ws; float* out; const __attribute__((address_space(4))) unsigned long long* kin; int wave0, vcu, G, bx, ph_lo, ph_end; XcdBarrier bar; };
#define tidq() ({ int tq_ = tid; asm volatile("" : "+v"(tq_)); tq_; })
#define KIN(i) ((const float*)(const GAS float*)(kin[(i) + kz]))
template <int PHI> __device__ __forceinline__ void run_phase(const KCtx& kc) {
    if (PHI < kc.ph_lo || PHI >= kc.ph_end) return;
    constexpr int ph = (MK_REPEAT_PH >= 0 && PHI > MK_REPEAT_PH) ? PHI - 1 : PHI;
    LAS unsigned char* lds = kc.lds; unsigned char* ws = kc.ws; const __attribute__((address_space(4))) unsigned long long* kin = kc.kin;
    const int wave0 = kc.wave0, vcu = kc.vcu, G = kc.G, bx = kc.bx, NGW = kc.G * NWAVES;
    struct { float* out; } args; args.out = kc.out;
        unsigned lz = 0u; asm volatile("" : "+v"(lz)); const int lane_o = (int)__builtin_amdgcn_mbcnt_hi(~0u, __builtin_amdgcn_mbcnt_lo(~0u, lz));
        const int lane = lane_o, wave = wave0, tid = wave0 * 64 + lane_o, gw = vcu * NWAVES + wave;
        int kz = 0; asm volatile("" : "+s"(kz));
        unsigned long long wsi = (unsigned long long)ws; asm volatile("" : "+s"(wsi)); unsigned char* wsp = (unsigned char*)(GAS unsigned char*)wsi;
        float* MOD = (float*)(wsp + WS_MOD); Tab* T = (Tab*)(wsp + WS_TAB); bf16_t* W = (bf16_t*)(wsp + WS_W); float* H = (float*)(wsp + WS_H);
        bf16_t* HB = (bf16_t*)(wsp + WS_R); bf16_t* PROJ = (bf16_t*)(wsp + WS_R + R_PROJ); bf16_t* Y = (bf16_t*)(wsp + WS_R + R_Y);
        unsigned long long outi = (unsigned long long)args.out; asm volatile("" : "+s"(outi)); float* outp = (float*)(GAS float*)outi; bf16_t* XN = (bf16_t*)outp;
        auto conv_desc = [&](int l, int r) -> ConvDesc {
            const float* src; int K_, N_, kind; size_t off;
            if (r < R_GU2)      {             src = KIN(7)  + (size_t)l * D * 2 * DFF; K_ = D;   N_ = 2 * DFF; kind = 1; off = OFF_GU1; }
            else if (r < R_DN1) { r -= R_GU2; src = KIN(9)  + (size_t)l * D * 2 * DFF; K_ = D;   N_ = 2 * DFF; kind = 1; off = OFF_GU2; }
            else if (r < R_DN2) { r -= R_DN1; src = KIN(8)  + (size_t)l * DFF * D;     K_ = DFF; N_ = D;       kind = 0; off = OFF_DN1; }
            else if (r < R_IN)  { r -= R_DN2; src = KIN(10) + (size_t)l * DFF * D;     K_ = DFF; N_ = D;       kind = 0; off = OFF_DN2; }
            else if (r < R_OUT) { r -= R_IN;  src = KIN(11) + (size_t)l * D * NIN;     K_ = D;   N_ = NIN;     kind = 2; off = OFF_IN; }
            else                { r -= R_OUT; src = KIN(12) + (size_t)l * D * D;       K_ = D;   N_ = D;       kind = 0; off = OFF_OUT; }
            return ConvDesc{src, W + (size_t)l * W_LAYER + off, K_, N_, kind, r};
        };
        auto conv_range = [&](int l, int r0, int r1, int nb, int bi) {
            const int step = nb * NWAVES; int r = r0 + bi * NWAVES + wave; if (r >= r1) return;
            LAS float* scr = (LAS float*)(lds + wave * 16896);
            ConvDesc dc = conv_desc(l, r); f32x4 vc[16]; p0_load(dc, vc, lane);
            for (;;) {
                const int rn = r + step; const bool hn = rn < r1; ConvDesc dn = conv_desc(l, hn ? rn : r); f32x4 vn[16];
                if (hn) p0_load(dn, vn, lane);
                p0_finish(dc, vc, scr, lane);
                if (!hn) break;
#pragma unroll
                for (int i = 0; i < 16; ++i) vc[i] = vn[i];
                dc = dn; r = rn;
            }
        };
        auto sw_rows = [&](int l, int k, int nb, int bi) {
            const int N = (k == 1) ? NIN : 2 * DFF; const bf16_t* Wt = W + (size_t)l * W_LAYER + (k == 0 ? OFF_GU1 : k == 1 ? OFF_IN : OFF_GU2); float* SWp = (float*)(wsp + WS_SW) + (size_t)(l * 3 + k) * 4 * 5632;
            f32x4 sh[4][4];
#pragma unroll
            for (int b = 0; b < 4; ++b)
#pragma unroll
                for (int j = 0; j < 4; ++j) sh[b][j] = *(const f32x4*)(MOD + (size_t)l * 5 * NMODW + (size_t)b * NMODW + (3 * k) * D + lane * 16 + 4 * j);
            const int stride = nb * NWAVES;
            for (int p0 = bi * NWAVES + wave; p0 < N; p0 += 4 * stride) {
                int pr[4]; bool hv[4]; v4u w0[4], w1[4];
#pragma unroll
                for (int q = 0; q < 4; ++q) { pr[q] = p0 + q * stride; hv[q] = pr[q] < N; const int pc = hv[q] ? pr[q] : p0; w0[q] = *(const v4u*)(Wt + (size_t)pc * D + lane * 16); w1[q] = *(const v4u*)(Wt + (size_t)pc * D + lane * 16 + 8); }
                float a[4][4];
#pragma unroll
                for (int q = 0; q < 4; ++q) { const unsigned ww[8] = {w0[q].x, w0[q].y, w0[q].z, w0[q].w, w1[q].x, w1[q].y, w1[q].z, w1[q].w};
#pragma unroll
                    for (int b = 0; b < 4; ++b) a[q][b] = 0.f;
#pragma unroll
                    for (int j = 0; j < 8; ++j) { const float lo = __uint_as_float(ww[j] << 16), hi = __uint_as_float(ww[j] & 0xffff0000u);
#pragma unroll
                        for (int b = 0; b < 4; ++b) a[q][b] += lo * sh[b][j >> 1][(2 * j) & 3] + hi * sh[b][j >> 1][(2 * j + 1) & 3]; } }
#pragma unroll
                for (int q = 0; q < 4; ++q)
#pragma unroll
                    for (int b = 0; b < 4; ++b) { const float sa = wave_sum(a[q][b], lane); if (lane == 0 && hv[q]) SWp[(size_t)b * 5632 + pr[q]] = sa; }
            }
        };
        if (ph == PH_PRO) {
            const float* cc = KIN(1); const float* c_ctx = KIN(3); const float* w_ada = KIN(4); const float* b_ada = KIN(5);
            LAS float* sc = (LAS float*)lds; LAS float* red = (LAS float*)(lds + 20480);
            for (int i = tid; i < 5 * 1024; i += NWAVES * 64) { const int b = i >> 10, k = i & 1023; const float v = b < 4 ? cc[b * 1024 + k] : c_ctx[k]; sc[i] = v / (1.f + __expf(-v)); }
            __syncthreads();
            for (int item = bx; item < 288; item += G) {
                const int l = item / 144, col0 = (item % 144) * 64, cq = tid & 15, kg = tid >> 4;
                const float* wp = w_ada + (size_t)l * D * NMODW + (size_t)(kg * 32) * NMODW + col0 + 4 * cq;
                f32x4 a0 = {0, 0, 0, 0}, a1 = a0, a2 = a0, a3 = a0, a4 = a0;
#pragma unroll 8
                for (int k = 0; k < 32; ++k) { const f32x4 wv = *(const f32x4*)(wp + (size_t)k * NMODW); const int kk = kg * 32 + k;
                    a0 += wv * sc[kk]; a1 += wv * sc[1024 + kk]; a2 += wv * sc[2048 + kk]; a3 += wv * sc[3072 + kk]; a4 += wv * sc[4096 + kk]; }
                LAS f32x4* rp = (LAS f32x4*)(red + (size_t)kg * 320 + 4 * cq);
                rp[0] = a0; rp[16] = a1; rp[32] = a2; rp[48] = a3; rp[64] = a4;
                __syncthreads();
                if (tid < 320) { float s = 0.f;
#pragma unroll 8
                    for (int k = 0; k < 32; ++k) s += red[k * 320 + tid];
                    const int b = tid >> 6, cidx = tid & 63; MOD[(size_t)l * 5 * NMODW + (size_t)b * NMODW + col0 + cidx] = s + b_ada[l * NMODW + col0 + cidx]; }
                __syncthreads();
            }
            for (int i = (bx * NWAVES * 64 + tid); i < 2 * 65536; i += G * NWAVES * 64) {
                const int l = i >> 16, r = i & 65535; const int c = r & 63, d = (r >> 6) & 63, ri = (r >> 12) & 1, blk = (r >> 13) & 3, dir = r >> 15;
                const float* src = (ri ? KIN(17) : KIN(15)) + (size_t)l * 32768;
                W[(size_t)l * W_LAYER + OFF_LRU + r] = f2bf(src[((size_t)(dir * 4 + blk) * 64 + c) * 64 + d]);
            }
            conv_range(0, R_GU1, R_GU2, G, bx);
        } else if (ph == PH_FINAL) {
            const float* fg = KIN(23); const bf16_t* Hb = (const bf16_t*)(wsp + WS_H);
            for (int row = gw; row < ML; row += NGW) {
                const v4u w0 = *(const v4u*)(Hb + (size_t)row * D + lane * 16), w1 = *(const v4u*)(Hb + (size_t)row * D + lane * 16 + 8);
                const unsigned ww[8] = {w0.x, w0.y, w0.z, w0.w, w1.x, w1.y, w1.z, w1.w}; float v[16]; float sq = 0.f;
#pragma unroll
                for (int j = 0; j < 8; ++j) { v[2 * j] = __uint_as_float(ww[j] << 16); v[2 * j + 1] = __uint_as_float(ww[j] & 0xffff0000u); sq += v[2 * j] * v[2 * j] + v[2 * j + 1] * v[2 * j + 1]; }
                const float rstd = 1.0f / sqrtf(wave_sum(sq, lane) * (1.0f / D) + 1e-6f);
#pragma unroll
                for (int j = 0; j < 4; ++j) { const f32x4 g4 = *(const f32x4*)(fg + lane * 16 + 4 * j); f32x4 o; o.x = v[4 * j] * rstd * g4.x; o.y = v[4 * j + 1] * rstd * g4.y; o.z = v[4 * j + 2] * rstd * g4.z; o.w = v[4 * j + 3] * rstd * g4.w;
                    *(f32x4*)(outp + (size_t)row * D + lane * 16 + 4 * j) = o; }
            }
        } else if (ph == PH_PRO2) {
            float* GS = (float*)(wsp + WS_GS); float* SW = (float*)(wsp + WS_SW); float* SSQ = (float*)(wsp + WS_SSQ);
            for (int i = bx * NWAVES * 64 + tid; i < 2 * 3 * 5 * D; i += G * NWAVES * 64) { const int c = i & 1023, b = (i >> 10) % 5, k = ((i >> 10) / 5) % 3, l = (i >> 10) / 15;
                GS[i] = KIN(6)[(size_t)(l * 3 + k) * D + c] * (1.0f + MOD[(size_t)l * 5 * NMODW + (size_t)b * NMODW + (3 * k + 1) * D + c]); }
            sw_rows(0, 0, G, bx);
            { const float* x = KIN(0); const float* ctxp = KIN(2); const float* g0 = KIN(6);
              f32x4 g0v[4];
#pragma unroll
              for (int j = 0; j < 4; ++j) g0v[j] = *(const f32x4*)(g0 + (lane + 64 * j) * 4);
              f32x4 vc[4], scc[4]; int row = gw;
#define P2_LD(r_, v_, s_) do { const f32x4* xr_ = (const f32x4*)(x + (size_t)(r_) * D) + lane; const float* sc_ = MOD + (size_t)((r_) >> 12) * NMODW + D; \
                  _Pragma("unroll") for (int j = 0; j < 4; ++j) { (v_)[j] = xr_[64 * j]; (s_)[j] = *(const f32x4*)(sc_ + (lane + 64 * j) * 4); } } while (0)
              if (row < ML) P2_LD(row, vc, scc);
              while (row < ML) { const int rn = row + NGW; f32x4 vn[4], scn[4];
                  if (rn < ML) P2_LD(rn, vn, scn);
                  float s = 0.f;
                  unsigned long long* o8 = (unsigned long long*)(XN + (size_t)row * D) + lane; unsigned long long* h8 = (unsigned long long*)((bf16_t*)H + (size_t)row * D) + lane;
#pragma unroll
                  for (int j = 0; j < 4; ++j) { const f32x4 v = vc[j]; s += (v.x * v.x + v.y * v.y) + (v.z * v.z + v.w * v.w);
                      h8[64 * j] = (unsigned long long)pk2(v.x, v.y) | ((unsigned long long)pk2(v.z, v.w) << 32);
                      const f32x4 y = v * g0v[j] * (scc[j] + 1.0f); o8[64 * j] = (unsigned long long)pk2(y.x, y.y) | ((unsigned long long)pk2(y.z, y.w) << 32); }
                  s = wave_sum(s, lane); if (lane == 0) *(f32x4*)(SSQ + (size_t)row * 4) = (f32x4){s, 0.f, 0.f, 0.f};
#pragma unroll
                  for (int j = 0; j < 4; ++j) { vc[j] = vn[j]; scc[j] = scn[j]; }
                  row = rn; }
#undef P2_LD
              for (int rowc = ML + gw; rowc < M; rowc += NGW) { const float* src = ctxp + (size_t)(rowc - ML) * D; const float* shift = MOD + (size_t)4 * NMODW;
                    norm_row(src, g0, shift, shift + D, XN + (size_t)rowc * D, lane);
#pragma unroll
                    for (int j = 0; j < 4; ++j) ((f32x4*)(H + (size_t)rowc * D))[lane + 64 * j] = ((const f32x4*)src)[lane + 64 * j]; }
            }
        } else {
            const int l = (ph - PH_L0) / PH_PER_LAYER, ty = (ph - PH_L0) % PH_PER_LAYER; const bool last = (l == 1);
            if (last && (ty == T_NC2 || ty == T_NC3)) return;
            bf16_t* Wl = W + (size_t)l * W_LAYER; const float* MODl = MOD + (size_t)l * 5 * NMODW;
            float* SSQ = (float*)(wsp + WS_SSQ); const float* GS = (const float*)(wsp + WS_GS); const float* SW = (const float*)(wsp + WS_SW);
            const int mrows = (last && ty >= T_OUT) ? ML : M;
            if (ty == T_NC1 || ty == T_NC2 || ty == T_NC3) {
                const int kk = (ty == T_NC1) ? 1 : (ty == T_NC2) ? 2 : 0, ln = (ty == T_NC3) ? l + 1 : l;
                const float* shift = MOD + (size_t)ln * 5 * NMODW + (size_t)4 * NMODW + (3 * kk) * D; const float* ngn = KIN(6) + (size_t)(ln * 3 + kk) * D;
                const int ns = (ty == T_NC2) ? 4 : 11;
                for (int row = ML + gw; row < M; row += NGW) {
                    f32x4* hr = (f32x4*)(H + (size_t)row * D) + lane; f32x4 v[4];
#pragma unroll
                    for (int j = 0; j < 4; ++j) v[j] = hr[64 * j];
#define NC_ALL(cnt_) do { typedef unsigned u32x2n __attribute__((ext_vector_type(2))); u32x2n w_[cnt_][4]; \
                        _Pragma("unroll") for (int q_ = 0; q_ < (cnt_); ++q_) { const u32x2n* sp = (const u32x2n*)((const bf16_t*)pg8::slab_ptr(wsi, outi, q_) + (size_t)(row - ML) * D) + lane; \
                            _Pragma("unroll") for (int j = 0; j < 4; ++j) w_[q_][j] = sp[64 * j]; } \
                        _Pragma("unroll") for (int q_ = 0; q_ < (cnt_); ++q_) _Pragma("unroll") for (int j = 0; j < 4; ++j) { const u32x2n t_ = w_[q_][j]; \
                            v[j] += (f32x4){__uint_as_float(t_.x << 16), __uint_as_float(t_.x & 0xffff0000u), __uint_as_float(t_.y << 16), __uint_as_float(t_.y & 0xffff0000u)}; } } while (0)
                    if (ns == 11) { NC_ALL(11); } else { NC_ALL(4); }
#undef NC_ALL
                    norm_regs(v, ngn, shift, shift + D, XN + (size_t)row * D, lane);
#pragma unroll
                    for (int j = 0; j < 4; ++j) hr[64 * j] = v[j];
                }
            } else if (ty == T_GU1 || ty == T_GU2) {
                pg8::Gemm g{XN, Wl + (ty == T_GU1 ? OFF_GU1 : OFF_GU2), mrows, 2 * DFF, D, D}; pg8::StaticOrder So; So.init(mrows, 2 * DFF, G, bx);
                pg8::EpiGU E{pg8::EpiCtx{wsi, outi, kin, l, ty}};
                pg8::gemm_phase<pg8::EpiGU, pg8::StaticOrder, true, true>(lds + RING_OFF, g, So, E, tidq());
                if (bx >= 216) {
                    const int bi = bx - 216;
                    if (l == 0 && ty == T_GU1) { conv_range(0, R_DN1, R_DN2, 40, bi); conv_range(0, R_IN, R_OUT, 40, bi); }
                    if (l == 0 && ty == T_GU2) { conv_range(1, R_GU1, R_GU2, 40, bi); }
                    if (l == 1 && ty == T_GU1) { conv_range(1, R_DN1, R_DN2, 40, bi); conv_range(1, R_IN, R_OUT, 40, bi); }
                }
            } else if (ty == T_DN1 || ty == T_DN2 || ty == T_OUT) {
                const bf16_t* A = (ty == T_OUT) ? Y : HB; const int K = (ty == T_OUT) ? D : DFF;
                const bf16_t* Bt = Wl + (ty == T_DN1 ? OFF_DN1 : ty == T_DN2 ? OFF_DN2 : OFF_OUT);
                {
                    pg8::Gemm g{A, Bt, M, D, K, K}; pg8::DnOrder So; So.so.init(ML, D, G, bx); So.ns = (mrows == M) ? K / 256 : 0; So.KS = 256; So.ntl = K / 64;
                    pg8::EpiDn E{pg8::EpiRes{pg8::EpiCtx{wsi, outi, kin, l, ty}, (LAS float*)(lds + EPI_OFF)}, pg8::EpiResAt{pg8::EpiCtx{wsi, outi, kin, l, ty}}};
                    pg8::gemm_phase<pg8::EpiDn, pg8::DnOrder, true, true>(lds + RING_OFF, g, So, E, tidq());
                }
                if (ty == T_DN1 && bx < 80)  { sw_rows(l, 1, 80, bx); conv_range(l, R_OUT, I_LAYER, 80, bx); }
                if (l == 0 && ty == T_OUT && bx < 192) { sw_rows(0, 2, 192, bx); sw_rows(1, 2, 192, bx); }
                if (l == 0 && ty == T_DN2 && bx < 80)  { sw_rows(1, 0, 80, bx); }
            } else if (ty == T_IN) {
                pg8::Gemm g{XN, Wl + OFF_IN, M, NIN, D, D}; pg8::StaticOrder So; So.init(M, NIN, G, bx);
                { const int tq = tidq(); *(LAS f32x4*)(lds + RING_OFF + pg8::STAGE_BYTES + 10240 + tq * 16) = *((const f32x4*)T->cosv + tq); asm volatile("s_waitcnt vmcnt(0) lgkmcnt(0)" ::: "memory"); __syncthreads(); }
                pg8::EpiIN E{pg8::EpiCtx{wsi, outi, kin, l, ty}, (const LAS float*)(lds + RING_OFF + pg8::STAGE_BYTES + 10240)};
                pg8::gemm_phase<pg8::EpiIN, pg8::StaticOrder, true, true>(lds + RING_OFF, g, So, E, tidq());
                if (bx >= 168) {
                    const int bi = bx - 168; if (l == 0) conv_range(0, R_GU2, R_DN1, 88, bi); conv_range(l, R_DN2, R_IN, 88, bi);
                }
            } else if (ty == T_M2) {
                return;
            } else if (ty == T_M1) {
              const float* cw = KIN(13) + (size_t)l * 1024; const float* cb = KIN(14) + (size_t)l * 256; const float* lbr = KIN(16) + (size_t)l * 512; const float* lbi = KIN(18) + (size_t)l * 512;
              float* SUMM = (float*)(wsp + WS_SUMM); unsigned* PH = (unsigned*)outp;
              gu32* lcnt = (gu32*)(wsp + WS_CTL) + 2048 + 64 * l;
              { unsigned nloc = 0;
                for (int u = vcu; u < 288; u += G) { int b, ck, mode; if (u < 256) { b = u >> 6; ck = 4 + (u & 63); mode = 0; } else { const int i2 = u - 256; b = i2 >> 3; ck = (i2 >> 1) & 3; mode = 1 + (i2 & 1); }
                    int tq = tid; asm volatile("" : "+v"(tq));
                    lru::lru_unit<false>(lds, PROJ, Y, Wl + OFF_LRU, cw, cb, lbr, lbi, T->lruc + l * 512, SUMM, PH, b, ck, mode, tq); ++nloc; }
                asm volatile("s_waitcnt vmcnt(0)" ::: "memory"); __syncthreads();
                if (wave == 0 && lane == 0) { __builtin_amdgcn_fence(__ATOMIC_RELEASE, "agent"); asm volatile("s_waitcnt vmcnt(0)" ::: "memory"); __hip_atomic_fetch_add(lcnt, nloc, __ATOMIC_RELAXED, __HIP_MEMORY_SCOPE_AGENT); }
              }
              {
                const float* sink = KIN(20) + l * 4;
                {
                    const int idx = vcu, b = idx >> 6, kvh = (idx >> 5) & 1, q0 = 128 * (idx & 31), g = wave >> 2, head = 2 * kvh + g;
                    att::TileSeq ts; ts.b = b; ts.mode = 1; ts.q0 = q0; ts.jlo = (q0 == 0) ? 2 : 0; { const int jh = (S - q0 + 128) / 64; ts.nt = 4 + ((jh < 6) ? jh : 6) - ts.jlo; }
                    { int tq = tid; asm volatile("" : "+v"(tq)); att::attn_unit<1, 2, 3, false>(lds, PROJ, Y, ts, b * S + q0 + 32 * (wave & 3), 512 + 64 * head, 768 + 64 * kvh, 896 + 64 * kvh, 256 + 64 * head, q0 + 32 * (wave & 3), sink[head] * LOG2E, 0.f, nullptr, 0.f, tq); }
                }
                if (!last && vcu >= 32 && vcu < 48) {
                    const int idx = vcu - 32, b = idx >> 2, kvh = (idx >> 1) & 1, qb = idx & 1, g = wave >> 2, head = 2 * kvh + g;
                    att::TileSeq ts; ts.b = b; ts.mode = 2; ts.q0 = 0; ts.jlo = 0; ts.nt = 4;
                    { int tq = tid; asm volatile("" : "+v"(tq)); att::attn_unit<1, 2, 3, false>(lds, PROJ, Y, ts, ML + b * LC + 128 * qb + 32 * (wave & 3), 512 + 64 * head, 768 + 64 * kvh, 896 + 64 * kvh, 256 + 64 * head, 0, sink[head] * LOG2E, 0.f, nullptr, 0.f, tq); }
                }
              }
              {
                const float lam = T->lam[l]; const float* subg = KIN(22) + l * 128; const float oml = 1.0f - (0.8f - 0.6f * __expf(-0.3f * (float)l));
                {
                    const int idx = vcu, b = idx >> 6, h = (idx >> 4) & 3, q0 = 256 * (idx & 15);
                    att::TileSeq ts; ts.b = b; ts.mode = 0; ts.q0 = 0; ts.jlo = 0; ts.nt = 68;
                    { int tq = tid; asm volatile("" : "+v"(tq)); att::attn_unit_pp<2, 4>(lds, PROJ, Y, ts, b * S + q0 + 32 * wave, 1024 + 128 * h, 1536 + 128 * h, 2048 + 128 * h, 512 + 128 * h, lam, subg, oml, tq); }
                }
                if (!last && vcu >= 48 && vcu < 64) {
                    const int idx = vcu - 48, b = idx >> 2, h = idx & 3;
                    att::TileSeq ts; ts.b = b; ts.mode = 2; ts.q0 = 0; ts.jlo = 0; ts.nt = 4;
                    { int tq = tid; asm volatile("" : "+v"(tq)); att::attn_unit_pp<2, 4>(lds, PROJ, Y, ts, ML + b * LC + 32 * wave, 1024 + 128 * h, 1536 + 128 * h, 2048 + 128 * h, 512 + 128 * h, lam, subg, oml, tq); }
                }
              }
              if (wave == 0) {
                  if (lane == 0) { unsigned spins = 0; while (__hip_atomic_load(lcnt, __ATOMIC_RELAXED, __HIP_MEMORY_SCOPE_AGENT) < 288u) { __builtin_amdgcn_s_sleep(8); if (++spins > (1u << 20)) break; } }
                  __builtin_amdgcn_fence(__ATOMIC_ACQUIRE, "agent"); asm volatile("s_waitcnt vmcnt(0)" ::: "memory");
              }
              __syncthreads();
              for (int u = vcu; u < 272; u += G) { const int b = u / 68, ck = u % 68; int tq = tid; asm volatile("" : "+v"(tq));
                  if (!(last && ck < 4)) lru::lru_final_unit(lds, PROJ, Y, SUMM, PH, b, ck, tq); }
              if (l == 0 && vcu >= 64) { __syncthreads(); conv_range(1, R_GU2, R_DN1, 192, vcu - 64); }
            }
        }
    if (PHI + 1 < kc.ph_end) xcd_barrier(kc.bar);
}
template <int... I> __device__ __forceinline__ void run_all(const KCtx& kc, std::integer_sequence<int, I...>) { (run_phase<I>(kc), ...); }

__global__ void __launch_bounds__(NWAVES * 64, 2) mk_fwd(Args args) {
    extern __shared__ __attribute__((aligned(16))) unsigned char lds_raw[];
    LAS unsigned char* lds = (LAS unsigned char*)lds_raw;
    volatile LAS unsigned* MISC = (volatile LAS unsigned*)(lds + MISC_OFF);
    const int tid0 = threadIdx.x; const int wave0 = __builtin_amdgcn_readfirstlane(tid0 >> 6);
    const int G = gridDim.x; const int bx = blockIdx.x; const int vcu = (G % 8 == 0) ? (bx % 8) * (G / 8) + bx / 8 : bx;
    unsigned char* ws = args.ws;
    gu32* ctl = (gu32*)(ws + WS_CTL);
    for (int u = tid0; u < (LDS_BYTES - LDSCTL_OFF) / 4; u += NWAVES * 64) ((LAS unsigned*)(lds + LDSCTL_OFF))[u] = 0u;
    __syncthreads();
    XcdBarrier bar = xcd_barrier_post((unsigned*)(ctl + CW_BAR) + args.li * XCD_BAR_WORDS, MISC + 8);

    const __attribute__((address_space(4))) unsigned long long* kin = (const __attribute__((address_space(4))) unsigned long long*)__builtin_amdgcn_kernarg_segment_ptr();
    const int NGW = G * NWAVES;

    if (args.ph_lo == PH_PRO && bx == 0) {
                const int tid = tid0; Tab* T = (Tab*)(ws + WS_TAB); const int kz = 0;
                const float* lru_lambda = KIN(19); const float* diff_lambda = KIN(21);
                for (int i = tid; i < 1024; i += NWAVES * 64) {
                    const int pos = i >> 4, f = i & 15;
                    const double q[4] = {1.0, 0.5623413251903491, 0.31622776601683794, 0.1778279410038923};
                    double inv = (f & 3) == 0 ? q[0] : (f & 3) == 1 ? q[1] : (f & 3) == 2 ? q[2] : q[3]; for (int j = 0; j < (f >> 2); ++j) inv *= 0.1;
                    const float ang = (float)pos * (float)inv;
                    double xx = (double)ang; const double TWO_PI = 6.283185307179586476925287, PI = 3.141592653589793238462643;
                    const double k = rint(xx * 0.15915494309189533577); double r = xx - k * TWO_PI;
                    double sgn = 1.0; if (r > PI * 0.5) { r = PI - r; sgn = -1.0; } else if (r < -PI * 0.5) { r = -PI - r; sgn = -1.0; }
                    const double r2 = r * r;
                    double ss = -1.9572941063391263e-20; ss = ss * r2 + 8.2206352466243295e-18; ss = ss * r2 - 2.8114572543455206e-15; ss = ss * r2 + 7.6471637318198164e-13; ss = ss * r2 - 1.6059043836821613e-10;
                    ss = ss * r2 + 2.5052108385441720e-08; ss = ss * r2 - 2.7557319223985893e-06; ss = ss * r2 + 1.9841269841269841e-04; ss = ss * r2 - 8.3333333333333332e-03; ss = ss * r2 + 1.6666666666666666e-01; ss = r - r * r2 * ss;
                    double cs = 4.1103176233121648e-19; cs = cs * r2 - 1.5619206968586226e-16; cs = cs * r2 + 4.7794773323873853e-14; cs = cs * r2 - 1.1470745597729725e-11; cs = cs * r2 + 2.0876756987868100e-09;
                    cs = cs * r2 - 2.7557319223985888e-07; cs = cs * r2 + 2.4801587301587302e-05; cs = cs * r2 - 1.3888888888888889e-03; cs = cs * r2 + 4.1666666666666664e-02; cs = cs * r2 - 0.5; cs = cs * r2 + 1.0;
                    T->cosv[i] = (float)(sgn * cs); T->sinv[i] = (float)ss;
                    T->lruc[i] = -8.0f * log1pf(expf(-lru_lambda[i]));
                }
                if (tid < 2) { const float* dl = diff_lambda + tid * 256; float s0 = 0.f, s1 = 0.f;
                    for (int j = 0; j < 64; ++j) { s0 += dl[j] * dl[64 + j]; s1 += dl[128 + j] * dl[192 + j]; }
                    T->lam[tid] = expf(s0) - expf(s1) + (0.8f - 0.6f * expf(-0.3f * (float)tid)); }
            }
    KCtx kc; kc.lds = lds; kc.ws = ws; kc.out = args.out; kc.kin = kin; kc.wave0 = wave0; kc.vcu = vcu; kc.G = G; kc.bx = bx; kc.ph_lo = args.ph_lo; kc.ph_end = args.ph_hi + (MK_REPEAT_PH >= 0 ? 1 : 0); kc.bar = bar;
    run_all(kc, std::make_integer_sequence<int, NPH + (MK_REPEAT_PH >= 0 ? 1 : 0)>{});
}

static void launch_seg(const Args& base, int lo, int hi, int& li, int grid, hipStream_t stream) {
    Args a = base; a.ph_lo = lo; a.ph_hi = hi; a.li = li++; a.rep = 0;
    void* kargs[] = {&a};
    hipError_t e = hipLaunchCooperativeKernel((const void*)mk_fwd, dim3(grid), dim3(NWAVES * 64), kargs, LDS_BYTES, stream);
    if (e != hipSuccess) fprintf(stderr, "kernel_launch: cooperative launch failed: %s (grid %d)\n", hipGetErrorString(e), grid);
}
extern "C" void kernel_launch(void* const* d_in, const int* in_sizes, int n_in, void* d_out, int out_size, void* d_ws, size_t ws_size, hipStream_t stream) {
    static int grid = 0;
    if (grid == 0) {
        if (n_in != 24 || ws_size < WS_END || out_size != ML * D) { fprintf(stderr, "kernel_launch: unexpected shapes (n_in %d, ws %zu need %zu, out %d)\n", n_in, ws_size, (size_t)WS_END, out_size); grid = -1; return; }
        int dev = 0, cus = 0, per_cu = 0;
        hipGetDevice(&dev); hipDeviceGetAttribute(&cus, hipDeviceAttributeMultiprocessorCount, dev);
        if (hipFuncSetAttribute((const void*)mk_fwd, hipFuncAttributeMaxDynamicSharedMemorySize, LDS_BYTES) != hipSuccess) { fprintf(stderr, "kernel_launch: hipFuncSetAttribute failed\n"); grid = -1; return; }
        if (hipOccupancyMaxActiveBlocksPerMultiprocessor(&per_cu, (const void*)mk_fwd, NWAVES * 64, LDS_BYTES) != hipSuccess || per_cu < 1) { fprintf(stderr, "kernel_launch: occupancy query says %d blocks per CU\n", per_cu); grid = -1; return; }
        (void)hipGetLastError();
        if (cus != 256) { fprintf(stderr, "kernel_launch: built for a 256-CU device (one workgroup per CU; the unit maps of the mixer phases assume it); found %d CUs; nothing launched\n", cus); grid = -1; return; }
        grid = cus;
    }
    if (grid < 0) return;
    hipMemsetAsync((char*)d_ws + WS_CTL, 0, 1u << 20, stream);
    Args a{};
    for (int i = 0; i < 24; ++i) a.in[i] = (const float*)d_in[i];
    a.out = (float*)d_out; a.ws = (unsigned char*)d_ws;
    int li = 0, lo = 0;
    launch_seg(a, lo, NPH, li, grid, stream);
}
```

```cpp
#include <hip/hip_runtime.h>
#include <cstdio>
#include <cstdint>
#include <cmath>

typedef unsigned short bf16_t;
constexpr int D = 1024, NB = 4, S = 4096, LC = 256, DFF = 2816, NIN = 2560;
constexpr int ML = NB * S, MC = NB * LC, M = ML + MC;
constexpr int NMODW = 9 * D;
constexpr float C2 = 0.125f * 1.4426950408889634f;
constexpr float LOG2E = 1.4426950408889634f;

__device__ __forceinline__ float bf2f(bf16_t v) { return __uint_as_float((unsigned)v << 16); }
__device__ __forceinline__ bf16_t f2bf(float f) { unsigned u = __float_as_uint(f); return (bf16_t)((u + 0x7fffu + ((u >> 16) & 1u)) >> 16); }
__device__ __forceinline__ unsigned cvtpk2(float lo, float hi) { typedef float f2_t __attribute__((ext_vector_type(2))); typedef __bf16 b2_t __attribute__((ext_vector_type(2))); f2_t v = {lo, hi}; b2_t b = __builtin_convertvector(v, b2_t); return __builtin_bit_cast(unsigned, b); }
__device__ __forceinline__ int bidx(int row) { return row < ML ? (row >> 12) : 4; }
__device__ __forceinline__ float silu_f(float x) { return x / (1.f + __expf(-x)); }
__device__ __forceinline__ float gelu_tanh_f(float x) { const float u = 0.7978845608028654f * (x + 0.044715f * x * x * x); return 0.5f * x * (1.f + tanhf(u)); }
__device__ __forceinline__ float sigmoid_f(float x) { return 1.f / (1.f + __expf(-x)); }

constexpr size_t MiB = 1u << 20;
constexpr size_t WS_CTL = 0;
constexpr size_t WS_MOD = 1 * MiB;
constexpr size_t WS_TAB = WS_MOD + 512 * 1024;
constexpr size_t WS_SUMM = 2 * MiB;
constexpr size_t WS_SSQ = 3 * MiB + 256 * 1024;
constexpr size_t WS_GS = 3 * MiB + 512 * 1024;
constexpr size_t WS_SW = 3 * MiB + 768 * 1024;
constexpr size_t WS_W = 5 * MiB;
constexpr size_t W_GU = (size_t)2 * DFF * D, W_DN = (size_t)D * DFF, W_IN = (size_t)NIN * D, W_OUT = (size_t)D * D, W_LRU = 2 * 4 * 2 * 64 * 64;
constexpr size_t W_LAYER = 2 * W_GU + 2 * W_DN + W_IN + W_OUT + W_LRU;
constexpr size_t OFF_GU1 = 0, OFF_DN1 = OFF_GU1 + W_GU, OFF_IN = OFF_DN1 + W_DN, OFF_OUT = OFF_IN + W_IN, OFF_GU2 = OFF_OUT + W_OUT, OFF_DN2 = OFF_GU2 + W_GU, OFF_LRU = OFF_DN2 + W_DN;
constexpr size_t WS_H = WS_W + ((2 * W_LAYER * 2 + MiB - 1) / MiB) * MiB;
constexpr size_t WS_R = WS_H + (((size_t)M * D * 4 + MiB - 1) / MiB) * MiB;
constexpr size_t R_PROJ = 0, R_Y = (size_t)M * NIN * 2, R_BYTES = (size_t)M * NIN * 2 + (size_t)M * D * 2;
constexpr size_t WS_NAIVE = WS_R + ((R_BYTES + MiB - 1) / MiB) * MiB;
constexpr size_t WS_END = WS_NAIVE + (size_t)M * 256 * 4;

enum { T_GU1 = 0, T_DN1, T_NC1, T_IN, T_M1, T_M2, T_OUT, T_NC2, T_GU2, T_DN2, T_NC3 };
struct Tab { float cosv[1024]; float sinv[1024]; float lam[2]; float pad[2]; float lruc[2 * 2 * 256]; };

__device__ __forceinline__ int dest_row(int kind, int n) {
    if (kind == 1) { const int s = n >= DFF ? 1 : 0, j = n - s * DFF; return 256 * (j >> 7) + 128 * s + (j & 127); }
    if (kind == 2) {
        const int pn = n >> 8, w = n & 255;
        if (pn == 2 || (pn >= 4 && pn <= 7)) { const int hh = w >> 6, x = (w >> 5) & 1, i = w & 31; return 256 * pn + 128 * x + 32 * hh + i; }
        if (pn == 3) { if (w < 128) { const int hh = w >> 6, x = (w >> 5) & 1, i = w & 31; return 768 + 128 * x + 32 * hh + i; } const int v = w - 128; return 768 + 128 * (v >> 6) + 64 + (v & 63); }
        return n;
    }
    return n;
}
__host__ __device__ __forceinline__ size_t wt_off(int n, int k, int K) { return ((size_t)(n >> 4) * (K >> 5) + (k >> 5)) * 512 + (n & 15) * 32 + (k & 31); }
#define XL_ROR_ADD(v_, c_) ((v_) + __int_as_float(__builtin_amdgcn_update_dpp(0, __float_as_int(v_), (c_), 0xF, 0xF, true)))
__device__ __forceinline__ float xl_row16_sum(float v) { v = XL_ROR_ADD(v, 0x121); v = XL_ROR_ADD(v, 0x122); v = XL_ROR_ADD(v, 0x124); v = XL_ROR_ADD(v, 0x128); return v; }
__device__ __forceinline__ float xl_x16_sum(float v) { auto rr = __builtin_amdgcn_permlane16_swap(__float_as_uint(v), __float_as_uint(v), false, false); return __uint_as_float(rr[0]) + __uint_as_float(rr[1]); }
__device__ __forceinline__ float xl_x32_sum(float v) { auto rr = __builtin_amdgcn_permlane32_swap(__float_as_uint(v), __float_as_uint(v), false, false); return __uint_as_float(rr[0]) + __uint_as_float(rr[1]); }
namespace pg8 {
#define PG8_LAS __attribute__((address_space(3)))
typedef unsigned short bf16_t;
typedef short bf16x8 __attribute__((ext_vector_type(8)));
typedef float f32x4 __attribute__((ext_vector_type(4)));
typedef unsigned u32x4 __attribute__((ext_vector_type(4)));
constexpr int BM = 256, BK = 64, HALF = 128, HTB = HALF * BK * 2  , STAGE_BYTES = 8 * HTB, NXCD = 8, WGM = 4;

__host__ __device__ __forceinline__ int lds_byte(int r, int c) { const int st = (r >> 4) * 2 + (c >> 5), rr = r & 15, cc = c & 31, ob = rr * 64 + cc * 2; return st * 1024 + (ob ^ (((ob >> 9) & 1) << 5)); }
__host__ __device__ __forceinline__ void stage_rc(int b, int& R, int& C) { const int st = b / 1024, sb = b % 1024, swz = sb ^ (((sb >> 9) & 1) << 5); R = (st >> 1) * 16 + swz / 64; C = (st & 1) * 32 + (swz % 64) / 2; }
__host__ __device__ __forceinline__ int perm32(int rho) { const int n = rho >> 4, i = rho & 15; return 8 * (i >> 2) + 4 * n + (i & 3); }

struct Unit { int pm, pn, ko, nt; };
struct Gemm { const bf16_t* A; const bf16_t* Bt; int M, N, K, ld, tiledA; };

struct StaticOrder {
    static constexpr bool VAR_NT = false;
    int nM, nN, nwg, G, c;
    __host__ __device__ void init(int M, int N, int G_, int c_) { nM = M / BM; nN = N / BM; nwg = nM * nN; G = G_; c = c_; }
    __host__ __device__ bool next(int i, Unit& u) const {
        const long L = (long)i * G + c; if (L >= nwg) return false;
        int wgid = (int)L; { const int q = nwg / NXCD, r = nwg % NXCD, xcd = wgid % NXCD, off = wgid / NXCD; wgid = (xcd < r ? xcd * (q + 1) : r * (q + 1) + (xcd - r) * q) + off; }
        const int nig = WGM * nN, gid = wgid / nig, fm = gid * WGM, gsz = (nM - fm) < WGM ? (nM - fm) : WGM;
        u.pm = fm + ((wgid % nig) % gsz); u.pn = (wgid % nig) / gsz; u.ko = 0; return true;
    }
    __device__ __forceinline__ void a_ready(const Unit&) const {}
    __device__ __forceinline__ void done(const Unit&) const {}
};
struct SliceOrder {
    static constexpr bool VAR_NT = false;
    int ns, KS, G, c;
    __host__ __device__ bool next(int i, Unit& u) const { const int L = i * G + (G - 1 - c); if (L >= 16 * ns) return false; const int tile = L / ns, sl = L % ns; u.pm = 64 + (tile >> 2); u.pn = tile & 3; u.ko = sl * KS; return true; }
    __device__ __forceinline__ void a_ready(const Unit&) const {}
    __device__ __forceinline__ void done(const Unit&) const {}
};

struct DnOrder {
    static constexpr bool VAR_NT = true;
    StaticOrder so; int ns, KS, ntl;
    __host__ __device__ bool next(int i, Unit& u) const {
        const int Ls = so.G - 1 - so.c; const bool hs = Ls < 16 * ns;
        if (hs && i == 0) { const int tile = Ls / ns, sl = Ls % ns; u.pm = 64 + (tile >> 2); u.pn = tile & 3; u.ko = sl * KS; u.nt = KS / BK; return true; }
        if (!so.next(hs ? i - 1 : i, u)) return false;
        u.nt = ntl; return true;
    }
    __device__ __forceinline__ void a_ready(const Unit&) const {}
    __device__ __forceinline__ void done(const Unit&) const {}
};

__device__ __forceinline__ unsigned cvt_pk_bf16(float lo, float hi) { unsigned r; asm volatile("v_cvt_pk_bf16_f32 %0, %1, %2" : "=v"(r) : "v"(lo), "v"(hi)); return r; }
__device__ __forceinline__ float fast_silu(float x) { return x * __builtin_amdgcn_rcpf(1.0f + __builtin_amdgcn_exp2f(-1.4426950408889634f * x)); }
__device__ __forceinline__ float fast_gelu_tanh(float x) {
    const float u = 0.7978845608028654f * (x + 0.044715f * x * x * x);
    return x * __builtin_amdgcn_rcpf(1.0f + __builtin_amdgcn_exp2f(-2.0f * 1.4426950408889634f * u));
}
struct EpiCtx { unsigned long long wsi, outi; const __attribute__((address_space(4))) unsigned long long* kin; int l, ty; };
#define PG8_GAS __attribute__((address_space(1)))
__device__ __forceinline__ unsigned char* ectx_ws(const EpiCtx& c) { return (unsigned char*)(PG8_GAS unsigned char*)c.wsi; }
__device__ __forceinline__ const float* ectx_in(const EpiCtx& c, int i) { return (const float*)(const PG8_GAS float*)(c.kin[i]); }
__device__ __forceinline__ int hw_lane() { unsigned z = 0u; asm volatile("" : "+v"(z)); return (int)__builtin_amdgcn_mbcnt_hi(~0u, __builtin_amdgcn_mbcnt_lo(~0u, z)); }
__device__ __forceinline__ void epi_stage_params(PG8_LAS unsigned char* par, const float* ssq_tile, const float* sw_tile, int wid, int) {
    const int lane = hw_lane();
    if (wid < 4) __builtin_amdgcn_global_load_lds((const unsigned*)(ssq_tile + (size_t)(wid * 64 + lane) * 4), (PG8_LAS unsigned*)(par + wid * 1024), 16, 0, 0);
    else if (wid == 4) __builtin_amdgcn_global_load_lds((const unsigned*)(sw_tile + lane * 4), (PG8_LAS unsigned*)(par + 4096), 16, 0, 0);
}
struct EpiGU {
    static constexpr bool PERM = true, AFTER_DRAIN = false, PARAMS = true, LOOSE = true; static constexpr int NST = 8;
    EpiCtx cx;
    __device__ __forceinline__ void stage(PG8_LAS unsigned char* par, const Unit& u, int wid, int lane) const {
        if (u.pm >= 64) return;
        unsigned char* wsb = ectx_ws(cx);
        epi_stage_params(par, (const float*)(wsb + WS_SSQ) + (size_t)u.pm * BM * 4, (const float*)(wsb + WS_SW) + (size_t)(cx.l * 3 + (cx.ty == T_GU1 ? 0 : 2)) * 4 * 5632 + (size_t)(u.pm >> 4) * 5632 + u.pn * 256, wid, lane);
    }
    __device__ __forceinline__ void operator()(const f32x4 (&acc)[2][2][4][2], const Unit& u, int wr, int wc, int fr_in, int fq_in, const PG8_LAS unsigned char* par) const {
        const int ln_ = hw_lane(); const int fr = ln_ & 15, fq = ln_ >> 4;
        unsigned char* wsb = ectx_ws(cx); bf16_t* HB = (bf16_t*)(wsb + WS_R);
        const int row0 = u.pm * BM + wr * 64 + fr, col0 = u.pn * 128 + wc * 32 + 8 * fq; const bool lat = u.pm < 64;
        float rs[2][4];
        { f32x4 sq[2][4];
#pragma unroll
          for (int ai = 0; ai < 2; ++ai)
#pragma unroll
            for (int m = 0; m < 4; ++m) sq[ai][m] = *(const PG8_LAS f32x4*)(par + (wr * 64 + fr + ai * HALF + m * 16) * 16);
#pragma unroll
          for (int ai = 0; ai < 2; ++ai)
#pragma unroll
            for (int m = 0; m < 4; ++m) rs[ai][m] = lat ? __builtin_amdgcn_rsqf(((sq[ai][m][0] + sq[ai][m][1]) + (sq[ai][m][2] + sq[ai][m][3])) * (1.0f / 1024.0f) + 1e-6f) : 1.0f; }
        f32x4 sv[2][2];
#pragma unroll
        for (int bj = 0; bj < 2; ++bj)
#pragma unroll
            for (int n = 0; n < 2; ++n) { const f32x4 t = *(const PG8_LAS f32x4*)(par + 4096 + (bj * 128 + wc * 32 + 8 * fq + 4 * n) * 4); sv[bj][n] = lat ? t : (f32x4){0.f, 0.f, 0.f, 0.f}; }
        f32x4 svg[2], svu[2];
#pragma unroll
        for (int n = 0; n < 2; ++n) { svg[n] = sv[0][n] * -1.4426950408889634f; svu[n] = sv[1][n] * -0.6931471805599453f; }
#pragma unroll
        for (int ai = 0; ai < 2; ++ai)
#pragma unroll
            for (int m = 0; m < 4; ++m) {
                const int row = row0 + ai * HALF + m * 16; bf16_t* rowp = HB + wt_off(row, col0, 2816);        const float rstd = rs[ai][m];
                const float rg = rstd * -1.4426950408889634f, ru = rstd * -0.6931471805599453f;
                const f32x4 g0 = acc[ai][0][m][0] * rg + svg[0], g1 = acc[ai][0][m][1] * rg + svg[1], u0 = acc[ai][1][m][0] * ru + svu[0], u1 = acc[ai][1][m][1] * ru + svu[1];
#define GU_F(g_, u_) (((g_) * (u_)) * __builtin_amdgcn_rcpf(1.0f + __builtin_amdgcn_exp2f(g_)))
                u32x4 w;
                w.x = cvt_pk_bf16(GU_F(g0[0], u0[0]), GU_F(g0[1], u0[1])); w.y = cvt_pk_bf16(GU_F(g0[2], u0[2]), GU_F(g0[3], u0[3]));
                w.z = cvt_pk_bf16(GU_F(g1[0], u1[0]), GU_F(g1[1], u1[1])); w.w = cvt_pk_bf16(GU_F(g1[2], u1[2]), GU_F(g1[3], u1[3]));
#undef GU_F
                *(u32x4*)rowp = w;
            }
    }
};
struct EpiRes {
    static constexpr bool PERM = true, AFTER_DRAIN = false, PARAMS = false, LOOSE = false, PREF = false;
    EpiCtx cx; PG8_LAS float* part;
    __device__ __forceinline__ void operator()(const f32x4 (&acc)[2][2][4][2], const Unit& u, int wr, int wc, int fr_in, int fq_in, const PG8_LAS unsigned char* par) const {
        const int ln_ = hw_lane(); const int fr = ln_ & 15, fq = ln_ >> 4;
        unsigned char* wsb = ectx_ws(cx); const int l = cx.l, ty = cx.ty;
        const bool hasAN = !(l == 1 && ty == T_DN2);
        const float coef = (ty == T_OUT) ? 1.0f : 0.5f;
        float* ssq = (float*)(wsb + WS_SSQ);
        const int pc0 = wc * 32 + 8 * fq;
        const size_t tb = ((size_t)u.pm * BM) * 1024 + (size_t)u.pn * BM;
        char* hbt = (char*)((bf16_t*)(wsb + WS_H) + tb); char* ant = (char*)((bf16_t*)(PG8_GAS bf16_t*)cx.outi + tb);
        const int r0 = wr * 64 + fr;
        unsigned ro[2][4];
#pragma unroll
        for (int ai = 0; ai < 2; ++ai)
#pragma unroll
            for (int m = 0; m < 4; ++m) ro[ai][m] = (unsigned)((r0 + ai * HALF + m * 16) * 1024 + pc0) * 2u;
        u32x4 hq[2][4][2];
#pragma unroll
        for (int ai = 0; ai < 2; ++ai)
#pragma unroll
            for (int m = 0; m < 4; ++m)
#pragma unroll
                for (int bj = 0; bj < 2; ++bj) hq[ai][m][bj] = *(const u32x4*)(hbt + (size_t)ro[ai][m] + bj * HALF * 2);
#pragma unroll
        for (int ai = 0; ai < 2; ++ai)
#pragma unroll
            for (int m = 0; m < 4; ++m) { float sqr = 0.f;
#pragma unroll
                for (int bj = 0; bj < 2; ++bj) { const int co = bj * HALF;
                    const f32x4 gv0 = *(const PG8_LAS f32x4*)(par + (pc0 + co) * 4) * coef, gv1 = *(const PG8_LAS f32x4*)(par + (pc0 + co + 4) * 4) * coef;
                    const u32x4 hw0 = hq[ai][m][bj];
                    const f32x4 hin0 = (f32x4){__uint_as_float(hw0.x << 16), __uint_as_float(hw0.x & 0xffff0000u), __uint_as_float(hw0.y << 16), __uint_as_float(hw0.y & 0xffff0000u)};
                    const f32x4 hin1 = (f32x4){__uint_as_float(hw0.z << 16), __uint_as_float(hw0.z & 0xffff0000u), __uint_as_float(hw0.w << 16), __uint_as_float(hw0.w & 0xffff0000u)};
                    const f32x4 v0 = hin0 + gv0 * acc[ai][bj][m][0], v1 = hin1 + gv1 * acc[ai][bj][m][1];
                    { u32x4 hw; hw.x = cvt_pk_bf16(v0[0], v0[1]); hw.y = cvt_pk_bf16(v0[2], v0[3]); hw.z = cvt_pk_bf16(v1[0], v1[1]); hw.w = cvt_pk_bf16(v1[2], v1[3]); *(u32x4*)(hbt + (size_t)ro[ai][m] + co * 2) = hw; }
                    if (hasAN) { const f32x4 gs0 = *(const PG8_LAS f32x4*)(par + 1024 + (pc0 + co) * 4), gs1 = *(const PG8_LAS f32x4*)(par + 1024 + (pc0 + co + 4) * 4);
                        sqr += ((v0[0] * v0[0] + v0[1] * v0[1]) + (v0[2] * v0[2] + v0[3] * v0[3])) + ((v1[0] * v1[0] + v1[1] * v1[1]) + (v1[2] * v1[2] + v1[3] * v1[3]));
                        const f32x4 a0 = v0 * gs0, a1 = v1 * gs1;
                        u32x4 w; w.x = cvt_pk_bf16(a0[0], a0[1]); w.y = cvt_pk_bf16(a0[2], a0[3]); w.z = cvt_pk_bf16(a1[0], a1[1]); w.w = cvt_pk_bf16(a1[2], a1[3]);
                        *(u32x4*)(ant + (size_t)ro[ai][m] + co * 2) = w; } }
                if (hasAN) { float s = sqr;
                    s = xl_x32_sum(xl_x16_sum(s));
                    if (fq == 0) part[(ai * HALF + wr * 64 + m * 16 + fr) * 4 + wc] = s; }
            }
        if (hasAN) { const int lane = ln_;
            asm volatile("s_waitcnt lgkmcnt(0)" ::: "memory"); __builtin_amdgcn_s_barrier(); asm volatile("" ::: "memory");
            const int tid = (wr * 4 + wc) * 64 + lane;
            if (tid < 256) { const f32x4 p = *(const PG8_LAS f32x4*)(part + tid * 4); ssq[(size_t)(u.pm * BM + tid) * 4 + u.pn] = (p[0] + p[1]) + (p[2] + p[3]); }
        }
    }
    __device__ __forceinline__ void rows_out(const f32x4 (&acc)[2][2][4][2], const Unit& u, int wr, int wc, PG8_LAS unsigned char* lds, const PG8_LAS unsigned char* par) const {
        const int ln_ = hw_lane(); const int fr = ln_ & 15, fq = ln_ >> 4;
        unsigned char* wsb = ectx_ws(cx); const int l = cx.l, ty = cx.ty;
        const bool hasAN = !(l == 1 && ty == T_DN2);
        const float coef = (ty == T_OUT) ? 1.0f : 0.5f;
        float* ssq = (float*)(wsb + WS_SSQ);
        const int pc0 = wc * 32 + 8 * fq;
        const size_t tb = ((size_t)u.pm * BM) * 1024 + (size_t)u.pn * BM;
        char* hbt = (char*)((bf16_t*)(wsb + WS_H) + tb); char* ant = (char*)((bf16_t*)(PG8_GAS bf16_t*)cx.outi + tb);
        const int r0 = wr * 64 + fr;
        unsigned ro[2][4];
#pragma unroll
        for (int ai = 0; ai < 2; ++ai)
#pragma unroll
            for (int m = 0; m < 4; ++m) ro[ai][m] = (unsigned)((r0 + ai * HALF + m * 16) * 1024 + pc0) * 2u;
        u32x4 hq[2][4][2];
#pragma unroll
        for (int ai = 0; ai < 2; ++ai)
#pragma unroll
            for (int m = 0; m < 4; ++m)
#pragma unroll
                for (int bj = 0; bj < 2; ++bj) hq[ai][m][bj] = *(const u32x4*)(hbt + (size_t)ro[ai][m] + bj * HALF * 2);
        const int wid = wr * 4 + wc;
#pragma unroll
        for (int ai = 0; ai < 2; ++ai) {
#pragma unroll
            for (int m = 0; m < 4; ++m) { float sqr = 0.f; const int rr = r0 + m * 16;
#pragma unroll
                for (int bj = 0; bj < 2; ++bj) { const int co = bj * HALF;
                    const f32x4 gv0 = *(const PG8_LAS f32x4*)(par + (pc0 + co) * 4) * coef, gv1 = *(const PG8_LAS f32x4*)(par + (pc0 + co + 4) * 4) * coef;
                    const u32x4 hw0 = hq[ai][m][bj];
                    const f32x4 hin0 = (f32x4){__uint_as_float(hw0.x << 16), __uint_as_float(hw0.x & 0xffff0000u), __uint_as_float(hw0.y << 16), __uint_as_float(hw0.y & 0xffff0000u)};
                    const f32x4 hin1 = (f32x4){__uint_as_float(hw0.z << 16), __uint_as_float(hw0.z & 0xffff0000u), __uint_as_float(hw0.w << 16), __uint_as_float(hw0.w & 0xffff0000u)};
                    const f32x4 v0 = hin0 + gv0 * acc[ai][bj][m][0], v1 = hin1 + gv1 * acc[ai][bj][m][1];
                    const int chunk = (bj * 16 + wc * 4 + fq) ^ (rr & 15);
                    { u32x4 hw; hw.x = cvt_pk_bf16(v0[0], v0[1]); hw.y = cvt_pk_bf16(v0[2], v0[3]); hw.z = cvt_pk_bf16(v1[0], v1[1]); hw.w = cvt_pk_bf16(v1[2], v1[3]); *(PG8_LAS u32x4*)(lds + rr * 512 + chunk * 16) = hw; }
                    if (hasAN) { const f32x4 gs0 = *(const PG8_LAS f32x4*)(par + 1024 + (pc0 + co) * 4), gs1 = *(const PG8_LAS f32x4*)(par + 1024 + (pc0 + co + 4) * 4);
                        sqr += ((v0[0] * v0[0] + v0[1] * v0[1]) + (v0[2] * v0[2] + v0[3] * v0[3])) + ((v1[0] * v1[0] + v1[1] * v1[1]) + (v1[2] * v1[2] + v1[3] * v1[3]));
                        const f32x4 a0 = v0 * gs0, a1 = v1 * gs1;
                        u32x4 w; w.x = cvt_pk_bf16(a0[0], a0[1]); w.y = cvt_pk_bf16(a0[2], a0[3]); w.z = cvt_pk_bf16(a1[0], a1[1]); w.w = cvt_pk_bf16(a1[2], a1[3]);
                        *(PG8_LAS u32x4*)(lds + 65536 + rr * 512 + chunk * 16) = w; } }
                if (hasAN) { float s = sqr;
                    s = xl_x32_sum(xl_x16_sum(s));
                    if (fq == 0) part[(ai * HALF + rr) * 4 + wc] = s; }
            }
            asm volatile("s_waitcnt lgkmcnt(0)" ::: "memory"); __builtin_amdgcn_s_barrier(); asm volatile("" ::: "memory");
#pragma unroll
            for (int i = 0; i < 8; ++i) { const int rr = 16 * wid + 2 * i + (ln_ >> 5), c = ln_ & 31; const unsigned lo = (unsigned)(rr * 512 + ((c ^ (rr & 15)) * 16)); const size_t go = (size_t)(ai * HALF + rr) * 2048 + c * 16;
                const u32x4 hv = *(const PG8_LAS u32x4*)(lds + lo); *(u32x4*)(hbt + go) = hv;
                if (hasAN) { const u32x4 av = *(const PG8_LAS u32x4*)(lds + 65536 + lo); *(u32x4*)(ant + go) = av; } }
            if (ai == 0) { asm volatile("s_waitcnt lgkmcnt(0)" ::: "memory"); __builtin_amdgcn_s_barrier(); asm volatile("" ::: "memory"); }
        }
        if (hasAN) {
            const int tid = wid * 64 + ln_;
            if (tid < 256) { const f32x4 p = *(const PG8_LAS f32x4*)(part + tid * 4); ssq[(size_t)(u.pm * BM + tid) * 4 + u.pn] = (p[0] + p[1]) + (p[2] + p[3]); }
        }
        asm volatile("s_waitcnt lgkmcnt(0)" ::: "memory"); __builtin_amdgcn_s_barrier(); asm volatile("" ::: "memory");
    }
};
__device__ __forceinline__ float* slab_ptr(unsigned long long wsi, unsigned long long outi, int s) {
    return s < 7 ? (float*)(PG8_GAS float*)(outi + ((size_t)34 << 20) + ((size_t)s << 22)) : (float*)(PG8_GAS float*)(wsi + WS_R + ((size_t)94 << 20) + ((size_t)(s - 7) << 22)); }
struct EpiResAt {
    static constexpr bool PERM = true, AFTER_DRAIN = false, PARAMS = false, LOOSE = false, PREF = false;
    EpiCtx cx;
    __device__ __forceinline__ void operator()(const f32x4 (&acc)[2][2][4][2], const Unit& u, int wr, int wc, int fr_in, int fq_in, const PG8_LAS unsigned char* par) const {
        const int ln_ = hw_lane(); const int fr = ln_ & 15, fq = ln_ >> 4;
        const int ty = cx.ty;
        const float coef = (ty == T_OUT) ? 1.0f : 0.5f;
        float* dst = (float*)((bf16_t*)slab_ptr(cx.wsi, cx.outi, u.ko >> 8) + (size_t)(u.pm - 64) * BM * 1024); const int col0 = u.pn * BM + wc * 32 + 8 * fq, r0 = wr * 64 + fr;
        f32x4 gv[2][2];
#pragma unroll
        for (int bj = 0; bj < 2; ++bj)
#pragma unroll
            for (int n = 0; n < 2; ++n) gv[bj][n] = *(const PG8_LAS f32x4*)(par + (wc * 32 + 8 * fq + bj * HALF + n * 4) * 4) * coef;
#pragma unroll
        for (int ai = 0; ai < 2; ++ai)
#pragma unroll
            for (int m = 0; m < 4; ++m) { bf16_t* rp = (bf16_t*)dst + (size_t)(r0 + ai * HALF + m * 16) * 1024 + col0;
#pragma unroll
                for (int bj = 0; bj < 2; ++bj) { const f32x4 t0 = gv[bj][0] * acc[ai][bj][m][0], t1 = gv[bj][1] * acc[ai][bj][m][1];
                    u32x4 w; w.x = cvt_pk_bf16(t0[0], t0[1]); w.y = cvt_pk_bf16(t0[2], t0[3]); w.z = cvt_pk_bf16(t1[0], t1[1]); w.w = cvt_pk_bf16(t1[2], t1[3]); *(u32x4*)(rp + bj * HALF) = w; } }
    }
};
struct EpiDn {
    static constexpr bool PERM = true, AFTER_DRAIN = true, PARAMS = true, LOOSE = true; static constexpr int NST = 16;
    EpiRes r; EpiResAt a;
    __device__ __forceinline__ void stage(PG8_LAS unsigned char* par, const Unit& u, int wid, int) const {
        if (wid >= 2) return;
        const int l = r.cx.l, ty = r.cx.ty; unsigned char* wsb = ectx_ws(r.cx); const int lane = hw_lane(); const bool ctxu = u.pm >= 64; const int b = ctxu ? 4 : (u.pm >> 4);
        if (wid == 0) { const int gk = (ty == T_DN1) ? 2 : (ty == T_OUT) ? 5 : 8;
            __builtin_amdgcn_global_load_lds((const unsigned*)((const float*)(wsb + WS_MOD) + (size_t)l * 5 * 9216 + (size_t)b * 9216 + gk * 1024 + u.pn * BM + lane * 4), (PG8_LAS unsigned*)par, 16, 0, 0); }
        else if (!ctxu && !(l == 1 && ty == T_DN2)) {
            const float* gsn = (const float*)(wsb + WS_GS) + (size_t)((ty == T_DN2 ? l + 1 : l) * 3 + (ty == T_DN1 ? 1 : ty == T_OUT ? 2 : 0)) * 5 * 1024;
            __builtin_amdgcn_global_load_lds((const unsigned*)(gsn + (size_t)b * 1024 + u.pn * BM + lane * 4), (PG8_LAS unsigned*)(par + 1024), 16, 0, 0); }
    }
    __device__ __forceinline__ void operator()(const f32x4 (&acc)[2][2][4][2], const Unit& u, int wr, int wc, int fr_in, int fq_in, const PG8_LAS unsigned char* par) const { if (u.pm >= 64) a(acc, u, wr, wc, fr_in, fq_in, par); else r(acc, u, wr, wc, fr_in, fq_in, par); }
    __device__ __forceinline__ void fused(const f32x4 (&acc)[2][2][4][2], const Unit& u, int wr, int wc, PG8_LAS unsigned char* lds, const PG8_LAS unsigned char* par) const { r.rows_out(acc, u, wr, wc, lds, par); }
};
struct EpiIN {
    static constexpr bool PERM = true, AFTER_DRAIN = false, PARAMS = true, LOOSE = true; static constexpr int NST = 16;
    EpiCtx cx; const PG8_LAS float* ropet;
    __device__ __forceinline__ void stage(PG8_LAS unsigned char* par, const Unit& u, int wid, int lane) const {
        if (u.pm >= 64) return;
        unsigned char* wsb = ectx_ws(cx);
        epi_stage_params(par, (const float*)(wsb + WS_SSQ) + (size_t)u.pm * BM * 4, (const float*)(wsb + WS_SW) + (size_t)(cx.l * 3 + 1) * 4 * 5632 + (size_t)(u.pm >> 4) * 5632 + u.pn * 256, wid, lane);
    }
    __device__ __forceinline__ void operator()(const f32x4 (&acc)[2][2][4][2], const Unit& u, int wr, int wc, int fr_in, int fq_in, const PG8_LAS unsigned char* par) const {
        const int ln_ = hw_lane(); const int fr = ln_ & 15, fq = ln_ >> 4;
        unsigned char* wsb = ectx_ws(cx); bf16_t* PROJ = (bf16_t*)(wsb + WS_R + R_PROJ); const PG8_LAS float* cosv = ropet; const PG8_LAS float* sinv = ropet + 1024;
        const int pn = u.pn; const int row0 = u.pm * BM + wr * 64 + fr; const int j0 = wc * 32 + 8 * fq;
        const bool rope_tile = (pn == 2) || (pn >= 4 && pn <= 7) || (pn == 3 && wc < 2);
        const float C2q = 0.125f * 1.4426950408889634f;
        const bool lat = u.pm < 64;
        f32x4 sv[2][2];
#pragma unroll
        for (int bj = 0; bj < 2; ++bj)
#pragma unroll
            for (int n = 0; n < 2; ++n) { const f32x4 t = *(const PG8_LAS f32x4*)(par + 4096 + (bj * 128 + j0 + 4 * n) * 4); sv[bj][n] = lat ? t : (f32x4){0.f, 0.f, 0.f, 0.f}; }
        float rs[2][4];
        { f32x4 sq[2][4];
#pragma unroll
          for (int ai = 0; ai < 2; ++ai)
#pragma unroll
            for (int m = 0; m < 4; ++m) sq[ai][m] = *(const PG8_LAS f32x4*)(par + (wr * 64 + fr + ai * HALF + m * 16) * 16);
#pragma unroll
          for (int ai = 0; ai < 2; ++ai)
#pragma unroll
            for (int m = 0; m < 4; ++m) rs[ai][m] = lat ? __builtin_amdgcn_rsqf(((sq[ai][m][0] + sq[ai][m][1]) + (sq[ai][m][2] + sq[ai][m][3])) * (1.0f / 1024.0f) + 1e-6f) : 1.0f; }
#define EPIIN_SV
#define EPIIN_RSTD(row_) const float rstd = rs[ai][m];
        if (!rope_tile) {
            int cbase[2];
            if (pn == 3) { cbase[0] = 896 + (j0 - 64); cbase[1] = 896 + 64 + (j0 - 64); } else { cbase[0] = 256 * pn + j0; cbase[1] = 256 * pn + 128 + j0; }
#pragma unroll
            for (int ai = 0; ai < 2; ++ai)
#pragma unroll
                for (int m = 0; m < 4; ++m) { bf16_t* rowp = PROJ + (size_t)(row0 + ai * HALF + m * 16) * 2560; EPIIN_RSTD(row0 + ai * HALF + m * 16) EPIIN_SV
#pragma unroll
                    for (int bj = 0; bj < 2; ++bj) { f32x4 v0 = acc[ai][bj][m][0] * rstd + sv[bj][0], v1 = acc[ai][bj][m][1] * rstd + sv[bj][1];
                        if (pn == 1) {
#pragma unroll
                            for (int e = 0; e < 4; ++e) { v0[e] = fast_gelu_tanh(v0[e]); v1[e] = fast_gelu_tanh(v1[e]); } }
                        u32x4 w; w.x = cvt_pk_bf16(v0[0], v0[1]); w.y = cvt_pk_bf16(v0[2], v0[3]); w.z = cvt_pk_bf16(v1[0], v1[1]); w.w = cvt_pk_bf16(v1[2], v1[3]);
                        *(u32x4*)(rowp + cbase[bj]) = w; } }
        } else {
            const bool latent = lat; const float qs = (pn == 2 || pn == 4 || pn == 5) ? C2q : 1.0f;
            const int c1 = (pn == 3 ? 768 : 256 * pn) + 64 * wc + 8 * fq;
            const int fo = 8 * (fq & 1);
#pragma unroll
            for (int ai = 0; ai < 2; ++ai) {
                const int posr = (4 * u.pm + 2 * ai + wr) & 63;
#pragma unroll
                for (int m = 0; m < 4; ++m) { bf16_t* rowp = PROJ + (size_t)(row0 + ai * HALF + m * 16) * 2560 + c1;
                    const int pos = (fq < 2) ? posr : (16 * m + fr); EPIIN_RSTD(row0 + ai * HALF + m * 16) EPIIN_SV
                    f32x4 x1a = acc[ai][0][m][0] * rstd + sv[0][0], x1b = acc[ai][0][m][1] * rstd + sv[0][1], x2a = acc[ai][1][m][0] * rstd + sv[1][0], x2b = acc[ai][1][m][1] * rstd + sv[1][1];
                    if (latent) {
                        const f32x4 ca = *(const PG8_LAS f32x4*)(cosv + pos * 16 + fo), cb = *(const PG8_LAS f32x4*)(cosv + pos * 16 + fo + 4), sa = *(const PG8_LAS f32x4*)(sinv + pos * 16 + fo), sb = *(const PG8_LAS f32x4*)(sinv + pos * 16 + fo + 4);
                        const f32x4 o1a = x1a * ca - x2a * sa, o1b = x1b * cb - x2b * sb, o2a = x1a * sa + x2a * ca, o2b = x1b * sb + x2b * cb;
                        x1a = o1a; x1b = o1b; x2a = o2a; x2b = o2b;
                    }
                    x1a = x1a * qs; x1b = x1b * qs; x2a = x2a * qs; x2b = x2b * qs;
                    u32x4 w1, w2; w1.x = cvt_pk_bf16(x1a[0], x1a[1]); w1.y = cvt_pk_bf16(x1a[2], x1a[3]); w1.z = cvt_pk_bf16(x1b[0], x1b[1]); w1.w = cvt_pk_bf16(x1b[2], x1b[3]);
                    w2.x = cvt_pk_bf16(x2a[0], x2a[1]); w2.y = cvt_pk_bf16(x2a[2], x2a[3]); w2.z = cvt_pk_bf16(x2b[0], x2b[1]); w2.w = cvt_pk_bf16(x2b[2], x2b[3]);
                    *(u32x4*)rowp = w1; *(u32x4*)(rowp + 32) = w2; }
            }
        }
    }
};
#undef EPIIN_RSTD
#undef EPIIN_SV

template <class Epi, class Sched, bool ALIGN_EPI = false, bool SP2 = false>
__device__ __forceinline__ void gemm_phase(PG8_LAS unsigned char* lds, const Gemm g, const Sched& S, const Epi& E, const int tid_in) {
    const int tid = tid_in, wid = __builtin_amdgcn_readfirstlane(tid >> 6), lane = tid & 63, wr = wid >> 2, wc = wid & 3, fr = lane & 15, fq = lane >> 4;
    const int K = g.K, LD = g.ld; int nt = K / BK;
    unsigned voffA[2], voffB[2];
#pragma unroll
    for (int i = 0; i < 2; ++i) { int R, C; stage_rc(tid * 16 + i * 8192, R, C); const int Rb = Epi::PERM ? ((R & ~31) + perm32(R & 31)) : R;
        voffA[i] = g.tiledA ? (unsigned)wt_off(R, C, LD) * 2u : (unsigned)(R * LD + C) * 2u; voffB[i] = (unsigned)wt_off(Rb, C, LD) * 2u; }
    const size_t kstep = g.tiledA ? (size_t)2048 : (size_t)(BK * 2);
    const size_t koA = g.tiledA ? 32 : 2;
    const size_t kstepB = 2048;
    const size_t hstep = (size_t)HALF * LD * 2;
    const size_t tstep = 2 * hstep;
    const unsigned ldsw = (unsigned)wid * 1024u;
    const int aoff = lds_byte(wr * 64 + fr, fq * 8), boff = lds_byte(wc * 32 + fr, fq * 8);
#define PG8_SA(b, h) (((b) * 2 + (h)) * HTB)
#define PG8_SB(b, h) ((4 + (b) * 2 + (h)) * HTB)
#define PG8_STAGE(bufoff, gbase, voff) do { _Pragma("unroll") for (int _i = 0; _i < 2; ++_i) { unsigned vo_ = (voff)[_i]; asm volatile("" : "+v"(vo_));   \
        __builtin_amdgcn_global_load_lds((const unsigned*)((const char*)(gbase) + vo_), (PG8_LAS unsigned*)(lds + (bufoff) + ldsw + _i * 8192), 16, 0, 0); } } while (0)
#define PG8_LDA(dst, b, h) do { _Pragma("unroll") for (int m = 0; m < 4; ++m) _Pragma("unroll") for (int k = 0; k < 2; ++k) dst[m][k] = *(const PG8_LAS bf16x8*)(lds + PG8_SA(b, h) + aoff + m * 2048 + k * 1024); } while (0)
#define PG8_LDB(dst, b, h) do { _Pragma("unroll") for (int n = 0; n < 2; ++n) _Pragma("unroll") for (int k = 0; k < 2; ++k) dst[n][k] = *(const PG8_LAS bf16x8*)(lds + PG8_SB(b, h) + boff + n * 2048 + k * 1024); } while (0)
#define PG8_MMA(ai, bj, At, Bt) do { __builtin_amdgcn_s_setprio(1); _Pragma("unroll") for (int m = 0; m < 4; ++m) _Pragma("unroll") for (int n = 0; n < 2; ++n) _Pragma("unroll") for (int k = 0; k < 2; ++k) \
        acc[ai][bj][m][n] = __builtin_amdgcn_mfma_f32_16x16x32_bf16(Bt[n][k], At[m][k], acc[ai][bj][m][n], 0, 0, 0); __builtin_amdgcn_s_setprio(0); } while (0)
#define PG8_WAIT_V(n) asm volatile("s_waitcnt vmcnt(" #n ")" ::: "memory")
#define PG8_WAIT_L(n) asm volatile("s_waitcnt lgkmcnt(" #n ")" ::: "memory")
#define PG8_WAIT_VN(n) asm volatile("s_waitcnt vmcnt(%0)" :: "n"(n) : "memory")
#define PG8_BAR __builtin_amdgcn_s_barrier()
#define PG8_SCHED __builtin_amdgcn_sched_barrier(0)
    Unit cur, nxt; int ui = 0;
    if (!S.next(0, cur)) return;
    f32x4 acc[2][2][4][2];
#pragma unroll
    for (int a = 0; a < 2; ++a)
#pragma unroll
        for (int b = 0; b < 2; ++b)
#pragma unroll
            for (int m = 0; m < 4; ++m)
#pragma unroll
                for (int n = 0; n < 2; ++n) acc[a][b][m][n] = (f32x4){0.f, 0.f, 0.f, 0.f};
    bf16x8 At[4][2], B0[2][2], B1[2][2];
    const char* cA = (const char*)g.A + (size_t)cur.pm * tstep + (size_t)cur.ko * koA; const char* cB = (const char*)g.Bt + (size_t)cur.pn * tstep + (size_t)cur.ko * 32;
    if constexpr (Sched::VAR_NT) nt = cur.nt;
    S.a_ready(cur);
    if constexpr (SP2) {
        PG8_STAGE(PG8_SB(0, 0), cB, voffB); PG8_STAGE(PG8_SB(0, 1), cB + hstep, voffB); PG8_STAGE(PG8_SA(0, 0), cA, voffA); PG8_STAGE(PG8_SA(0, 1), cA + hstep, voffA);
        if (wr == 1) PG8_BAR;
        PG8_WAIT_V(2); PG8_BAR;
        PG8_STAGE(PG8_SB(1, 0), cB + kstepB, voffB); PG8_STAGE(PG8_SA(1, 0), cA + kstep, voffA); PG8_STAGE(PG8_SB(1, 1), cB + hstep + kstepB, voffB);
        PG8_WAIT_V(6); PG8_BAR;
    } else {
        PG8_STAGE(PG8_SB(0, 0), cB, voffB); PG8_STAGE(PG8_SA(0, 0), cA, voffA); PG8_STAGE(PG8_SB(0, 1), cB + hstep, voffB); PG8_STAGE(PG8_SA(0, 1), cA + hstep, voffA);
        if (wr == 1) PG8_BAR;
        PG8_WAIT_V(4); PG8_BAR;
        PG8_STAGE(PG8_SB(1, 0), cB + kstepB, voffB); PG8_STAGE(PG8_SA(1, 0), cA + kstep, voffA); PG8_STAGE(PG8_SB(1, 1), cB + hstep + kstepB, voffB);
        PG8_WAIT_V(6); PG8_BAR;
    }
    if constexpr (Epi::PARAMS) E.stage(lds + STAGE_BYTES, cur, wid, lane);
    for (;;) {
        const bool has_next = S.next(ui + 1, nxt);
        const char* nA = has_next ? (const char*)g.A + (size_t)nxt.pm * tstep + (size_t)nxt.ko * koA : cA; const char* nB = has_next ? (const char*)g.Bt + (size_t)nxt.pn * tstep + (size_t)nxt.ko * 32 : cB;
        int t0 = 0;
        if constexpr (Epi::LOOSE) { if (ui > 0) {
            const char* a2 = cA + 2 * kstep; const char* b2 = cB + 2 * kstepB; asm volatile("" : "+s"(a2), "+s"(b2));
            const char* a3 = a2 + kstep; const char* b3 = b2 + kstepB; asm volatile("" : "+s"(a3), "+s"(b3));
            PG8_LDB(B0, 0, 0); PG8_LDB(B1, 0, 1); PG8_SCHED; PG8_LDA(At, 0, 0);
            PG8_WAIT_VN(8 + Epi::NST); PG8_WAIT_L(0); PG8_BAR; PG8_MMA(0, 0, At, B0); PG8_MMA(0, 1, At, B1); PG8_BAR; PG8_SCHED;
            PG8_LDA(At, 0, 1); PG8_STAGE(PG8_SB(0, 0), b2, voffB); PG8_STAGE(PG8_SB(0, 1), b2 + hstep, voffB); PG8_STAGE(PG8_SA(0, 0), a2, voffA);
            PG8_WAIT_VN(8 + Epi::NST); PG8_WAIT_L(0); PG8_BAR; PG8_MMA(1, 0, At, B0); PG8_MMA(1, 1, At, B1); PG8_BAR; PG8_SCHED;
            PG8_LDB(B0, 1, 0); PG8_LDB(B1, 1, 1); PG8_SCHED; PG8_LDA(At, 1, 0); PG8_STAGE(PG8_SA(0, 1), a2 + hstep, voffA);
            PG8_WAIT_VN(8 + Epi::NST); PG8_WAIT_L(0); PG8_BAR; PG8_MMA(0, 0, At, B0); PG8_MMA(0, 1, At, B1); PG8_BAR; PG8_SCHED;
            PG8_LDA(At, 1, 1); PG8_STAGE(PG8_SB(1, 0), b3, voffB); PG8_STAGE(PG8_SB(1, 1), b3 + hstep, voffB); PG8_STAGE(PG8_SA(1, 0), a3, voffA);
            PG8_WAIT_V(8); PG8_WAIT_L(0); PG8_BAR; PG8_MMA(1, 0, At, B0); PG8_MMA(1, 1, At, B1); PG8_BAR; PG8_SCHED;
            t0 = 2; } }
        for (int t = t0; t < nt; t += 2) {
            const bool last = (t == nt - 2);
            const char* a1 = cA + (size_t)(t + 1) * kstep;
            const char* a2 = last ? nA : cA + (size_t)(t + 2) * kstep; const char* b2 = last ? nB : cB + (size_t)(t + 2) * kstepB;
            const char* a3 = a2 + kstep; const char* b3 = b2 + kstepB;
            if (last && has_next) S.a_ready(nxt);
            if constexpr (SP2) {
            PG8_LDB(B0, 0, 0); PG8_LDB(B1, 0, 1); PG8_SCHED; PG8_LDA(At, 0, 0); PG8_STAGE(PG8_SA(1, 1), a1 + hstep, voffA);
            PG8_WAIT_V(8); PG8_WAIT_L(0); PG8_BAR; PG8_MMA(0, 0, At, B0); PG8_MMA(0, 1, At, B1); PG8_BAR; PG8_SCHED;
            PG8_LDA(At, 0, 1); PG8_STAGE(PG8_SB(0, 0), b2, voffB); PG8_STAGE(PG8_SB(0, 1), b2 + hstep, voffB); PG8_STAGE(PG8_SA(0, 0), a2, voffA);
            PG8_WAIT_V(8); PG8_WAIT_L(0); PG8_BAR; PG8_MMA(1, 0, At, B0); PG8_MMA(1, 1, At, B1); PG8_BAR; PG8_SCHED;
            PG8_LDB(B0, 1, 0); PG8_LDB(B1, 1, 1); PG8_SCHED; PG8_LDA(At, 1, 0); PG8_STAGE(PG8_SA(0, 1), a2 + hstep, voffA);
            PG8_WAIT_V(8); PG8_WAIT_L(0); PG8_BAR; PG8_MMA(0, 0, At, B0); PG8_MMA(0, 1, At, B1); PG8_BAR; PG8_SCHED;
            PG8_LDA(At, 1, 1); PG8_STAGE(PG8_SB(1, 0), b3, voffB); PG8_STAGE(PG8_SB(1, 1), b3 + hstep, voffB); PG8_STAGE(PG8_SA(1, 0), a3, voffA);
            PG8_WAIT_V(8); PG8_WAIT_L(0); PG8_BAR; PG8_MMA(1, 0, At, B0); PG8_MMA(1, 1, At, B1); PG8_BAR; PG8_SCHED;
            } else {
            PG8_LDB(B0, 0, 0); PG8_SCHED; PG8_LDA(At, 0, 0); PG8_STAGE(PG8_SA(1, 1), a1 + hstep, voffA);
            PG8_WAIT_L(8); PG8_BAR; PG8_WAIT_L(0); PG8_MMA(0, 0, At, B0); PG8_BAR; PG8_SCHED;
            PG8_LDB(B1, 0, 1); PG8_STAGE(PG8_SB(0, 0), b2, voffB);
            PG8_BAR; PG8_WAIT_L(0); PG8_MMA(0, 1, At, B1); PG8_BAR;
            PG8_LDA(At, 0, 1); PG8_STAGE(PG8_SA(0, 0), a2, voffA);
            PG8_BAR; PG8_WAIT_L(0); PG8_MMA(1, 0, At, B0); PG8_BAR; PG8_SCHED;
            PG8_STAGE(PG8_SB(0, 1), b2 + hstep, voffB);
            PG8_WAIT_V(6); PG8_BAR; PG8_MMA(1, 1, At, B1); PG8_BAR;
            PG8_LDB(B0, 1, 0); PG8_SCHED; PG8_LDA(At, 1, 0); PG8_STAGE(PG8_SA(0, 1), a2 + hstep, voffA);
            PG8_WAIT_L(8); PG8_BAR; PG8_WAIT_L(0); PG8_MMA(0, 0, At, B0); PG8_BAR; PG8_SCHED;
            PG8_LDB(B1, 1, 1); PG8_STAGE(PG8_SB(1, 0), b3, voffB);
            PG8_BAR; PG8_WAIT_L(0); PG8_MMA(0, 1, At, B1); PG8_BAR;
            PG8_LDA(At, 1, 1); PG8_STAGE(PG8_SA(1, 0), a3, voffA);
            PG8_BAR; PG8_WAIT_L(0); PG8_MMA(1, 0, At, B0); PG8_BAR; PG8_SCHED;
            PG8_STAGE(PG8_SB(1, 1), b3 + hstep, voffB);
            PG8_WAIT_V(6); PG8_BAR; PG8_MMA(1, 1, At, B1); PG8_BAR;
            }
        }
        if constexpr (Epi::PARAMS || Epi::LOOSE) { if (has_next) { if constexpr (Epi::LOOSE) { const char* xa = nA + kstep + hstep; asm volatile("" : "+s"(xa)); PG8_STAGE(PG8_SA(1, 1), xa, voffA); } if constexpr (Epi::PARAMS) E.stage(lds + STAGE_BYTES + ((ui + 1) & 1) * 5120, nxt, wid, lane); } }
        if constexpr (ALIGN_EPI) { if (wr == 0) PG8_BAR; }
        if (!Epi::AFTER_DRAIN || has_next) { if constexpr (Epi::PARAMS) E(acc, cur, wr, wc, fr, fq, lds + STAGE_BYTES + (ui & 1) * 5120); else E(acc, cur, wr, wc, fr, fq); S.done(cur); }
        if (!has_next) break;
#pragma unroll
        for (int a = 0; a < 2; ++a)
#pragma unroll
            for (int b = 0; b < 2; ++b)
#pragma unroll
                for (int m = 0; m < 4; ++m)
#pragma unroll
                    for (int n = 0; n < 2; ++n) acc[a][b][m][n] = (f32x4){0.f, 0.f, 0.f, 0.f};
        cur = nxt; cA = nA; cB = nB; ++ui; if constexpr (Sched::VAR_NT) nt = cur.nt;
        if constexpr (ALIGN_EPI) { if (wr == 1) PG8_BAR; }
    }
    PG8_WAIT_V(0);
    if constexpr (!ALIGN_EPI) { if (wr == 0) PG8_BAR; }
    PG8_BAR;
    if constexpr (Epi::AFTER_DRAIN) { E.fused(acc, cur, wr, wc, lds, lds + STAGE_BYTES + (ui & 1) * 5120); S.done(cur); }
#undef PG8_SA
#undef PG8_SB
#undef PG8_STAGE
#undef PG8_LDA
#undef PG8_LDB
#undef PG8_MMA
#undef PG8_WAIT_V
#undef PG8_WAIT_L
#undef PG8_WAIT_VN
#undef PG8_BAR
#undef PG8_SCHED
}
}

#define GAS __attribute__((address_space(1)))
#define LAS __attribute__((address_space(3)))
typedef unsigned short bf16;
typedef unsigned v4u __attribute__((ext_vector_type(4)));
typedef float f32x4 __attribute__((ext_vector_type(4)));
typedef short bf16x8 __attribute__((ext_vector_type(8)));
typedef GAS unsigned gu32;
typedef GAS unsigned long long gu64;
#define RLX_AGENT __ATOMIC_RELAXED, __HIP_MEMORY_SCOPE_AGENT
#define LDS_WAIT() asm volatile("s_waitcnt lgkmcnt(0)" ::: "memory")
#define VM_WAIT() asm volatile("s_waitcnt vmcnt(0)" ::: "memory")
__device__ __forceinline__ unsigned long long rt() { return __builtin_amdgcn_s_memrealtime(); }
#define XB_TMO      128
#define XB_XCNT(j)  (256  + 64 * (j))
#define XB_XSUB(j)  (1280 + 64 * (j))
#define XB_XGEN(j)  (2304 + 64 * (j))
#define XB_TOP      3328
#define XB_TOPGEN   3392
#define XCD_BAR_WORDS 3456
#define XB_SPIN_CAP (1u << 18)

__device__ __forceinline__ unsigned xb_ld(unsigned* p)              { return __hip_atomic_load(p, __ATOMIC_RELAXED, __HIP_MEMORY_SCOPE_AGENT); }
__device__ __forceinline__ unsigned xb_add(unsigned* p, unsigned v) { return __hip_atomic_fetch_add(p, v, __ATOMIC_RELAXED, __HIP_MEMORY_SCOPE_AGENT); }
__device__ __forceinline__ unsigned xb_xcc_id() { return (unsigned)__builtin_amdgcn_s_getreg((3 << 11) | 20) & 0xFu; }
#define XB_SPIN(cond, bar) do { unsigned _sp = 0; while (cond) { __builtin_amdgcn_s_sleep(1); \
    if ((++_sp & 255u) == 0u) { if (xb_ld(&(bar)[XB_TMO])) break; if (_sp > XB_SPIN_CAP) { atomicAdd(&(bar)[XB_TMO], 1u); break; } } } } while (0)

struct XcdBarrier {
    unsigned* bar; unsigned x; int w0;
    volatile LAS unsigned* st;
};

__device__ __forceinline__ XcdBarrier xcd_barrier_post(unsigned* bar, volatile LAS unsigned* st) {
    XcdBarrier b; b.bar = bar; b.x = xb_xcc_id(); b.st = st; b.w0 = __builtin_amdgcn_readfirstlane(threadIdx.x >> 6);
    if (threadIdx.x == 0) (void)xb_add(&bar[XB_XCNT(b.x)], 1u);
    return b;
}
__device__ __forceinline__ void xcd_barrier_complete(unsigned* bar, unsigned x, unsigned& nloc, unsigned& nx) {
    const unsigned G = gridDim.x * gridDim.y * gridDim.z;
    unsigned sum, cnt, mine, sp = 0u;
    for (;;) {
        sum = 0u; cnt = 0u; mine = 0u;
#pragma unroll
        for (unsigned j = 0; j < 16; ++j) { const unsigned c = xb_ld(&bar[XB_XCNT(j)]); sum += c; cnt += (c > 0u) ? 1u : 0u; mine = (j == x) ? c : mine; }
        if (sum == G) break;
        __builtin_amdgcn_s_sleep(1);
        if ((++sp & 255u) == 0u) { if (xb_ld(&bar[XB_TMO])) break; if (sp > XB_SPIN_CAP) { atomicAdd(&bar[XB_TMO], 1u); break; } }
    }
    nloc = mine > 0u ? mine : 1u; nx = cnt > 0u ? cnt : 1u;
}

__device__ __forceinline__ void xcd_barrier(const XcdBarrier& b) {
    asm volatile("s_waitcnt vmcnt(0)" ::: "memory");
    __syncthreads();
    if (b.w0 == 0 && __builtin_amdgcn_mbcnt_hi(~0u, __builtin_amdgcn_mbcnt_lo(~0u, 0u)) == 0u) {
        unsigned* bar = b.bar;
        __builtin_amdgcn_s_waitcnt(0);
        unsigned nloc = b.st[0], nx = b.st[1];
        if (nloc == 0u) { xcd_barrier_complete(bar, b.x, nloc, nx); b.st[0] = nloc; b.st[1] = nx; }
        const unsigned old = xb_add(&bar[XB_XSUB(b.x)], 1u);
        const unsigned gen = old / nloc;
        if (old + 1u == (gen + 1u) * nloc) {
            __builtin_amdgcn_fence(__ATOMIC_RELEASE, "agent");
            asm volatile("s_waitcnt vmcnt(0)" ::: "memory");
            const unsigned og = xb_add(&bar[XB_TOP], 1u);
            const unsigned tg = og / nx;
            if (og + 1u == (tg + 1u) * nx) xb_add(&bar[XB_TOPGEN], 1u);
            else XB_SPIN(xb_ld(&bar[XB_TOPGEN]) == tg, bar);
            __builtin_amdgcn_fence(__ATOMIC_ACQUIRE, "agent");
            xb_add(&bar[XB_XGEN(b.x)], 1u);
            asm volatile("s_waitcnt vmcnt(0)" ::: "memory");
        } else {
            XB_SPIN(xb_ld(&bar[XB_XGEN(b.x)]) == gen, bar);
            __builtin_amdgcn_fence(__ATOMIC_ACQUIRE, "agent");
            asm volatile("s_waitcnt vmcnt(0)" ::: "memory");
        }
    }
    __syncthreads();
}


namespace att {
typedef float f32x16 __attribute__((ext_vector_type(16)));
typedef short s16x4 __attribute__((ext_vector_type(4)));
typedef short v4i16_t __attribute__((ext_vector_type(4)));
typedef short bf16x8 __attribute__((ext_vector_type(8)));
typedef unsigned u32x4 __attribute__((ext_vector_type(4)));
#define ATT_LAS __attribute__((address_space(3)))
__device__ __forceinline__ int crow(int r, int hi) { return (r & 3) + 8 * (r >> 2) + 4 * hi; }
__device__ __forceinline__ unsigned cvtpk(float lo, float hi) { typedef float f2 __attribute__((ext_vector_type(2))); typedef __bf16 b2 __attribute__((ext_vector_type(2))); f2 v = {lo, hi}; b2 b = __builtin_convertvector(v, b2); return __builtin_bit_cast(unsigned, b); }
__device__ __forceinline__ float swapmax(float m) { auto rr = __builtin_amdgcn_permlane32_swap(__float_as_uint(m), __float_as_uint(m), false, false); return fmaxf(__uint_as_float(rr[0]), __uint_as_float(rr[1])); }
__device__ __forceinline__ float swapsum(float m) { auto rr = __builtin_amdgcn_permlane32_swap(__float_as_uint(m), __float_as_uint(m), false, false); return __uint_as_float(rr[0]) + __uint_as_float(rr[1]); }
__device__ __forceinline__ float sx(float v, int mask, int lane) { return __int_as_float(__builtin_amdgcn_ds_bpermute((lane ^ mask) << 2, __float_as_int(v))); }
constexpr float THR = 8.0f;
constexpr int NOMASK = -1000000;

struct TileSeq {
    int b, nt, mode  , q0, jlo;
    __device__ __forceinline__ int row(int t, int& kabs0) const {
        if (t < 4) { kabs0 = NOMASK; return 16384 + b * 256 + 64 * t; }
        if (mode == 0) { kabs0 = NOMASK; return b * 4096 + 64 * (t - 4); }
        const int j = jlo + t - 4; kabs0 = q0 - 128 + 64 * j; return b * 4096 + kabs0;
    }
};

__device__ __forceinline__ void dma16(const void* g, ATT_LAS unsigned char* l) {
    asm volatile("s_mov_b32 m0, %1\n\ts_nop 0\n\tglobal_load_lds_dwordx4 %0, off" :: "v"(g), "s"((unsigned)(unsigned long)l) : "memory", "m0");
}
template <int NS, int ND> __device__ __forceinline__ void issue_tile(ATT_LAS unsigned char* stage, const unsigned short* PROJ, int krow0, int kcol, int vcol, int wave, int lane) {
#pragma unroll
    for (int i = 0; i < NS; ++i) { const int p = wave + 8 * i, s = p >> 3, c = p & 7;
        const unsigned short* src = PROJ + (size_t)(krow0 + lane) * 2560 + kcol + 64 * s + 8 * c;
        dma16(src, stage + s * 8192 + c * 1024); }
#pragma unroll
    for (int i = 0; i < ND / 2; ++i) { const int p = wave + 8 * i, dblk = p >> 2, rg = p & 3;
        const unsigned short* src = PROJ + (size_t)(krow0 + 16 * rg + (lane >> 2)) * 2560 + vcol + 32 * dblk + 8 * (lane & 3);
        dma16(src, stage + NS * 8192 + (dblk * 4 + rg) * 1024); }
}
__device__ __forceinline__ s16x4 vtr(const ATT_LAS unsigned char* p) { return __builtin_bit_cast(s16x4, __builtin_amdgcn_ds_read_tr16_b64_v4i16((ATT_LAS v4i16_t*)p)); }

#define AT_ROWS_OUT(Ts_, ND_, Y_, qrow_, ycol_, lane_) do { asm volatile("s_waitcnt lgkmcnt(0)" ::: "memory"); \
        _Pragma("unroll") for (int j_ = 0; j_ < 2 * (ND_); ++j_) { const int idx_ = (lane_) + 64 * j_, row_ = idx_ / (4 * (ND_)), ch_ = idx_ % (4 * (ND_)); \
            const u32x4 v_ = *(const ATT_LAS u32x4*)((Ts_) + row_ * (64 * (ND_)) + ch_ * 16); \
            *(u32x4*)((Y_) + (size_t)((qrow_) + row_) * 1024 + (ycol_) + 8 * ch_) = v_; } } while (0)
#define AT_MX3(a, b, c) __builtin_fmaxf(__builtin_fmaxf((a), (b)), (c))
template <int NS, int ND> __device__ __forceinline__ void pv_step(f32x16 (&o)[NS][ND], const u32x4 (&pf)[NS][4], const ATT_LAS unsigned char* Vs);
template <int NS, int ND, int NSTG, bool QLDS>
__device__ __forceinline__ void attn_unit(ATT_LAS unsigned char* lds, const unsigned short* PROJ, unsigned short* Y, const TileSeq ts, int qrow, int qcol, int kcol, int vcol, int ycol,
                                          int qabs, float sinkl2, float lam, const float* subg, float oml, int tid) {
    constexpr int STAGE = NS * 8192 + ND * 4096, NDMA = NS + ND / 2;
    const int lane = tid & 63, r32 = lane & 31, hi = lane >> 5; const int wave = __builtin_amdgcn_readfirstlane(tid >> 6);
    constexpr int QBYTES = QLDS ? 8 * NS * 4096 : 0;
    ATT_LAS unsigned char* Qs = lds + NSTG * STAGE + wave * (NS * 4096);
    ATT_LAS float* wsf = (ATT_LAS float*)(lds + NSTG * STAGE + QBYTES) + wave * 64;
    int ka;
    { const int kr = ts.row(0, ka); issue_tile<NS, ND>(lds, PROJ, kr, kcol, vcol, wave, lane); }
    if (NSTG == 3 && ts.nt > 1) { const int kr = ts.row(1, ka); issue_tile<NS, ND>(lds + STAGE, PROJ, kr, kcol, vcol, wave, lane); }
    bf16x8 qf[NS][4];
#pragma unroll
    for (int s = 0; s < NS; ++s)
#pragma unroll
        for (int d0 = 0; d0 < 4; ++d0) { qf[s][d0] = *(const bf16x8*)(PROJ + (size_t)(qrow + r32) * 2560 + qcol + 64 * s + 16 * d0 + 8 * hi);
            if (QLDS) *(ATT_LAS bf16x8*)(Qs + (s * 8 + 2 * d0 + hi) * 512 + r32 * 16) = qf[s][d0]; }
    f32x16 o[NS][ND];
#pragma unroll
    for (int s = 0; s < NS; ++s)
#pragma unroll
        for (int d = 0; d < ND; ++d)
#pragma unroll
            for (int r = 0; r < 16; ++r) o[s][d][r] = 0.f;
    float mref[NS], lsum[NS];
#pragma unroll
    for (int s = 0; s < NS; ++s) { mref[s] = (NS == 1) ? sinkl2 : -1e30f; lsum[s] = (NS == 1 && hi == 0) ? 1.0f : 0.f; }
    const int koff = hi * 1024 + r32 * 16;
    const int voff = ((lane >> 4) & 1) * 32 + (lane & 3) * 8 + (4 * hi + ((lane & 15) >> 2)) * 64;
    __builtin_amdgcn_s_waitcnt(0x0F70);
    int st = 0;
    for (int t = 0; t < ts.nt; ++t) {
        if (NSTG == 3 && t + 1 < ts.nt) asm volatile("s_waitcnt vmcnt(%0)" ::"n"(NDMA) : "memory"); else asm volatile("s_waitcnt vmcnt(0)" ::: "memory");
        asm volatile("s_waitcnt lgkmcnt(0)" ::: "memory");
        __builtin_amdgcn_s_barrier();
        asm volatile("" ::: "memory");
        if (NSTG == 3) { if (t + 2 < ts.nt) { int k2; const int kr = ts.row(t + 2, k2); const int s2 = (st >= 1) ? st - 1 : 2; issue_tile<NS, ND>(lds + s2 * STAGE, PROJ, kr, kcol, vcol, wave, lane); } }
        else { if (t + 1 < ts.nt) { int k2; const int kr = ts.row(t + 1, k2); issue_tile<NS, ND>(lds + (st ^ 1) * STAGE, PROJ, kr, kcol, vcol, wave, lane); } }
        int kabs0; (void)ts.row(t, kabs0);
        const ATT_LAS unsigned char* Ks = lds + st * STAGE; const ATT_LAS unsigned char* Vs = Ks + NS * 8192;
        u32x4 pf[NS][4];
#pragma unroll
        for (int s = 0; s < NS; ++s) {
            f32x16 p0, p1;
#pragma unroll
            for (int r = 0; r < 16; ++r) { p0[r] = 0.f; p1[r] = 0.f; }
            bf16x8 kA[4], kB[4];
#pragma unroll
            for (int d0 = 0; d0 < 4; ++d0) { kA[d0] = *(const ATT_LAS bf16x8*)(Ks + s * 8192 + koff + d0 * 2048); kB[d0] = *(const ATT_LAS bf16x8*)(Ks + s * 8192 + koff + d0 * 2048 + 512); }
            __builtin_amdgcn_sched_group_barrier(0x100, 8, 0);
#pragma unroll
            for (int d0 = 0; d0 < 4; ++d0) {
                const bf16x8 qv = QLDS ? *(const ATT_LAS bf16x8*)(Qs + (s * 8 + 2 * d0 + hi) * 512 + r32 * 16) : qf[s][d0];
                p0 = __builtin_amdgcn_mfma_f32_32x32x16_bf16(kA[d0], qv, p0, 0, 0, 0);
                p1 = __builtin_amdgcn_mfma_f32_32x32x16_bf16(kB[d0], qv, p1, 0, 0, 0);
            }
            __builtin_amdgcn_sched_group_barrier(0x008, 8, 0);
            if (NS == 1 && kabs0 != NOMASK) {
                const int dq = qabs + r32 - kabs0 - 4 * hi;
#pragma unroll
                for (int r = 0; r < 16; ++r) { const int dk = dq - ((r & 3) + 8 * (r >> 2)); if (dk > 128 || dk < -128) p0[r] = -1e30f; if (dk - 32 > 128 || dk - 32 < -128) p1[r] = -1e30f; }
            }
            float rm; { float a_ = AT_MX3(p0[0], p0[1], p1[0]), b_ = AT_MX3(p0[2], p0[3], p1[1]); a_ = AT_MX3(a_, p1[2], p1[3]);
#pragma unroll
                for (int r = 4; r < 16; r += 4) { a_ = AT_MX3(a_, p0[r], p0[r + 1]); b_ = AT_MX3(b_, p0[r + 2], p0[r + 3]); a_ = AT_MX3(a_, p1[r], p1[r + 1]); b_ = AT_MX3(b_, p1[r + 2], p1[r + 3]); }
                rm = __builtin_fmaxf(a_, b_); }
            rm = swapmax(rm);
            if (__any(rm > mref[s] + THR)) {
                const float mn = fmaxf(mref[s], rm), f = __builtin_amdgcn_exp2f(mref[s] - mn);
                lsum[s] *= f; mref[s] = mn;
                if (hi == 0) wsf[r32] = f;
                float fr[16];
#pragma unroll
                for (int r = 0; r < 16; ++r) fr[r] = wsf[crow(r, hi)];
#pragma unroll
                for (int d = 0; d < ND; ++d)
#pragma unroll
                    for (int r = 0; r < 16; ++r) o[s][d][r] *= fr[r];
            }
            float sacc = lsum[s];
#pragma unroll
            for (int r = 0; r < 16; ++r) { p0[r] = __builtin_amdgcn_exp2f(p0[r] - mref[s]); p1[r] = __builtin_amdgcn_exp2f(p1[r] - mref[s]); sacc = sacc + p0[r]; sacc = sacc + p1[r]; }
            lsum[s] = sacc;
            pf[s][0] = (u32x4){cvtpk(p0[0], p0[1]), cvtpk(p0[2], p0[3]), cvtpk(p0[4], p0[5]), cvtpk(p0[6], p0[7])};
            pf[s][1] = (u32x4){cvtpk(p0[8], p0[9]), cvtpk(p0[10], p0[11]), cvtpk(p0[12], p0[13]), cvtpk(p0[14], p0[15])};
            pf[s][2] = (u32x4){cvtpk(p1[0], p1[1]), cvtpk(p1[2], p1[3]), cvtpk(p1[4], p1[5]), cvtpk(p1[6], p1[7])};
            pf[s][3] = (u32x4){cvtpk(p1[8], p1[9]), cvtpk(p1[10], p1[11]), cvtpk(p1[12], p1[13]), cvtpk(p1[14], p1[15])};
        }
        __builtin_amdgcn_sched_barrier(0);
        pv_step<NS, ND>(o, pf, Vs + voff);
        __builtin_amdgcn_sched_barrier(0);
        st = (NSTG == 3) ? ((st == 2) ? 0 : st + 1) : (st ^ 1);
    }
    unsigned lz_ = 0u; asm volatile("" : "+v"(lz_)); const int lane_e = (int)__builtin_amdgcn_mbcnt_hi(~0u, __builtin_amdgcn_mbcnt_lo(~0u, lz_));
    const int r32e = lane_e & 31, hie = lane_e >> 5;
    float inv[NS][16];
#pragma unroll
    for (int s = 0; s < NS; ++s) {
        const float lt = swapsum(lsum[s]);
        if (hie == 0) wsf[s * 32 + r32e] = 1.0f / lt;
    }
#pragma unroll
    for (int s = 0; s < NS; ++s)
#pragma unroll
        for (int r = 0; r < 16; ++r) inv[s][r] = wsf[s * 32 + crow(r, hie)];
    if (NS == 1) {
        ATT_LAS unsigned char* Ts = lds + NSTG * STAGE + QBYTES + 2048 + wave * (32 * 64 * ND);
#pragma unroll
        for (int r = 0; r < 16; ++r)
#pragma unroll
            for (int d = 0; d < ND; ++d) *(ATT_LAS unsigned short*)(Ts + crow(r, hie) * (64 * ND) + (32 * d + r32e) * 2) = f2bf(o[0][d][r] * inv[0][r]);
        AT_ROWS_OUT(Ts, ND, Y, qrow, ycol, lane_e);
    } else {
        float gsub[ND];
#pragma unroll
        for (int d = 0; d < ND; ++d) gsub[d] = subg[32 * d + r32e] * oml;
#pragma unroll
        for (int r = 0; r < 16; ++r) {
            float ss = 0.f; float ov[ND];
#pragma unroll
            for (int d = 0; d < ND; ++d) { ov[d] = o[0][d][r] * inv[0][r] - lam * (o[NS - 1][d][r] * inv[NS - 1][r]); ss += ov[d] * ov[d]; }
            ss = xl_x16_sum(xl_row16_sum(ss));
            const float rstd = 1.0f / sqrtf(ss * (1.0f / (32 * ND)) + 1e-6f);
            unsigned short* yp = Y + (size_t)(qrow + crow(r, hie)) * 1024 + ycol + r32e;
#pragma unroll
            for (int d = 0; d < ND; ++d) yp[32 * d] = f2bf(ov[d] * rstd * gsub[d]);
        }
    }
    asm volatile("s_waitcnt lgkmcnt(0)" ::: "memory");
    __builtin_amdgcn_s_barrier();
    asm volatile("" ::: "memory");
}

#define ATT_MX3(a, b, c) __builtin_fmaxf(__builtin_fmaxf((a), (b)), (c))
template <int NS, int ND> __device__ __forceinline__ void pv_step(f32x16 (&o)[NS][ND], const u32x4 (&pf)[NS][4], const ATT_LAS unsigned char* Vs) {
    constexpr int NF = 4 * ND, PVDEP = 3;
    __builtin_amdgcn_s_setprio(1);
    bf16x8 vf[NF];
#define PV_LD(i_) do { const int ks_ = (i_) / ND, d_ = (i_) % ND; const s16x4 lo_ = vtr(Vs + d_ * 4096 + ks_ * 1024), hh_ = vtr(Vs + d_ * 4096 + ks_ * 1024 + 512); \
        vf[i_] = (bf16x8){lo_[0], lo_[1], lo_[2], lo_[3], hh_[0], hh_[1], hh_[2], hh_[3]}; } while (0)
#pragma unroll
    for (int i = 0; i < PVDEP; ++i) PV_LD(i);
    __builtin_amdgcn_sched_group_barrier(0x100, 2 * PVDEP, 0);
#pragma unroll
    for (int i = 0; i < NF; ++i) {
        if (i + PVDEP < NF) PV_LD(i + PVDEP);
#pragma unroll
        for (int s = 0; s < NS; ++s) o[s][i % ND] = __builtin_amdgcn_mfma_f32_32x32x16_bf16(__builtin_bit_cast(bf16x8, pf[s][i / ND]), vf[i], o[s][i % ND], 0, 0, 0);
        if (i + PVDEP < NF) __builtin_amdgcn_sched_group_barrier(0x100, 2, 0);
        __builtin_amdgcn_sched_group_barrier(0x008, NS, 0);
    }
#undef PV_LD
    __builtin_amdgcn_s_setprio(0);
}
template <int NS, int ND>
__device__ __forceinline__ void attn_unit_pp(ATT_LAS unsigned char* lds, const unsigned short* PROJ, unsigned short* Y, const TileSeq ts, int qrow, int qcol, int kcol, int vcol, int ycol,
                                             float lam, const float* subg, float oml, int tid) {
    constexpr int KB = NS * 8192, VB = ND * 4096, OFF_V = 2 * KB, OFF_Q = 2 * KB + 3 * VB, OFF_W = OFF_Q + 8 * NS * 4096;
    const int lane = tid & 63, r32 = lane & 31, hi = lane >> 5; const int wave = __builtin_amdgcn_readfirstlane(tid >> 6); const bool grpB = wave >= 4;
    ATT_LAS unsigned char* Qs = lds + OFF_Q + wave * (NS * 4096);
    ATT_LAS float* wsf = (ATT_LAS float*)(lds + OFF_W) + wave * 64;
#define PP_ISSUE(t_, kslot_, vslot_) do { int ka_; const int kr_ = ts.row((t_), ka_); \
        _Pragma("unroll") for (int i_ = 0; i_ < NS; ++i_) { const int p_ = wave + 8 * i_, s_ = p_ >> 3, c_ = p_ & 7; \
            dma16(PROJ + (size_t)(kr_ + lane) * 2560 + kcol + 64 * s_ + 8 * c_, lds + (kslot_) * KB + s_ * 8192 + c_ * 1024); } \
        _Pragma("unroll") for (int i_ = 0; i_ < ND / 2; ++i_) { const int p_ = wave + 8 * i_, db_ = p_ >> 2, rg_ = p_ & 3; \
            dma16(PROJ + (size_t)(kr_ + 16 * rg_ + (lane >> 2)) * 2560 + vcol + 32 * db_ + 8 * (lane & 3), lds + OFF_V + (vslot_) * VB + (db_ * 4 + rg_) * 1024); } } while (0)
    PP_ISSUE(0, 0, 0);
#pragma unroll
    for (int s = 0; s < NS; ++s)
#pragma unroll
        for (int d0 = 0; d0 < 4; ++d0) *(ATT_LAS bf16x8*)(Qs + (s * 8 + 2 * d0 + hi) * 512 + r32 * 16) = *(const bf16x8*)(PROJ + (size_t)(qrow + r32) * 2560 + qcol + 64 * s + 16 * d0 + 8 * hi);
    f32x16 o[NS][ND];
#pragma unroll
    for (int s = 0; s < NS; ++s)
#pragma unroll
        for (int d = 0; d < ND; ++d)
#pragma unroll
            for (int r = 0; r < 16; ++r) o[s][d][r] = 0.f;
    float mref[NS], lsum[NS];
#pragma unroll
    for (int s = 0; s < NS; ++s) { mref[s] = 0.f; lsum[s] = 0.f; }
    u32x4 pf[NS][4];
#pragma unroll
    for (int s = 0; s < NS; ++s)
#pragma unroll
        for (int k = 0; k < 4; ++k) pf[s][k] = (u32x4){0u, 0u, 0u, 0u};
    const int koff = hi * 1024 + r32 * 16;
    const int voff = ((lane >> 4) & 1) * 32 + (lane & 3) * 8 + (4 * hi + ((lane & 15) >> 2)) * 64;
#define PP_QKSM(Ks_, MID_) do { \
        _Pragma("unroll") for (int s = 0; s < NS; ++s) { \
            f32x16 p0, p1; \
            _Pragma("unroll") for (int r = 0; r < 16; ++r) { p0[r] = -mref[s]; p1[r] = -mref[s]; } \
            bf16x8 kA_[4], kB_[4], qq_[4];        \
            _Pragma("unroll") for (int d0 = 0; d0 < 2; ++d0) { \
                kA_[d0] = *(const ATT_LAS bf16x8*)((Ks_) + s * 8192 + koff + d0 * 2048); kB_[d0] = *(const ATT_LAS bf16x8*)((Ks_) + s * 8192 + koff + d0 * 2048 + 512); \
                qq_[d0] = *(const ATT_LAS bf16x8*)(Qs + (s * 8 + 2 * d0 + hi) * 512 + r32 * 16); } \
            __builtin_amdgcn_sched_group_barrier(0x100, 6, 0); \
            _Pragma("unroll") for (int d0 = 0; d0 < 4; ++d0) { \
                if (d0 + 2 < 4) { kA_[d0 + 2] = *(const ATT_LAS bf16x8*)((Ks_) + s * 8192 + koff + (d0 + 2) * 2048); kB_[d0 + 2] = *(const ATT_LAS bf16x8*)((Ks_) + s * 8192 + koff + (d0 + 2) * 2048 + 512); \
                    qq_[d0 + 2] = *(const ATT_LAS bf16x8*)(Qs + (s * 8 + 2 * (d0 + 2) + hi) * 512 + r32 * 16); } \
                p0 = __builtin_amdgcn_mfma_f32_32x32x16_bf16(kA_[d0], qq_[d0], p0, 0, 0, 0); \
                p1 = __builtin_amdgcn_mfma_f32_32x32x16_bf16(kB_[d0], qq_[d0], p1, 0, 0, 0); \
                __builtin_amdgcn_sched_group_barrier(0x008, 2, 0); \
                if (d0 + 2 < 4) __builtin_amdgcn_sched_group_barrier(0x100, 3, 0); } \
            float rm; { float a_ = ATT_MX3(p0[0], p0[1], p1[0]), b_ = ATT_MX3(p0[2], p0[3], p1[1]); a_ = ATT_MX3(a_, p1[2], p1[3]); \
                _Pragma("unroll") for (int r = 4; r < 16; r += 4) { a_ = ATT_MX3(a_, p0[r], p0[r + 1]); b_ = ATT_MX3(b_, p0[r + 2], p0[r + 3]); a_ = ATT_MX3(a_, p1[r], p1[r + 1]); b_ = ATT_MX3(b_, p1[r + 2], p1[r + 3]); } \
                rm = __builtin_fmaxf(a_, b_); } \
            rm = swapmax(rm); \
            if (__any(rm > THR || firstf != 0.f)) { const float dl = fmaxf(rm, (firstf != 0.f) ? -100.f : 0.f), f = __builtin_amdgcn_exp2f(-dl); mref[s] += dl; lsum[s] *= f; \
                _Pragma("unroll") for (int r = 0; r < 16; ++r) { p0[r] -= dl; p1[r] -= dl; } \
                if (hi == 0) wsf[r32] = f; \
                _Pragma("unroll") for (int r = 0; r < 16; ++r) { const float fr = wsf[crow(r, hi)]; _Pragma("unroll") for (int d = 0; d < ND; ++d) o[s][d][r] *= fr; } } \
            float sacc = lsum[s];        \
            _Pragma("unroll") for (int r = 0; r < 16; ++r) { p0[r] = __builtin_amdgcn_exp2f(p0[r]); p1[r] = __builtin_amdgcn_exp2f(p1[r]); sacc = sacc + p0[r]; sacc = sacc + p1[r]; } \
            lsum[s] = sacc; \
            pf[s][0] = (u32x4){cvtpk(p0[0], p0[1]), cvtpk(p0[2], p0[3]), cvtpk(p0[4], p0[5]), cvtpk(p0[6], p0[7])}; \
            pf[s][1] = (u32x4){cvtpk(p0[8], p0[9]), cvtpk(p0[10], p0[11]), cvtpk(p0[12], p0[13]), cvtpk(p0[14], p0[15])}; \
            pf[s][2] = (u32x4){cvtpk(p1[0], p1[1]), cvtpk(p1[2], p1[3]), cvtpk(p1[4], p1[5]), cvtpk(p1[6], p1[7])}; \
            pf[s][3] = (u32x4){cvtpk(p1[8], p1[9]), cvtpk(p1[10], p1[11]), cvtpk(p1[12], p1[13]), cvtpk(p1[14], p1[15])}; \
            if (s == 0) { MID_; }        \
        } \
        firstf = 0.f; asm volatile("" : "+v"(firstf)); } while (0)
#define PP_TOP() do { asm volatile("s_waitcnt vmcnt(0)" ::: "memory"); asm volatile("s_waitcnt lgkmcnt(0)" ::: "memory"); __builtin_amdgcn_s_barrier(); asm volatile("" ::: "memory"); } while (0)
    int kst = 0, vst = 0, vprev = 2;
    float firstf = 1.f; asm volatile("" : "+v"(firstf));
    if (!grpB) {
        for (int t = 0; t < ts.nt; ++t) {
            PP_TOP();
            const int vnext = (vst == 2) ? 0 : vst + 1;
            PP_QKSM(lds + kst * KB, if (t + 1 < ts.nt) PP_ISSUE(t + 1, kst ^ 1, vnext));
            __builtin_amdgcn_sched_barrier(0);
            pv_step<NS, ND>(o, pf, lds + OFF_V + vst * VB + voff);
            vst = vnext; kst ^= 1;
        }
    } else {
        for (int t = 0; t < ts.nt; ++t) {
            PP_TOP();
            const int vnext = (vst == 2) ? 0 : vst + 1;
            if (t > 0) pv_step<NS, ND>(o, pf, lds + OFF_V + vprev * VB + voff);
            __builtin_amdgcn_sched_barrier(0);
            PP_QKSM(lds + kst * KB, if (t + 1 < ts.nt) PP_ISSUE(t + 1, kst ^ 1, vnext));
            vprev = vst; vst = vnext; kst ^= 1;
        }
        pv_step<NS, ND>(o, pf, lds + OFF_V + vprev * VB + voff);
    }
#undef PP_QKSM
#undef PP_TOP
#undef PP_ISSUE
    unsigned lz_ = 0u; asm volatile("" : "+v"(lz_)); const int lane_e = (int)__builtin_amdgcn_mbcnt_hi(~0u, __builtin_amdgcn_mbcnt_lo(~0u, lz_));
    const int r32e = lane_e & 31, hie = lane_e >> 5;
    float inv[NS][16];
#pragma unroll
    for (int s = 0; s < NS; ++s) {
        const float lt = swapsum(lsum[s]);
        if (hie == 0) wsf[s * 32 + r32e] = 1.0f / lt;
    }
#pragma unroll
    for (int s = 0; s < NS; ++s)
#pragma unroll
        for (int r = 0; r < 16; ++r) inv[s][r] = wsf[s * 32 + crow(r, hie)];
    if (NS == 1) {
#pragma unroll
        for (int r = 0; r < 16; ++r) { unsigned short* yp = Y + (size_t)(qrow + crow(r, hie)) * 1024 + ycol + r32e;
#pragma unroll
            for (int d = 0; d < ND; ++d) yp[32 * d] = f2bf(o[0][d][r] * inv[0][r]); }
    } else {
        float gsub[ND];
#pragma unroll
        for (int d = 0; d < ND; ++d) gsub[d] = subg[32 * d + r32e] * oml;
#pragma unroll
        for (int r = 0; r < 16; ++r) {
            float ss = 0.f; float ov[ND];
#pragma unroll
            for (int d = 0; d < ND; ++d) { ov[d] = o[0][d][r] * inv[0][r] - lam * (o[NS - 1][d][r] * inv[NS - 1][r]); ss += ov[d] * ov[d]; }
            ss = xl_x16_sum(xl_row16_sum(ss));
            const float rstd = 1.0f / sqrtf(ss * (1.0f / (32 * ND)) + 1e-6f);
#pragma unroll
            for (int d = 0; d < ND; ++d) *(ATT_LAS unsigned short*)(Qs + crow(r, hie) * (64 * ND) + (32 * d + r32e) * 2) = f2bf(ov[d] * rstd * gsub[d]);
        }
        AT_ROWS_OUT(Qs, ND, Y, qrow, ycol, lane_e);
    }
    asm volatile("s_waitcnt lgkmcnt(0)" ::: "memory");
    __builtin_amdgcn_s_barrier();
    asm volatile("" ::: "memory");
}
}

namespace lru {
typedef short bf16x8 __attribute__((ext_vector_type(8)));
typedef float f32x4 __attribute__((ext_vector_type(4)));
typedef unsigned u32x4 __attribute__((ext_vector_type(4)));
#define LRU_LAS __attribute__((address_space(3)))
constexpr int LXS = 528, UBS = 528, HSS = 1040;
constexpr int OFF_HS = 0, OFF_LX = 0, OFF_UB = 66560, OFF_HIN = 66560 + 33792;
__device__ __forceinline__ float sxl(float v, int srclane) { return __int_as_float(__builtin_amdgcn_ds_bpermute(srclane << 2, __float_as_int(v))); }
__device__ __forceinline__ float fsig(float x) { return __builtin_amdgcn_rcpf(1.0f + __builtin_amdgcn_exp2f(-1.4426950408889634f * x)); }


template <bool FINAL, int DIR>
__device__ __forceinline__ void lru_scan_part(LRU_LAS unsigned char* lds, const unsigned short* WL, const float* br, const float* bi, const float* lruc, float* SUMM, unsigned* PH, int rowbase, int b, int ck, int blk, int lane, int nt0, int nt1) {
    constexpr int dir = DIR;
    const int c16 = lane & 15, g = lane >> 4;
    const unsigned short* wbase = WL + (size_t)((dir * 4 + blk) * 2) * 4096;
    bf16x8 bwn[2][2]; float brn, bin_, cdn;
#define LRU_LOADW(nt_) do { const int chn_ = blk * 64 + 16 * (nt_) + c16; \
        _Pragma("unroll") for (int gt = 0; gt < 2; ++gt) _Pragma("unroll") for (int ks = 0; ks < 2; ++ks) bwn[gt][ks] = *(const bf16x8*)(wbase + (size_t)gt * 4096 + (16 * (nt_) + c16) * 64 + 32 * ks + 8 * g); \
        brn = br[dir * 256 + chn_]; bin_ = bi[dir * 256 + chn_]; cdn = lruc[dir * 256 + chn_]; } while (0)
    LRU_LOADW(nt0);
#pragma unroll 2
    for (int nt = nt0; nt < nt1; ++nt) {
        const int ch = blk * 64 + 16 * nt + c16;
        bf16x8 bw[2][2];
#pragma unroll
        for (int gt = 0; gt < 2; ++gt)
#pragma unroll
            for (int ks = 0; ks < 2; ++ks) bw[gt][ks] = bwn[gt][ks];
        const float brv = brn, biv = bin_, cdec = cdn;
        if (nt + 1 < nt1) LRU_LOADW(nt + 1);
        f32x4 ar[4], ai[4];
#pragma unroll
        for (int m = 0; m < 4; ++m) {
            ar[m] = (f32x4){0.f, 0.f, 0.f, 0.f}; ai[m] = ar[m];
#pragma unroll
            for (int ks = 0; ks < 2; ++ks) { const bf16x8 af = *(const LRU_LAS bf16x8*)(lds + OFF_UB + (16 * m + c16) * UBS + (blk * 64 + 32 * ks + 8 * g) * 2);
                ar[m] = __builtin_amdgcn_mfma_f32_16x16x32_bf16(af, bw[0][ks], ar[m], 0, 0, 0); ai[m] = __builtin_amdgcn_mfma_f32_16x16x32_bf16(af, bw[1][ks], ai[m], 0, 0, 0); }
        }
        float Pi[4][4], Hi[4][4], Ps[4], Hs[4];
#pragma unroll
        for (int m = 0; m < 4; ++m) {
            float P = 1.f, Hh = 0.f;
#pragma unroll
            for (int ee = 0; ee < 4; ++ee) { constexpr int dummy = 0; const int e = dir ? 3 - ee : ee;
                const int tok = 16 * m + 4 * g + e;
                const float r = fsig(ar[m][e] + brv), iv = fsig(ai[m][e] + biv), la = r * cdec, a = __builtin_amdgcn_exp2f(1.4426950408889634f * la);
                const float uval = __uint_as_float((unsigned)(*(const LRU_LAS unsigned short*)(lds + OFF_UB + tok * UBS + ch * 2)) << 16);
                const float bb = __builtin_amdgcn_sqrtf((1.f - a) * (1.f + a)) * iv * uval;
                Hh = a * Hh + bb; P = P * a; Pi[m][e] = P; Hi[m][e] = Hh; }
            Ps[m] = P; Hs[m] = Hh;
        }
        float Pc = 1.f, Hc = 0.f;
#pragma unroll
        for (int mm = 0; mm < 4; ++mm) { const int m = dir ? 3 - mm : mm;
            const float P0 = Ps[m], H0 = Hs[m];
            float Pq, Hq;
            { auto rp = __builtin_amdgcn_permlane16_swap(__float_as_uint(P0), __float_as_uint(P0), false, false); auto rh = __builtin_amdgcn_permlane16_swap(__float_as_uint(H0), __float_as_uint(H0), false, false);
              Pq = __uint_as_float((g & 1) ? rp[0] : rp[1]); Hq = __uint_as_float((g & 1) ? rh[0] : rh[1]); }
            const bool second = dir ? ((g & 1) == 0) : ((g & 1) == 1);
            const float Pf = second ? Pq : P0, Hf = second ? Hq : H0, Psd = second ? P0 : Pq, Hsd = second ? H0 : Hq;
            const float PT = Psd * Pf, HT = Psd * Hf + Hsd;
            float Pe = second ? Pq : 1.f, He = second ? Hq : 0.f;
            float PTq, HTq;
            { auto rp = __builtin_amdgcn_permlane32_swap(__float_as_uint(PT), __float_as_uint(PT), false, false); auto rh = __builtin_amdgcn_permlane32_swap(__float_as_uint(HT), __float_as_uint(HT), false, false);
              PTq = __uint_as_float((g & 2) ? rp[0] : rp[1]); HTq = __uint_as_float((g & 2) ? rh[0] : rh[1]); }
            const bool later = dir ? (g < 2) : (g >= 2);
            if (later) { He = Pe * HTq + He; Pe = Pe * PTq; }
            const float Pt = PT * PTq, Ht = later ? (PT * HTq + HT) : (PTq * HT + HTq);
            { const float Pb = Pe * Pc, Hb = Pe * Hc + He;
#pragma unroll
              for (int e = 0; e < 4; ++e) { const int tok = 16 * m + 4 * g + e; const float pt = Pi[m][e] * Pb, ht = Pi[m][e] * Hb + Hi[m][e];
                  PH[((size_t)dir * 17408 + rowbase + tok) * 256 + ch] = cvtpk2(pt, ht); } }
            Hc = Pt * Hc + Ht; Pc = Pt * Pc;
        }
        if (!FINAL) { if (g == 0) { float2 o; o.x = Pc; o.y = Hc; *(float2*)(SUMM + ((size_t)(b * 2 + dir) * 68 + ck) * 512 + 2 * ch) = o; } }
    }
#undef LRU_LOADW
}
template <bool FINAL>
__device__ __forceinline__ void lru_unit(LRU_LAS unsigned char* lds, const unsigned short* PROJ, unsigned short* Y, const unsigned short* WL, const float* cw, const float* cb,
                                         const float* br, const float* bi, const float* lruc, float* SUMM, unsigned* PH, int b, int ck, int mode, int tid) {
    const int lane = tid & 63; const int wave = __builtin_amdgcn_readfirstlane(tid >> 6);
    const int seqbase = (ck < 4) ? 16384 + b * 256 : b * 4096, pos0 = (ck < 4) ? 64 * ck : 64 * (ck - 4), len = (ck < 4) ? 256 : 4096;
    {
        u32x4 v[5];
#pragma unroll
        for (int k = 0; k < 5; ++k) { int it = tid + 512 * k; it = (it < 67 * 32) ? it : 67 * 32 - 1; const int i = it >> 5, c = it & 31, p = pos0 - 2 + i; const int pc = p < 0 ? 0 : (p >= len ? len - 1 : p);
            v[k] = *(const u32x4*)(PROJ + (size_t)(seqbase + pc) * 2560 + 8 * c); }
#pragma unroll
        for (int k = 0; k < 5; ++k) { const int it = tid + 512 * k; const int i = it >> 5, c = it & 31, p = pos0 - 2 + i; const bool ok = (p >= 0 && p < len);
            const u32x4 z = {0u, 0u, 0u, 0u}; if (it < 67 * 32) *(LRU_LAS u32x4*)(lds + OFF_LX + i * LXS + c * 16) = ok ? v[k] : z; }
    }
    __syncthreads();
    {
        const int ch2 = tid & 127, tg = tid >> 7; float w0[4], w1[4];
#pragma unroll
        for (int k = 0; k < 4; ++k) { w0[k] = cw[k * 256 + 2 * ch2]; w1[k] = cw[k * 256 + 2 * ch2 + 1]; }
        const float b0 = cb[2 * ch2], b1 = cb[2 * ch2 + 1];
        float x0[4], x1[4];
#pragma unroll
        for (int k = 0; k < 3; ++k) { const unsigned v = *(const LRU_LAS unsigned*)(lds + OFF_LX + (tg * 16 + k) * LXS + ch2 * 4); x0[k + 1] = __uint_as_float(v << 16); x1[k + 1] = __uint_as_float(v & 0xffff0000u); }
#pragma unroll
        for (int t = 0; t < 16; ++t) {
            x0[0] = x0[1]; x0[1] = x0[2]; x0[2] = x0[3]; x1[0] = x1[1]; x1[1] = x1[2]; x1[2] = x1[3];
            const unsigned v = *(const LRU_LAS unsigned*)(lds + OFF_LX + (tg * 16 + t + 3) * LXS + ch2 * 4); x0[3] = __uint_as_float(v << 16); x1[3] = __uint_as_float(v & 0xffff0000u);
            const float u0 = b0 + w0[0] * x0[0] + w0[1] * x0[1] + w0[2] * x0[2] + w0[3] * x0[3], u1 = b1 + w1[0] * x1[0] + w1[1] * x1[1] + w1[2] * x1[2] + w1[3] * x1[3];
            *(LRU_LAS unsigned*)(lds + OFF_UB + (tg * 16 + t) * UBS + ch2 * 4) = cvtpk2(u0, u1);
        }
    }
    __syncthreads();
    { const int dsel = (mode == 0) ? (wave & 1) : (mode - 1), nt0 = (mode == 0) ? 0 : 2 * (wave & 1), nt1 = (mode == 0) ? 4 : nt0 + 2;
      if (dsel) lru_scan_part<FINAL, 1>(lds, WL, br, bi, lruc, SUMM, PH, seqbase + pos0, b, ck, wave >> 1, lane, nt0, nt1);
      else      lru_scan_part<FINAL, 0>(lds, WL, br, bi, lruc, SUMM, PH, seqbase + pos0, b, ck, wave >> 1, lane, nt0, nt1); }
    __syncthreads();
}

__device__ __forceinline__ void lru_final_unit(LRU_LAS unsigned char* lds, const unsigned short* PROJ, unsigned short* Y, const float* SUMM, const unsigned* PH, int b, int ck, int tid) {
    const int seqbase = (ck < 4) ? 16384 + b * 256 : b * 4096, pos0 = (ck < 4) ? 64 * ck : 64 * (ck - 4);
    { const int ch = tid & 255, dir = tid >> 8; const float* sp = SUMM + ((size_t)(b * 2 + dir) * 68) * 512 + 2 * ch;
      const int np = dir ? ((ck < 4) ? 3 - ck : 4 + (67 - ck)) : ck; float hin = 0.f;
      for (int p0 = 0; p0 < np; p0 += 16) { float2 v[16];
#pragma unroll
          for (int j = 0; j < 16; ++j) { int p = p0 + j; p = (p < np) ? p : np - 1; const int c = dir ? ((p < 4) ? 3 - p : 67 - (p - 4)) : p; v[j] = *(const float2*)(sp + (size_t)c * 512); }
#pragma unroll
          for (int j = 0; j < 16; ++j) { const bool ok = (p0 + j) < np; const float px = ok ? v[j].x : 1.f, hy = ok ? v[j].y : 0.f; hin = px * hin + hy; } }
      *(LRU_LAS float*)(lds + tid * 4) = hin; }
    __syncthreads();
    const int tok = tid >> 3, cg = tid & 7; const size_t row = (size_t)seqbase + pos0 + tok;
    u32x4 F0[4], F1[4], R0[4], R1[4], LG[4];
#pragma unroll
    for (int j = 0; j < 4; ++j) { const int c0 = 8 * cg + 64 * j;
        F0[j] = *(const u32x4*)(PH + row * 256 + c0); F1[j] = *(const u32x4*)(PH + row * 256 + c0 + 4); R0[j] = *(const u32x4*)(PH + ((size_t)17408 + row) * 256 + c0); R1[j] = *(const u32x4*)(PH + ((size_t)17408 + row) * 256 + c0 + 4);
        LG[j] = *(const u32x4*)(PROJ + row * 2560 + 256 + c0); }
#pragma unroll
    for (int j = 0; j < 4; ++j) { const int c0 = 8 * cg + 64 * j;
        const u32x4 f0 = F0[j], f1 = F1[j], r0 = R0[j], r1 = R1[j];
        const u32x4 lg = LG[j];
        const unsigned ff[8] = {f0.x, f0.y, f0.z, f0.w, f1.x, f1.y, f1.z, f1.w}, rr[8] = {r0.x, r0.y, r0.z, r0.w, r1.x, r1.y, r1.z, r1.w}; const unsigned lgw[4] = {lg.x, lg.y, lg.z, lg.w};
        float y[8];
#pragma unroll
        for (int k = 0; k < 8; ++k) { const float hf = *(const LRU_LAS float*)(lds + (c0 + k) * 4), hr = *(const LRU_LAS float*)(lds + (256 + c0 + k) * 4);
            const float h = (__uint_as_float(ff[k] & 0xffff0000u) + __uint_as_float(ff[k] << 16) * hf) + (__uint_as_float(rr[k] & 0xffff0000u) + __uint_as_float(rr[k] << 16) * hr);
            const float g = (k & 1) ? __uint_as_float(lgw[k >> 1] & 0xffff0000u) : __uint_as_float(lgw[k >> 1] << 16); y[k] = h * g; }
        u32x4 o; o.x = cvtpk2(y[0], y[1]); o.y = cvtpk2(y[2], y[3]); o.z = cvtpk2(y[4], y[5]); o.w = cvtpk2(y[6], y[7]);
        *(u32x4*)(Y + row * 1024 + c0) = o; }
    __syncthreads();
}
}

#include <utility>
constexpr int NWAVES = 8;
constexpr int RING_OFF = 0, RING_BYTES = 150528;
constexpr int LDSCTL_OFF = RING_BYTES, MISC_OFF = LDSCTL_OFF + 320;
constexpr int LDS_BYTES = 155648;
constexpr int CW_BAR = 4096;
constexpr int MAX_LAUNCHES = 16;
static_assert((CW_BAR + MAX_LAUNCHES * XCD_BAR_WORDS) * 4 <= (int)(1u << 20), "CTL words inside the memset region");

constexpr int PH_PRO = 0, PH_PRO2 = 1, PH_L0 = 2, PH_PER_LAYER = 11, PH_FINAL = PH_L0 + 2 * PH_PER_LAYER, NPH = PH_FINAL + 1;
constexpr int EPI_OFF = LDSCTL_OFF + 1024;

#ifndef MK_REPEAT_PH
#define MK_REPEAT_PH (-1)
#endif
struct Args { const float* in[24]; float* out; unsigned char* ws; int ph_lo, ph_hi, li, rep; };

__device__ __forceinline__ float shfl_xor_l(float v, int mask, int lane) { return __int_as_float(__builtin_amdgcn_ds_bpermute((lane ^ mask) << 2, __float_as_int(v))); }
__device__ __forceinline__ float wave_sum(float v, int) { return xl_x32_sum(xl_x16_sum(xl_row16_sum(v))); }
__device__ __forceinline__ unsigned pk2(float lo, float hi) { return cvtpk2(lo, hi); }

__device__ __forceinline__ void p0_transpose_item(const float* W, int K, int N, bf16_t* WT, int kind, LAS float* scr, int item, int lane) {
    const int nblk = N / 64, kb = item / nblk, nb = item % nblk, k0 = 64 * kb, n0 = 64 * nb;
    const int rr = lane >> 4, cq = lane & 15;
    f32x4 v[16];
#pragma unroll
    for (int i = 0; i < 16; ++i) v[i] = *(const f32x4*)(W + (size_t)(k0 + 4 * i + rr) * N + n0 + 4 * cq);
#pragma unroll
    for (int i = 0; i < 16; ++i) { LAS float* p = scr + (4 * i + rr) * 65 + 4 * cq; p[0] = v[i].x; p[1] = v[i].y; p[2] = v[i].z; p[3] = v[i].w; }
    LDS_WAIT(); asm volatile("" ::: "memory");
    const int c = lane & 7;
#pragma unroll
    for (int j = 0; j < 8; ++j) { const int n = (lane >> 3) + 8 * j; const LAS float* s = scr + (8 * c) * 65 + n;
        v4u o; o.x = pk2(s[0 * 65], s[1 * 65]); o.y = pk2(s[2 * 65], s[3 * 65]); o.z = pk2(s[4 * 65], s[5 * 65]); o.w = pk2(s[6 * 65], s[7 * 65]);
        *(GAS v4u*)(WT + wt_off(dest_row(kind, n0 + n), k0 + 8 * c, K)) = o; }
    LDS_WAIT(); asm volatile("" ::: "memory");
}

struct ConvDesc { const float* W; bf16_t* WT; int K, N, kind, item; };
__device__ __forceinline__ void p0_load(const ConvDesc& d, f32x4 (&v)[16], int lane) {
    const int nblk = d.N / 64, kb = d.item / nblk, nb = d.item % nblk, k0 = 64 * kb, n0 = 64 * nb; const int rr = lane >> 4, cq = lane & 15;
#pragma unroll
    for (int i = 0; i < 16; ++i) v[i] = *(const f32x4*)(d.W + (size_t)(k0 + 4 * i + rr) * d.N + n0 + 4 * cq);
}
__device__ __forceinline__ void p0_finish(const ConvDesc& d, const f32x4 (&v)[16], LAS float* scr, int lane) {
    const int nblk = d.N / 64, kb = d.item / nblk, nb = d.item % nblk, k0 = 64 * kb, n0 = 64 * nb; const int rr = lane >> 4, cq = lane & 15;
#pragma unroll
    for (int i = 0; i < 16; ++i) { LAS float* p = scr + (4 * i + rr) * 65 + 4 * cq; p[0] = v[i].x; p[1] = v[i].y; p[2] = v[i].z; p[3] = v[i].w; }
    LDS_WAIT(); asm volatile("" ::: "memory");
    const int c = lane & 7;
#pragma unroll
    for (int j = 0; j < 8; ++j) { const int n = (lane >> 3) + 8 * j; const LAS float* s = scr + (8 * c) * 65 + n;
        v4u o; o.x = pk2(s[0 * 65], s[1 * 65]); o.y = pk2(s[2 * 65], s[3 * 65]); o.z = pk2(s[4 * 65], s[5 * 65]); o.w = pk2(s[6 * 65], s[7 * 65]);
        *(GAS v4u*)(d.WT + wt_off(dest_row(d.kind, n0 + n), k0 + 8 * c, d.K)) = o; }
    LDS_WAIT(); asm volatile("" ::: "memory");
}

__device__ __forceinline__ void norm_row(const float* src, const float* g, const float* shift, const float* scale, bf16_t* orow, int lane) {
    const f32x4* xr = (const f32x4*)src + lane; f32x4 v[4]; float s = 0.f;
#pragma unroll
    for (int j = 0; j < 4; ++j) { v[j] = xr[64 * j]; s += (v[j].x * v[j].x + v[j].y * v[j].y) + (v[j].z * v[j].z + v[j].w * v[j].w); }
    const float rstd = 1.0f / sqrtf(wave_sum(s, lane) * (1.0f / D) + 1e-6f);
    unsigned long long* o8 = (unsigned long long*)orow + lane;
#pragma unroll
    for (int j = 0; j < 4; ++j) { const int c0 = (lane + 64 * j) * 4; const f32x4 gg = *(const f32x4*)(g + c0), sc = *(const f32x4*)(scale + c0), sh = *(const f32x4*)(shift + c0);
        const f32x4 y = v[j] * rstd * gg * (sc + 1.0f) + sh;
        o8[64 * j] = (unsigned long long)pk2(y.x, y.y) | ((unsigned long long)pk2(y.z, y.w) << 32); }
}

__device__ __forceinline__ void norm_regs(const f32x4 (&v)[4], const float* g, const float* shift, const float* scale, bf16_t* orow, int lane) {
    float s = 0.f;
#pragma unroll
    for (int j = 0; j < 4; ++j) s += (v[j].x * v[j].x + v[j].y * v[j].y) + (v[j].z * v[j].z + v[j].w * v[j].w);
    const float rstd = 1.0f / sqrtf(wave_sum(s, lane) * (1.0f / D) + 1e-6f);
    unsigned long long* o8 = (unsigned long long*)orow + lane;
#pragma unroll
    for (int j = 0; j < 4; ++j) { const int c0 = (lane + 64 * j) * 4; const f32x4 gg = *(const f32x4*)(g + c0), sc = *(const f32x4*)(scale + c0), sh = *(const f32x4*)(shift + c0);
        const f32x4 y = v[j] * rstd * gg * (sc + 1.0f) + sh;
        o8[64 * j] = (unsigned long long)pk2(y.x, y.y) | ((unsigned long long)pk2(y.z, y.w) << 32); }
}

constexpr int I_GU = (D / 64) * (2 * DFF / 64), I_DN = (DFF / 64) * (D / 64), I_IN = (D / 64) * (NIN / 64), I_OUT = (D / 64) * (D / 64);
constexpr int R_GU1 = 0, R_GU2 = I_GU, R_DN1 = 2 * I_GU, R_DN2 = R_DN1 + I_DN, R_IN = R_DN2 + I_DN, R_OUT = R_IN + I_IN, I_LAYER = R_OUT + I_OUT;

struct KCtx { LAS unsigned char* lds; unsigned char* ws; float* out; const __attribute__((address_space(4))) unsigned long long* kin; int wave0, vcu, G, bx, ph_lo, ph_end; XcdBarrier bar; };
#define tidq() ({ int tq_ = tid; asm volatile("" : "+v"(tq_)); tq_; })
#define KIN(i) ((const float*)(const GAS float*)(kin[(i) + kz]))
template <int PHI> __device__ __forceinline__ void run_phase(const KCtx& kc) {
    if (PHI < kc.ph_lo || PHI >= kc.ph_end) return;
    constexpr int ph = (MK_REPEAT_PH >= 0 && PHI > MK_REPEAT_PH) ? PHI - 1 : PHI;
    LAS unsigned char* lds = kc.lds; unsigned char* ws = kc.ws; const __attribute__((address_space(4))) unsigned long long* kin = kc.kin;
    const int wave0 = kc.wave0, vcu = kc.vcu, G = kc.G, bx = kc.bx, NGW = kc.G * NWAVES;
    struct { float* out; } args; args.out = kc.out;
        unsigned lz = 0u; asm volatile("" : "+v"(lz)); const int lane_o = (int)__builtin_amdgcn_mbcnt_hi(~0u, __builtin_amdgcn_mbcnt_lo(~0u, lz));
        const int lane = lane_o, wave = wave0, tid = wave0 * 64 + lane_o, gw = vcu * NWAVES + wave;
        int kz = 0; asm volatile("" : "+s"(kz));
        unsigned long long wsi = (unsigned long long)ws; asm volatile("" : "+s"(wsi)); unsigned char* wsp = (unsigned char*)(GAS unsigned char*)wsi;
        float* MOD = (float*)(wsp + WS_MOD); Tab* T = (Tab*)(wsp + WS_TAB); bf16_t* W = (bf16_t*)(wsp + WS_W); float* H = (float*)(wsp + WS_H);
        bf16_t* HB = (bf16_t*)(wsp + WS_R); bf16_t* PROJ = (bf16_t*)(wsp + WS_R + R_PROJ); bf16_t* Y = (bf16_t*)(wsp + WS_R + R_Y);
        unsigned long long outi = (unsigned long long)args.out; asm volatile("" : "+s"(outi)); float* outp = (float*)(GAS float*)outi; bf16_t* XN = (bf16_t*)outp;
        auto conv_desc = [&](int l, int r) -> ConvDesc {
            const float* src; int K_, N_, kind; size_t off;
            if (r < R_GU2)      {             src = KIN(7)  + (size_t)l * D * 2 * DFF; K_ = D;   N_ = 2 * DFF; kind = 1; off = OFF_GU1; }
            else if (r < R_DN1) { r -= R_GU2; src = KIN(9)  + (size_t)l * D * 2 * DFF; K_ = D;   N_ = 2 * DFF; kind = 1; off = OFF_GU2; }
            else if (r < R_DN2) { r -= R_DN1; src = KIN(8)  + (size_t)l * DFF * D;     K_ = DFF; N_ = D;       kind = 0; off = OFF_DN1; }
            else if (r < R_IN)  { r -= R_DN2; src = KIN(10) + (size_t)l * DFF * D;     K_ = DFF; N_ = D;       kind = 0; off = OFF_DN2; }
            else if (r < R_OUT) { r -= R_IN;  src = KIN(11) + (size_t)l * D * NIN;     K_ = D;   N_ = NIN;     kind = 2; off = OFF_IN; }
            else                { r -= R_OUT; src = KIN(12) + (size_t)l * D * D;       K_ = D;   N_ = D;       kind = 0; off = OFF_OUT; }
            return ConvDesc{src, W + (size_t)l * W_LAYER + off, K_, N_, kind, r};
        };
        auto conv_range = [&](int l, int r0, int r1, int nb, int bi) {
            const int step = nb * NWAVES; int r = r0 + bi * NWAVES + wave; if (r >= r1) return;
            LAS float* scr = (LAS float*)(lds + wave * 16896);
            ConvDesc dc = conv_desc(l, r); f32x4 vc[16]; p0_load(dc, vc, lane);
            for (;;) {
                const int rn = r + step; const bool hn = rn < r1; ConvDesc dn = conv_desc(l, hn ? rn : r); f32x4 vn[16];
                if (hn) p0_load(dn, vn, lane);
                p0_finish(dc, vc, scr, lane);
                if (!hn) break;
#pragma unroll
                for (int i = 0; i < 16; ++i) vc[i] = vn[i];
                dc = dn; r = rn;
            }
        };
        auto sw_rows = [&](int l, int k, int nb, int bi) {
            const int N = (k == 1) ? NIN : 2 * DFF; const bf16_t* Wt = W + (size_t)l * W_LAYER + (k == 0 ? OFF_GU1 : k == 1 ? OFF_IN : OFF_GU2); float* SWp = (float*)(wsp + WS_SW) + (size_t)(l * 3 + k) * 4 * 5632;
            f32x4 sh[4][4];
#pragma unroll
            for (int b = 0; b < 4; ++b)
#pragma unroll
                for (int j = 0; j < 4; ++j) sh[b][j] = *(const f32x4*)(MOD + (size_t)l * 5 * NMODW + (size_t)b * NMODW + (3 * k) * D + lane * 16 + 4 * j);
            const int stride = nb * NWAVES;
            for (int p0 = bi * NWAVES + wave; p0 < N; p0 += 4 * stride) {
                int pr[4]; bool hv[4]; v4u w0[4], w1[4];
#pragma unroll
                for (int q = 0; q < 4; ++q) { pr[q] = p0 + q * stride; hv[q] = pr[q] < N; const int pc = hv[q] ? pr[q] : p0; w0[q] = *(const v4u*)(Wt + wt_off(pc, lane * 16, D)); w1[q] = *(const v4u*)(Wt + wt_off(pc, lane * 16 + 8, D)); }
                float a[4][4];
#pragma unroll
                for (int q = 0; q < 4; ++q) { const unsigned ww[8] = {w0[q].x, w0[q].y, w0[q].z, w0[q].w, w1[q].x, w1[q].y, w1[q].z, w1[q].w};
#pragma unroll
                    for (int b = 0; b < 4; ++b) a[q][b] = 0.f;
#pragma unroll
                    for (int j = 0; j < 8; ++j) { const float lo = __uint_as_float(ww[j] << 16), hi = __uint_as_float(ww[j] & 0xffff0000u);
#pragma unroll
                        for (int b = 0; b < 4; ++b) a[q][b] += lo * sh[b][j >> 1][(2 * j) & 3] + hi * sh[b][j >> 1][(2 * j + 1) & 3]; } }
#pragma unroll
                for (int q = 0; q < 4; ++q)
#pragma unroll
                    for (int b = 0; b < 4; ++b) { const float sa = wave_sum(a[q][b], lane); if (lane == 0 && hv[q]) SWp[(size_t)b * 5632 + pr[q]] = sa; }
            }
        };
        if (ph == PH_PRO) {
            const float* cc = KIN(1); const float* c_ctx = KIN(3); const float* w_ada = KIN(4); const float* b_ada = KIN(5);
            LAS float* sc = (LAS float*)lds; LAS float* red = (LAS float*)(lds + 20480);
            for (int i = tid; i < 5 * 1024; i += NWAVES * 64) { const int b = i >> 10, k = i & 1023; const float v = b < 4 ? cc[b * 1024 + k] : c_ctx[k]; sc[i] = v / (1.f + __expf(-v)); }
            __syncthreads();
            for (int item = bx; item < 288; item += G) {
                const int l = item / 144, col0 = (item % 144) * 64, cq = tid & 15, kg = tid >> 4;
                const float* wp = w_ada + (size_t)l * D * NMODW + (size_t)(kg * 32) * NMODW + col0 + 4 * cq;
                f32x4 a0 = {0, 0, 0, 0}, a1 = a0, a2 = a0, a3 = a0, a4 = a0;
#pragma unroll 8
                for (int k = 0; k < 32; ++k) { const f32x4 wv = *(const f32x4*)(wp + (size_t)k * NMODW); const int kk = kg * 32 + k;
                    a0 += wv * sc[kk]; a1 += wv * sc[1024 + kk]; a2 += wv * sc[2048 + kk]; a3 += wv * sc[3072 + kk]; a4 += wv * sc[4096 + kk]; }
                LAS f32x4* rp = (LAS f32x4*)(red + (size_t)kg * 320 + 4 * cq);
                rp[0] = a0; rp[16] = a1; rp[32] = a2; rp[48] = a3; rp[64] = a4;
                __syncthreads();
                if (tid < 320) { float s = 0.f;
#pragma unroll 8
                    for (int k = 0; k < 32; ++k) s += red[k * 320 + tid];
                    const int b = tid >> 6, cidx = tid & 63; MOD[(size_t)l * 5 * NMODW + (size_t)b * NMODW + col0 + cidx] = s + b_ada[l * NMODW + col0 + cidx]; }
                __syncthreads();
            }
            for (int i = (bx * NWAVES * 64 + tid); i < 2 * 65536; i += G * NWAVES * 64) {
                const int l = i >> 16, r = i & 65535; const int c = r & 63, d = (r >> 6) & 63, ri = (r >> 12) & 1, blk = (r >> 13) & 3, dir = r >> 15;
                const float* src = (ri ? KIN(17) : KIN(15)) + (size_t)l * 32768;
                W[(size_t)l * W_LAYER + OFF_LRU + r] = f2bf(src[((size_t)(dir * 4 + blk) * 64 + c) * 64 + d]);
            }
            conv_range(0, R_GU1, R_GU2, G, bx);
        } else if (ph == PH_FINAL) {
            const float* fg = KIN(23); const bf16_t* Hb = (const bf16_t*)(wsp + WS_H);
            typedef unsigned u32x2f __attribute__((ext_vector_type(2)));
            f32x4 g4[4];
#pragma unroll
            for (int j = 0; j < 4; ++j) g4[j] = *(const f32x4*)(fg + (lane + 64 * j) * 4);
            int row = gw; u32x2f cc[4], nn[4];
#define FN_LD(r_, w_) do { const u32x2f* hp_ = (const u32x2f*)(Hb + (size_t)(r_) * D) + lane; _Pragma("unroll") for (int j = 0; j < 4; ++j) (w_)[j] = hp_[64 * j]; } while (0)
            if (row < ML) FN_LD(row, cc);
            while (row < ML) { const int rn = row + NGW;
                if (rn < ML) FN_LD(rn, nn);
                f32x4 v[4]; float sq = 0.f;
#pragma unroll
                for (int j = 0; j < 4; ++j) { v[j] = (f32x4){__uint_as_float(cc[j].x << 16), __uint_as_float(cc[j].x & 0xffff0000u), __uint_as_float(cc[j].y << 16), __uint_as_float(cc[j].y & 0xffff0000u)};
                    sq += (v[j].x * v[j].x + v[j].y * v[j].y) + (v[j].z * v[j].z + v[j].w * v[j].w); }
                const float rstd = 1.0f / sqrtf(wave_sum(sq, lane) * (1.0f / D) + 1e-6f);
#pragma unroll
                for (int j = 0; j < 4; ++j) ((f32x4*)(outp + (size_t)row * D))[lane + 64 * j] = v[j] * rstd * g4[j];
#pragma unroll
                for (int j = 0; j < 4; ++j) cc[j] = nn[j];
                row = rn; }
#undef FN_LD
        } else if (ph == PH_PRO2) {
            float* GS = (float*)(wsp + WS_GS); float* SW = (float*)(wsp + WS_SW); float* SSQ = (float*)(wsp + WS_SSQ);
            for (int i = bx * NWAVES * 64 + tid; i < 2 * 3 * 5 * D; i += G * NWAVES * 64) { const int c = i & 1023, b = (i >> 10) % 5, k = ((i >> 10) / 5) % 3, l = (i >> 10) / 15;
                GS[i] = KIN(6)[(size_t)(l * 3 + k) * D + c] * (1.0f + MOD[(size_t)l * 5 * NMODW + (size_t)b * NMODW + (3 * k + 1) * D + c]); }
            sw_rows(0, 0, G, bx);
            { const float* x = KIN(0); const float* ctxp = KIN(2); const float* g0 = KIN(6);
              f32x4 gsv[4][2][2];
#pragma unroll
              for (int b = 0; b < 4; ++b)
#pragma unroll
                  for (int j = 0; j < 2; ++j)
#pragma unroll
                      for (int h = 0; h < 2; ++h) { const int c = 8 * lane + 512 * j + 4 * h; gsv[b][j][h] = *(const f32x4*)(g0 + c) * (*(const f32x4*)(MOD + (size_t)b * NMODW + D + c) + 1.0f); }
              f32x4 vc[2][2], vn[2][2];
#define P2_LD(r_, v_) do { const f32x4* xr_ = (const f32x4*)(x + (size_t)(r_) * D) + 2 * lane; \
                  _Pragma("unroll") for (int j = 0; j < 2; ++j) { (v_)[j][0] = xr_[128 * j]; (v_)[j][1] = xr_[128 * j + 1]; } } while (0)
              P2_LD(gw, vc);
#pragma unroll
              for (int k = 0; k < 8; ++k) { const int row = gw + k * 2048;
                  if (k + 1 < 8) P2_LD(row + 2048, vn);
                  float s = 0.f;
                  v4u* o16 = (v4u*)(XN + (size_t)row * D) + lane; v4u* h16 = (v4u*)((bf16_t*)H + (size_t)row * D) + lane;
#pragma unroll
                  for (int j = 0; j < 2; ++j) { const f32x4 a = vc[j][0], c = vc[j][1]; s += ((a.x * a.x + a.y * a.y) + (a.z * a.z + a.w * a.w)) + ((c.x * c.x + c.y * c.y) + (c.z * c.z + c.w * c.w));
                      v4u hw; hw.x = pk2(a.x, a.y); hw.y = pk2(a.z, a.w); hw.z = pk2(c.x, c.y); hw.w = pk2(c.z, c.w); h16[64 * j] = hw;
                      const f32x4 ya = a * gsv[k >> 1][j][0], yc = c * gsv[k >> 1][j][1];
                      v4u yw; yw.x = pk2(ya.x, ya.y); yw.y = pk2(ya.z, ya.w); yw.z = pk2(yc.x, yc.y); yw.w = pk2(yc.z, yc.w); o16[64 * j] = yw; }
                  s = wave_sum(s, lane); if (lane == 0) *(f32x4*)(SSQ + (size_t)row * 4) = (f32x4){s, 0.f, 0.f, 0.f};
#pragma unroll
                  for (int j = 0; j < 2; ++j) { vc[j][0] = vn[j][0]; vc[j][1] = vn[j][1]; }
              }
#undef P2_LD
              for (int rowc = ML + gw; rowc < M; rowc += NGW) { const float* src = ctxp + (size_t)(rowc - ML) * D; const float* shift = MOD + (size_t)4 * NMODW;
                    norm_row(src, g0, shift, shift + D, XN + (size_t)rowc * D, lane);
#pragma unroll
                    for (int j = 0; j < 4; ++j) ((f32x4*)(H + (size_t)rowc * D))[lane + 64 * j] = ((const f32x4*)src)[lane + 64 * j]; }
            }
        } else {
            const int l = (ph - PH_L0) / PH_PER_LAYER, ty = (ph - PH_L0) % PH_PER_LAYER; const bool last = (l == 1);
            if (last && (ty == T_NC2 || ty == T_NC3)) return;
            bf16_t* Wl = W + (size_t)l * W_LAYER; const float* MODl = MOD + (size_t)l * 5 * NMODW;
            float* SSQ = (float*)(wsp + WS_SSQ); const float* GS = (const float*)(wsp + WS_GS); const float* SW = (const float*)(wsp + WS_SW);
            const int mrows = (last && ty >= T_OUT) ? ML : M;
            if (ty == T_NC1 || ty == T_NC2 || ty == T_NC3) {
                const int kk = (ty == T_NC1) ? 1 : (ty == T_NC2) ? 2 : 0, ln = (ty == T_NC3) ? l + 1 : l;
                const float* shift = MOD + (size_t)ln * 5 * NMODW + (size_t)4 * NMODW + (3 * kk) * D; const float* ngn = KIN(6) + (size_t)(ln * 3 + kk) * D;
                const int ns = (ty == T_NC2) ? 4 : 11;
                for (int row = ML + gw; row < M; row += NGW) {
                    f32x4* hr = (f32x4*)(H + (size_t)row * D) + 2 * lane; f32x4 v[2][2];
#pragma unroll
                    for (int j = 0; j < 2; ++j) { v[j][0] = hr[128 * j]; v[j][1] = hr[128 * j + 1]; }
#define NC_ALL(cnt_) do { v4u w_[cnt_][2]; \
                        _Pragma("unroll") for (int q_ = 0; q_ < (cnt_); ++q_) { const v4u* sp = (const v4u*)((const bf16_t*)pg8::slab_ptr(wsi, outi, q_) + (size_t)(row - ML) * D) + lane; \
                            _Pragma("unroll") for (int j = 0; j < 2; ++j) w_[q_][j] = sp[64 * j]; } \
                        _Pragma("unroll") for (int q_ = 0; q_ < (cnt_); ++q_) _Pragma("unroll") for (int j = 0; j < 2; ++j) { const v4u t_ = w_[q_][j]; \
                            v[j][0] += (f32x4){__uint_as_float(t_.x << 16), __uint_as_float(t_.x & 0xffff0000u), __uint_as_float(t_.y << 16), __uint_as_float(t_.y & 0xffff0000u)}; \
                            v[j][1] += (f32x4){__uint_as_float(t_.z << 16), __uint_as_float(t_.z & 0xffff0000u), __uint_as_float(t_.w << 16), __uint_as_float(t_.w & 0xffff0000u)}; } } while (0)
                    if (ns == 11) { NC_ALL(11); } else { NC_ALL(4); }
#undef NC_ALL
                    float sq = 0.f;
#pragma unroll
                    for (int j = 0; j < 2; ++j)
#pragma unroll
                        for (int h = 0; h < 2; ++h) sq += (v[j][h].x * v[j][h].x + v[j][h].y * v[j][h].y) + (v[j][h].z * v[j][h].z + v[j][h].w * v[j][h].w);
                    const float rstd = 1.0f / sqrtf(wave_sum(sq, lane) * (1.0f / D) + 1e-6f);
                    f32x4 y[2][2];
#pragma unroll
                    for (int j = 0; j < 2; ++j)
#pragma unroll
                        for (int h = 0; h < 2; ++h) { const int c = 8 * lane + 512 * j + 4 * h; const f32x4 gg = *(const f32x4*)(ngn + c), sc = *(const f32x4*)(shift + D + c), sh = *(const f32x4*)(shift + c);
                            y[j][h] = v[j][h] * rstd * gg * (sc + 1.0f) + sh; }
                    v4u* o16 = (v4u*)(XN + (size_t)row * D) + lane;
#pragma unroll
                    for (int j = 0; j < 2; ++j) { v4u yw; yw.x = pk2(y[j][0].x, y[j][0].y); yw.y = pk2(y[j][0].z, y[j][0].w); yw.z = pk2(y[j][1].x, y[j][1].y); yw.w = pk2(y[j][1].z, y[j][1].w); o16[64 * j] = yw;
                        hr[128 * j] = v[j][0]; hr[128 * j + 1] = v[j][1]; }
                }
            } else if (ty == T_GU1 || ty == T_GU2) {
                pg8::Gemm g{XN, Wl + (ty == T_GU1 ? OFF_GU1 : OFF_GU2), mrows, 2 * DFF, D, D, 0}; pg8::StaticOrder So; So.init(mrows, 2 * DFF, G, bx);
                pg8::EpiGU E{pg8::EpiCtx{wsi, outi, kin, l, ty}};
                pg8::gemm_phase<pg8::EpiGU, pg8::StaticOrder, true, true>(lds + RING_OFF, g, So, E, tidq());
                if (bx >= 216) {
                    const int bi = bx - 216;
                    if (l == 0 && ty == T_GU1) { conv_range(0, R_DN1, R_DN2, 40, bi); conv_range(0, R_IN, R_OUT, 40, bi); }
                    if (l == 0 && ty == T_GU2) { conv_range(1, R_GU1, R_GU2, 40, bi); }
                    if (l == 1 && ty == T_GU1) { conv_range(1, R_DN1, R_DN2, 40, bi); conv_range(1, R_IN, R_OUT, 40, bi); }
                }
            } else if (ty == T_DN1 || ty == T_DN2 || ty == T_OUT) {
                const bf16_t* A = (ty == T_OUT) ? Y : HB; const int K = (ty == T_OUT) ? D : DFF;
                const bf16_t* Bt = Wl + (ty == T_DN1 ? OFF_DN1 : ty == T_DN2 ? OFF_DN2 : OFF_OUT);
                {
                    pg8::Gemm g{A, Bt, M, D, K, K, (ty == T_OUT) ? 0 : 1};        pg8::DnOrder So; So.so.init(ML, D, G, bx); So.ns = (mrows == M) ? K / 256 : 0; So.KS = 256; So.ntl = K / 64;
                    pg8::EpiDn E{pg8::EpiRes{pg8::EpiCtx{wsi, outi, kin, l, ty}, (LAS float*)(lds + EPI_OFF)}, pg8::EpiResAt{pg8::EpiCtx{wsi, outi, kin, l, ty}}};
                    pg8::gemm_phase<pg8::EpiDn, pg8::DnOrder, true, true>(lds + RING_OFF, g, So, E, tidq());
                }
                if (ty == T_DN1 && bx < 80)  { sw_rows(l, 1, 80, bx); conv_range(l, R_OUT, I_LAYER, 80, bx); }
                if (l == 0 && ty == T_OUT && bx < 192) { sw_rows(0, 2, 192, bx); sw_rows(1, 2, 192, bx); }
                if (l == 0 && ty == T_DN2 && bx < 80)  { sw_rows(1, 0, 80, bx); }
            } else if (ty == T_IN) {
                pg8::Gemm g{XN, Wl + OFF_IN, M, NIN, D, D, 0}; pg8::StaticOrder So; So.init(M, NIN, G, bx);
                { const int tq = tidq(); *(LAS f32x4*)(lds + RING_OFF + pg8::STAGE_BYTES + 10240 + tq * 16) = *((const f32x4*)T->cosv + tq); asm volatile("s_waitcnt vmcnt(0) lgkmcnt(0)" ::: "memory"); __syncthreads(); }
                pg8::EpiIN E{pg8::EpiCtx{wsi, outi, kin, l, ty}, (const LAS float*)(lds + RING_OFF + pg8::STAGE_BYTES + 10240)};
                pg8::gemm_phase<pg8::EpiIN, pg8::StaticOrder, true, true>(lds + RING_OFF, g, So, E, tidq());
                if (bx >= 168) {
                    const int bi = bx - 168; if (l == 0) conv_range(0, R_GU2, R_DN1, 88, bi); conv_range(l, R_DN2, R_IN, 88, bi);
                }
            } else if (ty == T_M2) {
                return;
            } else if (ty == T_M1) {
              const float* cw = KIN(13) + (size_t)l * 1024; const float* cb = KIN(14) + (size_t)l * 256; const float* lbr = KIN(16) + (size_t)l * 512; const float* lbi = KIN(18) + (size_t)l * 512;
              float* SUMM = (float*)(wsp + WS_SUMM); unsigned* PH = (unsigned*)outp;
              gu32* lcnt = (gu32*)(wsp + WS_CTL) + 2048 + 64 * l;
              { unsigned nloc = 0;
                for (int u = vcu; u < 288; u += G) { int b, ck, mode; if (u < 256) { b = u >> 6; ck = 4 + (u & 63); mode = 0; } else { const int i2 = u - 256; b = i2 >> 3; ck = (i2 >> 1) & 3; mode = 1 + (i2 & 1); }
                    int tq = tid; asm volatile("" : "+v"(tq));
                    lru::lru_unit<false>(lds, PROJ, Y, Wl + OFF_LRU, cw, cb, lbr, lbi, T->lruc + l * 512, SUMM, PH, b, ck, mode, tq); ++nloc; }
                asm volatile("s_waitcnt vmcnt(0)" ::: "memory"); __syncthreads();
                if (wave == 0 && lane == 0) { __builtin_amdgcn_fence(__ATOMIC_RELEASE, "agent"); asm volatile("s_waitcnt vmcnt(0)" ::: "memory"); __hip_atomic_fetch_add(lcnt, nloc, __ATOMIC_RELAXED, __HIP_MEMORY_SCOPE_AGENT); }
              }
              {
                const float* sink = KIN(20) + l * 4;
                {
                    const int idx = vcu, b = idx >> 6, kvh = (idx >> 5) & 1, q0 = 128 * (idx & 31), g = wave >> 2, head = 2 * kvh + g;
                    att::TileSeq ts; ts.b = b; ts.mode = 1; ts.q0 = q0; ts.jlo = (q0 == 0) ? 2 : 0; { const int jh = (S - q0 + 128) / 64; ts.nt = 4 + ((jh < 6) ? jh : 6) - ts.jlo; }
                    { int tq = tid; asm volatile("" : "+v"(tq)); att::attn_unit<1, 2, 3, false>(lds, PROJ, Y, ts, b * S + q0 + 32 * (wave & 3), 512 + 64 * head, 768 + 64 * kvh, 896 + 64 * kvh, 256 + 64 * head, q0 + 32 * (wave & 3), sink[head] * LOG2E, 0.f, nullptr, 0.f, tq); }
                }
                if (!last && vcu >= 32 && vcu < 48) {
                    const int idx = vcu - 32, b = idx >> 2, kvh = (idx >> 1) & 1, qb = idx & 1, g = wave >> 2, head = 2 * kvh + g;
                    att::TileSeq ts; ts.b = b; ts.mode = 2; ts.q0 = 0; ts.jlo = 0; ts.nt = 4;
                    { int tq = tid; asm volatile("" : "+v"(tq)); att::attn_unit<1, 2, 3, false>(lds, PROJ, Y, ts, ML + b * LC + 128 * qb + 32 * (wave & 3), 512 + 64 * head, 768 + 64 * kvh, 896 + 64 * kvh, 256 + 64 * head, 0, sink[head] * LOG2E, 0.f, nullptr, 0.f, tq); }
                }
              }
              {
                const float lam = T->lam[l]; const float* subg = KIN(22) + l * 128; const float oml = 1.0f - (0.8f - 0.6f * __expf(-0.3f * (float)l));
                {
                    const int idx = vcu, b = idx >> 6, h = (idx >> 4) & 3, q0 = 256 * (idx & 15);
                    att::TileSeq ts; ts.b = b; ts.mode = 0; ts.q0 = 0; ts.jlo = 0; ts.nt = 68;
                    { int tq = tid; asm volatile("" : "+v"(tq)); att::attn_unit_pp<2, 4>(lds, PROJ, Y, ts, b * S + q0 + 32 * wave, 1024 + 128 * h, 1536 + 128 * h, 2048 + 128 * h, 512 + 128 * h, lam, subg, oml, tq); }
                }
                if (!last && vcu >= 48 && vcu < 64) {
                    const int idx = vcu - 48, b = idx >> 2, h = idx & 3;
                    att::TileSeq ts; ts.b = b; ts.mode = 2; ts.q0 = 0; ts.jlo = 0; ts.nt = 4;
                    { int tq = tid; asm volatile("" : "+v"(tq)); att::attn_unit_pp<2, 4>(lds, PROJ, Y, ts, ML + b * LC + 32 * wave, 1024 + 128 * h, 1536 + 128 * h, 2048 + 128 * h, 512 + 128 * h, lam, subg, oml, tq); }
                }
              }
              if (wave == 0) {
                  if (lane == 0) { unsigned spins = 0; while (__hip_atomic_load(lcnt, __ATOMIC_RELAXED, __HIP_MEMORY_SCOPE_AGENT) < 288u) { __builtin_amdgcn_s_sleep(8); if (++spins > (1u << 20)) break; } }
                  __builtin_amdgcn_fence(__ATOMIC_ACQUIRE, "agent"); asm volatile("s_waitcnt vmcnt(0)" ::: "memory");
              }
              __syncthreads();
              for (int u = vcu; u < 272; u += G) { const int b = u / 68, ck = u % 68; int tq = tid; asm volatile("" : "+v"(tq));
                  if (!(last && ck < 4)) lru::lru_final_unit(lds, PROJ, Y, SUMM, PH, b, ck, tq); }
              if (l == 0 && vcu >= 64) { __syncthreads(); conv_range(1, R_GU2, R_DN1, 192, vcu - 64); }
            }
        }
    if (PHI + 1 < kc.ph_end) xcd_barrier(kc.bar);
}
template <int... I> __device__ __forceinline__ void run_all(const KCtx& kc, std::integer_sequence<int, I...>) { (run_phase<I>(kc), ...); }

__global__ void __launch_bounds__(NWAVES * 64, 2) mk_fwd(Args args) {
    extern __shared__ __attribute__((aligned(16))) unsigned char lds_raw[];
    LAS unsigned char* lds = (LAS unsigned char*)lds_raw;
    volatile LAS unsigned* MISC = (volatile LAS unsigned*)(lds + MISC_OFF);
    const int tid0 = threadIdx.x; const int wave0 = __builtin_amdgcn_readfirstlane(tid0 >> 6);
    const int G = gridDim.x; const int bx = blockIdx.x; const int vcu = (G % 8 == 0) ? (bx % 8) * (G / 8) + bx / 8 : bx;
    unsigned char* ws = args.ws;
    gu32* ctl = (gu32*)(ws + WS_CTL);
    for (int u = tid0; u < (LDS_BYTES - LDSCTL_OFF) / 4; u += NWAVES * 64) ((LAS unsigned*)(lds + LDSCTL_OFF))[u] = 0u;
    __syncthreads();
    XcdBarrier bar = xcd_barrier_post((unsigned*)(ctl + CW_BAR) + args.li * XCD_BAR_WORDS, MISC + 8);

    const __attribute__((address_space(4))) unsigned long long* kin = (const __attribute__((address_space(4))) unsigned long long*)__builtin_amdgcn_kernarg_segment_ptr();
    const int NGW = G * NWAVES;

    if (args.ph_lo == PH_PRO && bx == 0) {
                const int tid = tid0; Tab* T = (Tab*)(ws + WS_TAB); const int kz = 0;
                const float* lru_lambda = KIN(19); const float* diff_lambda = KIN(21);
                for (int i = tid; i < 1024; i += NWAVES * 64) {
                    const int pos = i >> 4, f = i & 15;
                    const double q[4] = {1.0, 0.5623413251903491, 0.31622776601683794, 0.1778279410038923};
                    double inv = (f & 3) == 0 ? q[0] : (f & 3) == 1 ? q[1] : (f & 3) == 2 ? q[2] : q[3]; for (int j = 0; j < (f >> 2); ++j) inv *= 0.1;
                    const float ang = (float)pos * (float)inv;
                    double xx = (double)ang; const double TWO_PI = 6.283185307179586476925287, PI = 3.141592653589793238462643;
                    const double k = rint(xx * 0.15915494309189533577); double r = xx - k * TWO_PI;
                    double sgn = 1.0; if (r > PI * 0.5) { r = PI - r; sgn = -1.0; } else if (r < -PI * 0.5) { r = -PI - r; sgn = -1.0; }
                    const double r2 = r * r;
                    double ss = -1.9572941063391263e-20; ss = ss * r2 + 8.2206352466243295e-18; ss = ss * r2 - 2.8114572543455206e-15; ss = ss * r2 + 7.6471637318198164e-13; ss = ss * r2 - 1.6059043836821613e-10;
                    ss = ss * r2 + 2.5052108385441720e-08; ss = ss * r2 - 2.7557319223985893e-06; ss = ss * r2 + 1.9841269841269841e-04; ss = ss * r2 - 8.3333333333333332e-03; ss = ss * r2 + 1.6666666666666666e-01; ss = r - r * r2 * ss;
                    double cs = 4.1103176233121648e-19; cs = cs * r2 - 1.5619206968586226e-16; cs = cs * r2 + 4.7794773323873853e-14; cs = cs * r2 - 1.1470745597729725e-11; cs = cs * r2 + 2.0876756987868100e-09;
                    cs = cs * r2 - 2.7557319223985888e-07; cs = cs * r2 + 2.4801587301587302e-05; cs = cs * r2 - 1.3888888888888889e-03; cs = cs * r2 + 4.1666666666666664e-02; cs = cs * r2 - 0.5; cs = cs * r2 + 1.0;
                    T->cosv[i] = (float)(sgn * cs); T->sinv[i] = (float)ss;
                    T->lruc[i] = -8.0f * log1pf(expf(-lru_lambda[i]));
                }
                if (tid < 2) { const float* dl = diff_lambda + tid * 256; float s0 = 0.f, s1 = 0.f;
                    for (int j = 0; j < 64; ++j) { s0 += dl[j] * dl[64 + j]; s1 += dl[128 + j] * dl[192 + j]; }
                    T->lam[tid] = expf(s0) - expf(s1) + (0.8f - 0.6f * expf(-0.3f * (float)tid)); }
            }
    KCtx kc; kc.lds = lds; kc.ws = ws; kc.out = args.out; kc.kin = kin; kc.wave0 = wave0; kc.vcu = vcu; kc.G = G; kc.bx = bx; kc.ph_lo = args.ph_lo; kc.ph_end = args.ph_hi + (MK_REPEAT_PH >= 0 ? 1 : 0); kc.bar = bar;
    run_all(kc, std::make_integer_sequence<int, NPH + (MK_REPEAT_PH >= 0 ? 1 : 0)>{});
}

static void launch_seg(const Args& base, int lo, int hi, int& li, int grid, hipStream_t stream) {
    Args a = base; a.ph_lo = lo; a.ph_hi = hi; a.li = li++; a.rep = 0;
    void* kargs[] = {&a};
    hipError_t e = hipLaunchCooperativeKernel((const void*)mk_fwd, dim3(grid), dim3(NWAVES * 64), kargs, LDS_BYTES, stream);
    if (e != hipSuccess) fprintf(stderr, "kernel_launch: cooperative launch failed: %s (grid %d)\n", hipGetErrorString(e), grid);
}
extern "C" void kernel_launch(void* const* d_in, const int* in_sizes, int n_in, void* d_out, int out_size, void* d_ws, size_t ws_size, hipStream_t stream) {
    static int grid = 0;
    if (grid == 0) {
        if (n_in != 24 || ws_size < WS_END || out_size != ML * D) { fprintf(stderr, "kernel_launch: unexpected shapes (n_in %d, ws %zu need %zu, out %d)\n", n_in, ws_size, (size_t)WS_END, out_size); grid = -1; return; }
        int dev = 0, cus = 0, per_cu = 0;
        hipGetDevice(&dev); hipDeviceGetAttribute(&cus, hipDeviceAttributeMultiprocessorCount, dev);
        if (hipFuncSetAttribute((const void*)mk_fwd, hipFuncAttributeMaxDynamicSharedMemorySize, LDS_BYTES) != hipSuccess) { fprintf(stderr, "kernel_launch: hipFuncSetAttribute failed\n"); grid = -1; return; }
        if (hipOccupancyMaxActiveBlocksPerMultiprocessor(&per_cu, (const void*)mk_fwd, NWAVES * 64, LDS_BYTES) != hipSuccess || per_cu < 1) { fprintf(stderr, "kernel_launch: occupancy query says %d blocks per CU\n", per_cu); grid = -1; return; }
        (void)hipGetLastError();
        if (cus != 256) { fprintf(stderr, "kernel_launch: built for a 256-CU device (one workgroup per CU; the unit maps of the mixer phases assume it); found %d CUs; nothing launched\n", cus); grid = -1; return; }
        grid = cus;
    }
    if (grid < 0) return;
    hipMemsetAsync((char*)d_ws + WS_CTL, 0, 1u << 20, stream);
    Args a{};
    for (int i = 0; i < 24; ++i) a.in[i] = (const float*)d_in[i];
    a.out = (float*)d_out; a.ws = (unsigned char*)d_ws;
    int li = 0, lo = 0;
    launch_seg(a, lo, NPH, li, grid, stream);
}
```
